# Optimizing an MI355X kernel written in HIP

```python
import jax
import jax.numpy as jnp
from jax import lax
import numpy as np

D_MODEL = 1024
BATCH = 4
SEQ = 4096
DEPTH = 2

GRID_W = 64
CTX_LEN = 256
N_HEADS = 4
HEAD_DIM = 64
MIX_W = N_HEADS * HEAD_DIM
N_BRANCH = 4
CONV_W = 4
LRU_C = 8.0
RET_CHUNK = 128
MLSTM_CHUNK = 128
HGRN_CHUNK = 16
ROPE_BASE = 10000.0
N_GROUPS = 4
EXP_PER_GROUP = 4
N_EXPERTS = N_GROUPS * EXP_PER_GROUP
TOP_K = 2
D_EXPERT = 512
N_MOD = 6
EPS = 1e-6
M_INIT = -1e30

IN_COLS = (
    ('a_x', MIX_W), ('a_g', MIX_W),
    ('b_q', MIX_W), ('b_k', MIX_W), ('b_v', MIX_W), ('b_g', MIX_W),
    ('c_q', MIX_W), ('c_k', MIX_W), ('c_v', MIX_W), ('c_o', MIX_W), ('c_gates', 4 * N_HEADS),
    ('d_q', MIX_W), ('d_ff', MIX_W), ('d_fb', MIX_W), ('d_i', MIX_W), ('d_g', MIX_W),
    ('merge', N_BRANCH * D_MODEL),
)
IN_W = 15 * MIX_W + 4 * N_HEADS + N_BRANCH * D_MODEL

kernel_name = 'hybrid_lru_retention_mlstm_hgrn2_hmoe_dit'


def rmsnorm(t):
    tf = t.astype(jnp.float32)
    return (tf * lax.rsqrt(jnp.mean(tf * tf, -1, keepdims=True) + EPS)).astype(t.dtype)


def modulate(t, shift, scale):
    return rmsnorm(t) * (1.0 + scale) + shift


def split_cols(p):
    out, off = {}, 0
    for name, width in IN_COLS:
        out[name] = p[..., off:off + width]
        off += width
    return out


def heads(t):
    b, n, _ = t.shape
    return t.astype(jnp.float32).reshape(b, n, N_HEADS, HEAD_DIM).transpose(0, 2, 1, 3)


def head_norm(o, center):
    if center:
        o = o - jnp.mean(o, -1, keepdims=True)
    o = o * lax.rsqrt(jnp.mean(o * o, -1, keepdims=True) + EPS)
    b, h, n, dh = o.shape
    return o.transpose(0, 2, 1, 3).reshape(b, n, h * dh)


def tflip(t, rev):
    return jnp.flip(t, 2) if rev else t


def centred_dwconv(t, w, b):
    y = lax.conv_general_dilated(
        t, w[:, None, :].astype(t.dtype), window_strides=(1,), padding=((2, 1),),
        dimension_numbers=('NWC', 'WIO', 'NWC'), feature_group_count=t.shape[-1])
    return y + b


def rope_tables(row, col):
    n = HEAD_DIM // 4
    inv = jnp.power(ROPE_BASE, -jnp.arange(n, dtype=jnp.float32) / n)
    ang = jnp.concatenate([row[:, None] * inv, col[:, None] * inv], -1)
    return jnp.cos(ang), jnp.sin(ang)


def apply_rope(t, cos, sin):
    half = HEAD_DIM // 2
    t1, t2 = t[..., :half], t[..., half:]
    return jnp.concatenate([t1 * cos - t2 * sin, t1 * sin + t2 * cos], -1)


def rglru_scan(u, w_r, b_r, w_i, b_i, lam, h0, reverse):
    b, n, _ = u.shape
    uf = u.astype(jnp.float32)
    if reverse:
        uf = jnp.flip(uf, 1)
    uh = uf.reshape(b, n, N_HEADS, HEAD_DIM)
    r = jax.nn.sigmoid(jnp.einsum('bthi,hij->bthj', uh, w_r).reshape(b, n, MIX_W) + b_r)
    gi = jax.nn.sigmoid(jnp.einsum('bthi,hij->bthj', uh, w_i).reshape(b, n, MIX_W) + b_i)
    log_a = LRU_C * r * jax.nn.log_sigmoid(lam.astype(jnp.float32))
    a = jnp.exp(log_a)
    inp = jnp.sqrt(-jnp.expm1(2.0 * log_a)) * (gi * uf)

    def combine(left, right):
        a_l, h_l = left
        a_r, h_r = right
        return a_r * a_l, a_r * h_l + h_r

    a_cum, h = lax.associative_scan(combine, (a, inp), axis=1)
    h = h + a_cum * h0[:, None, :]
    h_final = h[:, -1]
    if reverse:
        h = jnp.flip(h, 1)
    return h, h_final


def mixer_rglru(pc, px, conv_w, conv_b, gate_w, gate_b, lam):
    uc = centred_dwconv(pc['a_x'], conv_w, conv_b)
    ux = centred_dwconv(px['a_x'], conv_w, conv_b)
    h0 = jnp.zeros((uc.shape[0], MIX_W), jnp.float32)
    hcs, hxs = [], []
    for d in range(2):
        prm = (gate_w[d, 0], gate_b[d, 0], gate_w[d, 1], gate_b[d, 1], lam[d])
        hc, state = rglru_scan(uc, *prm, h0, d == 1)
        hx, _ = rglru_scan(ux, *prm, state, d == 1)
        hcs.append(hc)
        hxs.append(hx)
    yc = jax.nn.gelu(pc['a_g'].astype(jnp.float32)) * (hcs[0] + hcs[1])
    yx = jax.nn.gelu(px['a_g'].astype(jnp.float32)) * (hxs[0] + hxs[1])
    return yc, yx


def retention_chunked(q, k, v, log_gamma, s0, include_diag):
    b, h, n, dh = q.shape
    L = RET_CHUNK
    nc = n // L
    q, k, v = (t.reshape(b, h, nc, L, dh) for t in (q, k, v))
    pos = jnp.arange(L, dtype=jnp.float32)
    diff = pos[:, None] - pos[None, :]
    mask = (diff >= 0) if include_diag else (diff > 0)
    decay = jnp.where(mask, jnp.exp(log_gamma[:, None, None] * jnp.maximum(diff, 0.0)), 0.0)
    scores = jnp.einsum('bhnid,bhnjd->bhnij', q, k) * decay[:, None]
    o_intra = jnp.einsum('bhnij,bhnje->bhnie', scores, v)
    k_w = jnp.exp(log_gamma[:, None] * (L - 1.0 - pos))
    kv = jnp.einsum('bhnjd,bhnje->bhnde', k * k_w[:, None, :, None], v)
    g_chunk = jnp.exp(log_gamma * L)[:, None, None]

    def step(s, kv_n):
        return g_chunk * s + kv_n, s

    s_final, s_prev = lax.scan(step, s0, jnp.moveaxis(kv, 2, 0))
    s_prev = jnp.moveaxis(s_prev, 0, 2)
    q_w = jnp.exp(log_gamma[:, None] * (pos + 1.0))
    o_inter = jnp.einsum('bhnid,bhnde->bhnie', q * q_w[:, None, :, None], s_prev)
    return (o_intra + o_inter).reshape(b, h, n, dh), s_final


def mixer_retention(pc, px, theta, cos, sin):
    scale = HEAD_DIM ** -0.5
    qc, kc, vc = heads(pc['b_q']), heads(pc['b_k']) * scale, heads(pc['b_v'])
    qx = apply_rope(heads(px['b_q']), cos, sin)
    kx = apply_rope(heads(px['b_k']), cos, sin) * scale
    vx = heads(px['b_v'])
    s0 = jnp.zeros(qc.shape[:2] + (HEAD_DIM, HEAD_DIM), jnp.float32)
    ocs, oxs = [], []
    for d in range(2):
        rev = d == 1
        lg = jax.nn.log_sigmoid(theta[d].astype(jnp.float32))
        oc, state = retention_chunked(tflip(qc, rev), tflip(kc, rev), tflip(vc, rev), lg, s0, not rev)
        ox, _ = retention_chunked(tflip(qx, rev), tflip(kx, rev), tflip(vx, rev), lg, state, not rev)
        ocs.append(tflip(oc, rev))
        oxs.append(tflip(ox, rev))

    def out(p, o):
        return head_norm(o[0] + o[1], True) * jax.nn.silu(p['b_g'].astype(jnp.float32))

    return out(pc, ocs), out(px, oxs)


def mlstm_chunked(q, k, v, log_i, log_f, state):
    b, h, n, dh = q.shape
    L = MLSTM_CHUNK
    nc = n // L
    q, k, v = (t.reshape(b, h, nc, L, dh) for t in (q, k, v))
    log_i = log_i.reshape(b, h, nc, L)
    cum = jnp.cumsum(log_f.reshape(b, h, nc, L), -1)
    causal = jnp.tril(jnp.ones((L, L), bool))
    log_d = jnp.where(causal, cum[..., :, None] - cum[..., None, :] + log_i[..., None, :], -jnp.inf)
    m_intra = jnp.max(log_d, -1)
    cum_end = cum[..., -1]
    log_w = cum_end[..., None] - cum + log_i
    m_loc = jnp.max(log_w, -1)
    w = jnp.exp(log_w - m_loc[..., None])
    c_loc = jnp.einsum('bhnj,bhnjd,bhnje->bhnde', w, k, v)
    n_loc = jnp.einsum('bhnj,bhnjd->bhnd', w, k)

    def step(carry, xs):
        c_s, n_s, m_s = carry
        c_l, n_l, m_l, ce = xs
        m_new = jnp.maximum(ce + m_s, m_l)
        s_old = jnp.exp(ce + m_s - m_new)
        s_loc = jnp.exp(m_l - m_new)
        c_new = s_old[..., None, None] * c_s + s_loc[..., None, None] * c_l
        n_new = s_old[..., None] * n_s + s_loc[..., None] * n_l
        return (c_new, n_new, m_new), (c_s, n_s, m_s)

    xs = tuple(jnp.moveaxis(t, 2, 0) for t in (c_loc, n_loc, m_loc, cum_end))
    final, prev = lax.scan(step, state, xs)
    c_prev, n_prev, m_prev = (jnp.moveaxis(t, 0, 2) for t in prev)
    m_inter = cum + m_prev[..., None]
    m_q = jnp.maximum(m_intra, m_inter)
    s = jnp.einsum('bhnid,bhnjd->bhnij', q, k) * jnp.exp(log_d - m_q[..., None])
    s_inter = jnp.exp(m_inter - m_q)
    num = jnp.einsum('bhnij,bhnje->bhnie', s, v) + s_inter[..., None] * jnp.einsum('bhnid,bhnde->bhnie', q, c_prev)
    den = jnp.sum(s, -1) + s_inter * jnp.einsum('bhnid,bhnd->bhni', q, n_prev)
    hid = num / jnp.maximum(jnp.abs(den), jnp.exp(-m_q))[..., None]
    return hid.reshape(b, h, n, dh), final


def mixer_mlstm(pc, px, conv_w, conv_b, gate_b):
    def prep(p):
        b, n, _ = p['c_q'].shape
        qk = jax.nn.silu(centred_dwconv(jnp.concatenate([p['c_q'], p['c_k']], -1), conv_w, conv_b))
        q = heads(qk[..., :MIX_W])
        k = heads(qk[..., MIX_W:]) * HEAD_DIM ** -0.5
        v = heads(p['c_v'])
        g = (p['c_gates'].astype(jnp.float32) + gate_b.reshape(-1)).reshape(b, n, 4, N_HEADS)
        return q, k, v, g.transpose(2, 0, 3, 1)

    qc, kc, vc, gc = prep(pc)
    qx, kx, vx, gx = prep(px)
    b = qc.shape[0]
    init = (jnp.zeros((b, N_HEADS, HEAD_DIM, HEAD_DIM), jnp.float32),
            jnp.zeros((b, N_HEADS, HEAD_DIM), jnp.float32),
            jnp.full((b, N_HEADS), M_INIT, jnp.float32))
    hcs, hxs = [], []
    for d in range(2):
        rev = d == 1
        hc, state = mlstm_chunked(tflip(qc, rev), tflip(kc, rev), tflip(vc, rev), tflip(gc[2 * d], rev),
                                  tflip(jax.nn.log_sigmoid(gc[2 * d + 1]), rev), init)
        hx, _ = mlstm_chunked(tflip(qx, rev), tflip(kx, rev), tflip(vx, rev), tflip(gx[2 * d], rev),
                              tflip(jax.nn.log_sigmoid(gx[2 * d + 1]), rev), state)
        hcs.append(tflip(hc, rev))
        hxs.append(tflip(hx, rev))

    def out(p, o):
        return jax.nn.sigmoid(p['c_o'].astype(jnp.float32)) * head_norm(o[0] + o[1], True)

    return out(pc, hcs), out(px, hxs)


def gla_chunked(q, k, v, log_f, s0):
    b, h, n, dk = q.shape
    dv = v.shape[-1]
    L = HGRN_CHUNK
    nc = n // L
    q, k, log_f = (t.reshape(b, h, nc, L, dk) for t in (q, k, log_f))
    v = v.reshape(b, h, nc, L, dv)
    cum = jnp.cumsum(log_f, 3)
    causal = jnp.tril(jnp.ones((L, L), bool))[:, :, None]
    decay = jnp.exp(jnp.where(causal, cum[..., :, None, :] - cum[..., None, :, :], -jnp.inf))
    scores = jnp.einsum('bhnic,bhnjc,bhnijc->bhnij', q, k, decay)
    o_intra = jnp.einsum('bhnij,bhnje->bhnie', scores, v)
    cum_end = cum[..., -1, :]
    kv = jnp.einsum('bhnjc,bhnje->bhnce', k * jnp.exp(cum_end[..., None, :] - cum), v)

    def step(s, xs):
        kv_n, ce = xs
        return jnp.exp(ce)[..., None] * s + kv_n, s

    s_final, s_prev = lax.scan(step, s0, (jnp.moveaxis(kv, 2, 0), jnp.moveaxis(cum_end, 2, 0)))
    s_prev = jnp.moveaxis(s_prev, 0, 2)
    o_inter = jnp.einsum('bhnic,bhnce->bhnie', q * jnp.exp(cum), s_prev)
    return (o_intra + o_inter).reshape(b, h, n, dv), s_final


def mixer_hgrn2(pc, px, lb):
    def prep(p):
        q = heads(jax.nn.silu(p['d_q'].astype(jnp.float32)))
        v = heads(p['d_i'])
        f = [heads(lb + (1.0 - lb) * jax.nn.sigmoid(p[name].astype(jnp.float32))) for name in ('d_ff', 'd_fb')]
        return q, v, f

    qc, vc, fc = prep(pc)
    qx, vx, fx = prep(px)
    s0 = jnp.zeros(qc.shape[:2] + (HEAD_DIM, HEAD_DIM), jnp.float32)
    ocs, oxs = [], []
    for d in range(2):
        rev = d == 1
        f_c, f_x = tflip(fc[d], rev), tflip(fx[d], rev)
        oc, state = gla_chunked(tflip(qc, rev), 1.0 - f_c, tflip(vc, rev), jnp.log(f_c), s0)
        ox, _ = gla_chunked(tflip(qx, rev), 1.0 - f_x, tflip(vx, rev), jnp.log(f_x), state)
        ocs.append(tflip(oc, rev))
        oxs.append(tflip(ox, rev))

    def out(p, o):
        return head_norm(o[0] + o[1], False) * jax.nn.silu(p['d_g'].astype(jnp.float32))

    return out(pc, ocs), out(px, oxs)


def token_mixers(hc, hx, w_in, a_conv_w, a_conv_b, a_gate_w, a_gate_b, a_lambda, b_theta,
                 c_conv_w, c_conv_b, c_gate_b, lb, w_branch, w_out, cos, sin, need_ctx):
    pc = split_cols(hc @ w_in)
    px = split_cols(hx @ w_in)
    ya = mixer_rglru(pc, px, a_conv_w, a_conv_b, a_gate_w, a_gate_b, a_lambda)
    yb = mixer_retention(pc, px, b_theta, cos, sin)
    yc = mixer_mlstm(pc, px, c_conv_w, c_conv_b, c_gate_b)
    yd = mixer_hgrn2(pc, px, lb)

    def merge(p, ys, dtype):
        y = jnp.stack(ys, 2).astype(dtype)
        gate = jax.nn.sigmoid(p['merge'].reshape(y.shape[:2] + (N_BRANCH, D_MODEL)))
        z = jnp.sum(gate * jnp.einsum('btnw,nwd->btnd', y, w_branch), 2)
        return z @ w_out

    mix_x = merge(px, [ya[1], yb[1], yc[1], yd[1]], hx.dtype)
    mix_c = merge(pc, [ya[0], yb[0], yc[0], yd[0]], hc.dtype) if need_ctx else None
    return mix_c, mix_x


def hier_moe(h, w_group, b_group, w_router, b_router, w1, w3, w2):
    lead = h.shape[:-1]
    g_logit = (h @ w_group).astype(jnp.float32) + b_group
    g_idx = jnp.argmax(g_logit, -1)
    g_prob = jnp.max(jax.nn.softmax(g_logit, -1), -1, keepdims=True)
    e_logit = ((h @ w_router).astype(jnp.float32) + b_router).reshape(lead + (N_GROUPS, EXP_PER_GROUP))
    e_logit = jnp.sum(e_logit * jax.nn.one_hot(g_idx, N_GROUPS, dtype=jnp.float32)[..., None], -2)
    top_v, top_i = lax.top_k(e_logit, TOP_K)
    top_w = jax.nn.softmax(top_v, -1) * g_prob
    expert_id = g_idx[..., None] * EXP_PER_GROUP + top_i
    gates = jnp.sum(jax.nn.one_hot(expert_id, N_EXPERTS, dtype=jnp.float32) * top_w[..., None], -2)
    out = jnp.zeros_like(h)
    for e in range(N_EXPERTS):
        y = (jax.nn.silu(h @ w1[e]) * (h @ w3[e])) @ w2[e]
        out = out + gates[..., e:e + 1].astype(h.dtype) * y
    return out


def setup_inputs(seed: int = 0) -> dict:
    key = jax.random.key(seed)
    ks = jax.random.split(key, 28)
    f32 = jnp.float32

    def nrm(k, shape, scale):
        return jax.random.normal(k, shape, f32) * scale

    lru_a8 = jax.random.uniform(ks[11], (DEPTH, 2, MIX_W), f32, 0.9, 0.999)
    lru_a = lru_a8 ** (1.0 / LRU_C)
    gamma = 1.0 - 2.0 ** (-5.0 - jnp.arange(N_HEADS, dtype=f32))
    theta0 = jnp.log(gamma) - jnp.log1p(-gamma)
    zero_h = jnp.zeros((N_HEADS,), f32)
    f_bias = jnp.linspace(3.0, 6.0, N_HEADS, dtype=f32)
    gate_bias0 = jnp.stack([zero_h, f_bias, zero_h, f_bias])
    return {
        'x': nrm(ks[0], (BATCH, SEQ, D_MODEL), 1.0),
        'c': nrm(ks[1], (BATCH, D_MODEL), 1.0),
        'ctx': nrm(ks[2], (BATCH, CTX_LEN, D_MODEL), 1.0),
        'c_ctx': nrm(ks[3], (D_MODEL,), 1.0),
        'w_mod': nrm(ks[4], (DEPTH, D_MODEL, N_MOD * D_MODEL), 0.5 * D_MODEL ** -0.5),
        'b_mod': nrm(ks[5], (DEPTH, N_MOD * D_MODEL), 0.02),
        'w_in': nrm(ks[6], (DEPTH, D_MODEL, IN_W), D_MODEL ** -0.5),
        'a_conv_w': nrm(ks[7], (DEPTH, CONV_W, MIX_W), CONV_W ** -0.5),
        'a_conv_b': nrm(ks[8], (DEPTH, MIX_W), 0.02),
        'a_gate_w': nrm(ks[9], (DEPTH, 2, 2, N_HEADS, HEAD_DIM, HEAD_DIM), HEAD_DIM ** -0.5),
        'a_gate_b': nrm(ks[10], (DEPTH, 2, 2, MIX_W), 0.02),
        'a_lambda': jnp.log(lru_a) - jnp.log1p(-lru_a),
        'b_theta': theta0 + nrm(ks[12], (DEPTH, 2, N_HEADS), 0.01),
        'c_conv_w': nrm(ks[13], (DEPTH, CONV_W, 2 * MIX_W), CONV_W ** -0.5),
        'c_conv_b': nrm(ks[14], (DEPTH, 2 * MIX_W), 0.02),
        'c_gate_b': gate_bias0 + nrm(ks[15], (DEPTH, 4, N_HEADS), 0.1),
        'd_lb': nrm(ks[16], (DEPTH, MIX_W), 1.0),
        'w_branch': nrm(ks[17], (DEPTH, N_BRANCH, MIX_W, D_MODEL), MIX_W ** -0.5),
        'w_out': nrm(ks[18], (DEPTH, D_MODEL, D_MODEL), D_MODEL ** -0.5),
        'moe_w_group': nrm(ks[19], (DEPTH, D_MODEL, N_GROUPS), D_MODEL ** -0.5),
        'moe_b_group': nrm(ks[20], (DEPTH, N_GROUPS), 0.01),
        'moe_w_router': nrm(ks[21], (DEPTH, D_MODEL, N_EXPERTS), D_MODEL ** -0.5),
        'moe_b_router': nrm(ks[22], (DEPTH, N_EXPERTS), 0.01),
        'moe_w1': nrm(ks[23], (DEPTH, N_EXPERTS, D_MODEL, D_EXPERT), D_MODEL ** -0.5),
        'moe_w3': nrm(ks[24], (DEPTH, N_EXPERTS, D_MODEL, D_EXPERT), D_MODEL ** -0.5),
        'moe_w2': nrm(ks[25], (DEPTH, N_EXPERTS, D_EXPERT, D_MODEL), D_EXPERT ** -0.5),
        'final_norm_w': 1.0 + nrm(ks[26], (D_MODEL,), 0.02),
    }


def reference(x, c, ctx, c_ctx, w_mod, b_mod, w_in, a_conv_w, a_conv_b, a_gate_w, a_gate_b,
              a_lambda, b_theta, c_conv_w, c_conv_b, c_gate_b, d_lb, w_branch, w_out,
              moe_w_group, moe_b_group, moe_w_router, moe_b_router, moe_w1, moe_w3, moe_w2,
              final_norm_w):
    n_lat = x.shape[1]
    rows = n_lat // GRID_W
    row = jnp.repeat(jnp.arange(rows), GRID_W)
    col = jnp.tile(jnp.arange(GRID_W), rows)
    cos, sin = rope_tables(row, col)
    lbs = jnp.cumsum(jax.nn.softmax(d_lb.astype(jnp.float32), axis=0), axis=0)
    lbs = lbs - lbs[0]
    s_c = jax.nn.silu(c)
    s_cc = jax.nn.silu(c_ctx)
    for l in range(DEPTH):
        need_ctx = l < DEPTH - 1
        mx = (s_c @ w_mod[l] + b_mod[l]).reshape(-1, N_MOD, 1, D_MODEL)
        mc = (s_cc @ w_mod[l] + b_mod[l]).reshape(N_MOD, D_MODEL)
        hx = modulate(x, mx[:, 0], mx[:, 1])
        hc = modulate(ctx, mc[0], mc[1])
        mix_c, mix_x = token_mixers(hc, hx, w_in[l], a_conv_w[l], a_conv_b[l], a_gate_w[l], a_gate_b[l],
                                    a_lambda[l], b_theta[l], c_conv_w[l], c_conv_b[l], c_gate_b[l],
                                    lbs[l], w_branch[l], w_out[l], cos, sin, need_ctx)
        moe_prm = (moe_w_group[l], moe_b_group[l], moe_w_router[l], moe_b_router[l],
                   moe_w1[l], moe_w3[l], moe_w2[l])
        x = x + mx[:, 2] * mix_x
        x = x + mx[:, 5] * hier_moe(modulate(x, mx[:, 3], mx[:, 4]), *moe_prm)
        if need_ctx:
            ctx = ctx + mc[2] * mix_c
            ctx = ctx + mc[5] * hier_moe(modulate(ctx, mc[3], mc[4]), *moe_prm)
    return rmsnorm(x) * final_norm_w
```

```cpp
#ifndef EMU
#include <hip/hip_runtime.h>
#include <hip/hip_cooperative_groups.h>
#include <cstdio>
typedef short bf16x8 __attribute__((ext_vector_type(8)));
typedef float f32x4 __attribute__((ext_vector_type(4)));
#define MFMA16(a, b, c) __builtin_amdgcn_mfma_f32_16x16x32_bf16(a, b, c, 0, 0, 0)
#define LAUNCH(kern, grid, block, smem, stream, ...) hipLaunchKernelGGL(kern, dim3(grid), dim3(block), smem, stream, __VA_ARGS__)
#define DYN_SMEM(name) extern __shared__ __attribute__((aligned(16))) char name[]
#else
#define MFMA16(a, b, c) emu_mfma16(a, b, c)
#define LAUNCH(kern, grid, block, smem, stream, ...) emu::launch(dim3(grid), dim3(block), false, [=]() { kern(__VA_ARGS__); })
#define DYN_SMEM(name) char* name = emu::tl_blk->dyn_smem
#endif

typedef unsigned short bf16_t;
typedef unsigned u32x4 __attribute__((ext_vector_type(4)));
typedef unsigned u32x2 __attribute__((ext_vector_type(2)));
typedef float f32x2 __attribute__((ext_vector_type(2)));

#ifdef EMU_SMALL
constexpr int D = 256, NB = 2, SEQ = 256, CTX = 128, DE = 128;
#else
constexpr int D = 1024, NB = 4, SEQ = 4096, CTX = 256, DE = 512;
#endif
constexpr int DEPTH = 2, NH = 4, HD = 64, MW = 256;
constexpr int TS = CTX + SEQ;
constexpr int T = NB * TS;
constexpr int NT = TS / 128;
constexpr int CT = CTX / 128;
constexpr int MT = T / 128;
constexpr int INW = 15 * MW + 16 + 4 * D;
constexpr int PW = 15 * MW;
constexpr int NMOD = 6;
constexpr int GRIDW = 64;
constexpr int NCLS = 24;
constexpr float EPS = 1e-6f;
enum { C_AX = 0, C_AG = 1, C_BQ = 2, C_BK = 3, C_BV = 4, C_BG = 5, C_CQ = 6, C_CK = 7, C_CV = 8, C_CO = 9,
       C_DQ = 10, C_DFF = 11, C_DFB = 12, C_DI = 13, C_DG = 14 };

struct Params {
  const float *x, *c, *ctx, *c_ctx, *w_mod, *b_mod, *w_in, *a_conv_w, *a_conv_b, *a_gate_w, *a_gate_b, *a_lambda,
      *b_theta, *c_conv_w, *c_conv_b, *c_gate_b, *d_lb, *w_branch, *w_out, *moe_w_group, *moe_b_group,
      *moe_w_router, *moe_b_router, *moe_w1, *moe_w3, *moe_w2, *final_norm_w;
  float* out;
  float* modv;
  float* xc;
  bf16_t* h;
  bf16_t* P;
  float* cg;
  bf16_t* y;
  bf16_t* z;
  bf16_t* mid;
  bf16_t *WinT, *WmT, *WbT, *WoT, *W1T, *W3T, *W2T;
  float* retKV;
  bf16_t* retSp;
  float* mlC;
  float* mlCe;
  bf16_t* mlSp;
  float* glKV;
  float* glE;
  float* glSp;
  float* lruS;
  float* lruC;
  int* moe_cnt;
  int* moe_list;
  float* moe_tw;
  int layer;
  int pad_;
};

__device__ __forceinline__ unsigned f2u(float f) { return __builtin_bit_cast(unsigned, f); }
__device__ __forceinline__ float u2f(unsigned u) { return __builtin_bit_cast(float, u); }
__device__ __forceinline__ bf16_t f2bf(float f) {
  unsigned u = f2u(f);
  u += 0x7FFFu + ((u >> 16) & 1u);
  return (bf16_t)(u >> 16);
}
__device__ __forceinline__ float bf2f(bf16_t b) { return u2f(((unsigned)b) << 16); }
__device__ __forceinline__ unsigned pack2(float lo, float hi) { return (unsigned)f2bf(lo) | ((unsigned)f2bf(hi) << 16); }
__device__ __forceinline__ float sigmoidf_(float x) { return 1.0f / (1.0f + expf(-x)); }
__device__ __forceinline__ float siluf_(float x) { return x / (1.0f + expf(-x)); }
__device__ __forceinline__ float logsigf_(float x) {
  return (x >= 0.f) ? -log1pf(expf(-x)) : (x - log1pf(expf(x)));
}
__device__ __forceinline__ float geluf_(float x) {
  return 0.5f * x * (1.0f + tanhf(0.7978845608028654f * (x + 0.044715f * x * x * x)));
}
__device__ __forceinline__ float* xrow(const Params& p, int r) {
  int b = r / TS, s = r - b * TS;
  return (s < CTX) ? (p.xc + ((size_t)b * CTX + s) * D) : (p.out + ((size_t)b * SEQ + (s - CTX)) * D);
}
__device__ __forceinline__ const float* modrow(const Params& p, int r, int m) {
  int b = r / TS, s = r - b * TS;
  int mr = (s < CTX) ? NB : b;
  return p.modv + ((size_t)p.layer * (NB + 1) + mr) * (NMOD * D) + m * D;
}
__device__ __forceinline__ int imin(int a, int b) { return a < b ? a : b; }
__device__ __forceinline__ float wave_sum(float v) {
#pragma unroll
  for (int o = 32; o > 0; o >>= 1) v += __shfl_xor(v, o, 64);
  return v;
}

__device__ void phase_init(const Params& p) {
  int gt = blockIdx.x * blockDim.x + threadIdx.x, gn = gridDim.x * blockDim.x;
  const f32x4* xs = (const f32x4*)p.x;
  f32x4* xd = (f32x4*)p.out;
  for (size_t i = gt; i < (size_t)NB * SEQ * D / 4; i += gn) xd[i] = xs[i];
  const f32x4* cs = (const f32x4*)p.ctx;
  f32x4* cd = (f32x4*)p.xc;
  for (size_t i = gt; i < (size_t)NB * CTX * D / 4; i += gn) cd[i] = cs[i];
  for (int i = gt; i < DEPTH * 2 * NCLS; i += gn) p.moe_cnt[i] = 0;
}

__device__ void phase_modv(const Params& p) {
  __shared__ float sc[(NB + 1) * D];
  for (int i = threadIdx.x; i < (NB + 1) * D; i += blockDim.x) {
    int r = i / D, k = i - r * D;
    float v = (r < NB) ? p.c[r * D + k] : p.c_ctx[k];
    sc[i] = siluf_(v);
  }
  __syncthreads();
  const int ncols = DEPTH * NMOD * D;
  for (int col = blockIdx.x * blockDim.x + threadIdx.x; col < ncols; col += gridDim.x * blockDim.x) {
    int l = col / (NMOD * D), n = col - l * (NMOD * D);
    const float* w = p.w_mod + (size_t)l * D * (NMOD * D) + n;
    float acc[NB + 1];
#pragma unroll
    for (int r = 0; r <= NB; ++r) acc[r] = 0.f;
    for (int k = 0; k < D; ++k) {
      float wv = w[(size_t)k * (NMOD * D)];
#pragma unroll
      for (int r = 0; r <= NB; ++r) acc[r] += sc[r * D + k] * wv;
    }
    float bb = p.b_mod[l * (NMOD * D) + n];
#pragma unroll
    for (int r = 0; r <= NB; ++r) p.modv[((size_t)l * (NB + 1) + r) * (NMOD * D) + n] = acc[r] + bb;
  }
}

__device__ void convT_tile(const float* src, int ld_src, bf16_t* dst, int ld_dst, int k0, int n0, float* tile  ) {
  int tx = threadIdx.x & 63, ty = threadIdx.x >> 6;
  for (int kk = ty; kk < 64; kk += 4) tile[kk * 65 + tx] = src[(size_t)(k0 + kk) * ld_src + n0 + tx];
  __syncthreads();
  for (int c = threadIdx.x; c < 512; c += 256) {
    int n = c >> 3, kc = (c & 7) * 8;
    u32x4 v;
    v[0] = pack2(tile[(kc + 0) * 65 + n], tile[(kc + 1) * 65 + n]);
    v[1] = pack2(tile[(kc + 2) * 65 + n], tile[(kc + 3) * 65 + n]);
    v[2] = pack2(tile[(kc + 4) * 65 + n], tile[(kc + 5) * 65 + n]);
    v[3] = pack2(tile[(kc + 6) * 65 + n], tile[(kc + 7) * 65 + n]);
    *(u32x4*)(dst + (size_t)(n0 + n) * ld_dst + k0 + kc) = v;
  }
  __syncthreads();
}
__device__ void phase_convw(const Params& p, int part) {
  __shared__ float tile[64 * 65];
  const int l = p.layer;
  const int tA = (D / 64) * (2560 / 64), tB = (D / 64) * (1280 / 64), tM = (D / 64) * (4 * D / 64);
  const int tWb = 4 * (MW / 64) * (D / 64), tWo = (D / 64) * (D / 64);
  const int tE = 16 * (D / 64) * (DE / 64);
  const int total = tA + tB + tM + tWb + tWo + 3 * tE;
  const int nA = tA + tB + tM + tWb + tWo;
  const int lo = part ? nA : 0, hi = part ? total : nA;
  for (int t = lo + blockIdx.x; t < hi; t += gridDim.x) {
    int u = t;
    const float* win = p.w_in + (size_t)l * D * INW;
    if (u < tA) { int kt = u / (2560 / 64), nt = u % (2560 / 64); convT_tile(win, INW, p.WinT, D, kt * 64, nt * 64, tile); continue; }
    u -= tA;
    if (u < tB) { int kt = u / (1280 / 64), nt = u % (1280 / 64); convT_tile(win + 2576, INW, p.WinT + (size_t)2560 * D, D, kt * 64, nt * 64, tile); continue; }
    u -= tB;
    if (u < tM) { int kt = u / (4 * D / 64), nt = u % (4 * D / 64); convT_tile(win + 3856, INW, p.WmT, D, kt * 64, nt * 64, tile); continue; }
    u -= tM;
    if (u < tWb) {
      int n = u / ((MW / 64) * (D / 64)), r = u % ((MW / 64) * (D / 64)); int kt = r / (D / 64), nt = r % (D / 64);
      convT_tile(p.w_branch + ((size_t)l * 4 + n) * MW * D, D, p.WbT + (size_t)n * D * MW, MW, kt * 64, nt * 64, tile); continue;
    }
    u -= tWb;
    if (u < tWo) { int kt = u / (D / 64), nt = u % (D / 64); convT_tile(p.w_out + (size_t)l * D * D, D, p.WoT, D, kt * 64, nt * 64, tile); continue; }
    u -= tWo;
    if (u < 2 * tE) {
      int which = u / tE; int v = u % tE; int e = v / ((D / 64) * (DE / 64)), r = v % ((D / 64) * (DE / 64)); int kt = r / (DE / 64), nt = r % (DE / 64);
      const float* src = (which ? p.moe_w3 : p.moe_w1) + ((size_t)l * 16 + e) * D * DE;
      bf16_t* dst = (which ? p.W3T : p.W1T) + (size_t)e * DE * D;
      convT_tile(src, DE, dst, D, kt * 64, nt * 64, tile); continue;
    }
    u -= 2 * tE;
    { int e = u / ((DE / 64) * (D / 64)), r = u % ((DE / 64) * (D / 64)); int kt = r / (D / 64), nt = r % (D / 64);
      convT_tile(p.moe_w2 + ((size_t)l * 16 + e) * DE * D, D, p.W2T + (size_t)e * D * DE, DE, kt * 64, nt * 64, tile); }
  }
}

__device__ void phase_norm(const Params& p, int which) {
  const int lane = threadIdx.x & 63, wid = threadIdx.x >> 6, nw = blockDim.x >> 6;
  const bool last = (p.layer == DEPTH - 1);
  for (int r = blockIdx.x * nw + wid; r < T; r += gridDim.x * nw) {
    int b = r / TS, s = r - b * TS;
    if (which == 1 && last && s < CTX) continue;
    const float* xr = xrow(p, r);
    float v[D / 64];
    float ss = 0.f;
#pragma unroll
    for (int i = 0; i < D / 256; ++i) {
      f32x4 t = *(const f32x4*)(xr + i * 256 + lane * 4);
      v[i * 4 + 0] = t[0]; v[i * 4 + 1] = t[1]; v[i * 4 + 2] = t[2]; v[i * 4 + 3] = t[3];
      ss += t[0] * t[0] + t[1] * t[1] + t[2] * t[2] + t[3] * t[3];
    }
    ss = wave_sum(ss);
    float rs = rsqrtf(ss * (1.0f / D) + EPS);
    const float* sh = modrow(p, r, which ? 3 : 0);
    const float* sc = modrow(p, r, which ? 4 : 1);
    float hv[D / 64];
#pragma unroll
    for (int i = 0; i < D / 256; ++i) {
      f32x4 s4 = *(const f32x4*)(sh + i * 256 + lane * 4);
      f32x4 c4 = *(const f32x4*)(sc + i * 256 + lane * 4);
#pragma unroll
      for (int j = 0; j < 4; ++j) hv[i * 4 + j] = v[i * 4 + j] * rs * (1.0f + c4[j]) + s4[j];
      u32x2 o; o[0] = pack2(hv[i * 4 + 0], hv[i * 4 + 1]); o[1] = pack2(hv[i * 4 + 2], hv[i * 4 + 3]);
      *(u32x2*)(p.h + (size_t)r * D + i * 256 + lane * 4) = o;
    }
    if (which == 0) {
      const float* wg = p.w_in + (size_t)p.layer * D * INW + 2560;
      float acc[16];
#pragma unroll
      for (int g = 0; g < 16; ++g) acc[g] = 0.f;
#pragma unroll
      for (int i = 0; i < D / 256; ++i)
#pragma unroll
        for (int j = 0; j < 4; ++j) {
          int k = i * 256 + lane * 4 + j;
          const f32x4* wp = (const f32x4*)(wg + (size_t)k * INW);
          float hk = hv[i * 4 + j];
#pragma unroll
          for (int q = 0; q < 4; ++q) { f32x4 w4 = wp[q]; acc[q * 4 + 0] += hk * w4[0]; acc[q * 4 + 1] += hk * w4[1]; acc[q * 4 + 2] += hk * w4[2]; acc[q * 4 + 3] += hk * w4[3]; }
        }
#pragma unroll
      for (int g = 0; g < 16; ++g) acc[g] = wave_sum(acc[g]);
      if (lane < 16) {
        float a = 0.f;
#pragma unroll
        for (int g = 0; g < 16; ++g) if (lane == g) a = acc[g];
        p.cg[(size_t)r * 16 + lane] = a + p.c_gate_b[p.layer * 16 + lane];
      }
    } else {
      const float* wgr = p.moe_w_group + (size_t)p.layer * D * 4;
      const float* wrt = p.moe_w_router + (size_t)p.layer * D * 16;
      float ag[4], ar[16];
#pragma unroll
      for (int g = 0; g < 4; ++g) ag[g] = 0.f;
#pragma unroll
      for (int g = 0; g < 16; ++g) ar[g] = 0.f;
#pragma unroll
      for (int i = 0; i < D / 256; ++i)
#pragma unroll
        for (int j = 0; j < 4; ++j) {
          int k = i * 256 + lane * 4 + j;
          float hk = hv[i * 4 + j];
          f32x4 g4 = *(const f32x4*)(wgr + (size_t)k * 4);
#pragma unroll
          for (int q = 0; q < 4; ++q) ag[q] += hk * g4[q];
          const f32x4* wp = (const f32x4*)(wrt + (size_t)k * 16);
#pragma unroll
          for (int q = 0; q < 4; ++q) { f32x4 w4 = wp[q]; ar[q * 4 + 0] += hk * w4[0]; ar[q * 4 + 1] += hk * w4[1]; ar[q * 4 + 2] += hk * w4[2]; ar[q * 4 + 3] += hk * w4[3]; }
        }
#pragma unroll
      for (int g = 0; g < 4; ++g) ag[g] = wave_sum(ag[g]) + p.moe_b_group[p.layer * 4 + g];
#pragma unroll
      for (int g = 0; g < 16; ++g) ar[g] = wave_sum(ar[g]) + p.moe_b_router[p.layer * 16 + g];
      int gi = 0; float gm = ag[0];
#pragma unroll
      for (int g = 1; g < 4; ++g) if (ag[g] > gm) { gm = ag[g]; gi = g; }
      float gs = 0.f;
#pragma unroll
      for (int g = 0; g < 4; ++g) gs += expf(ag[g] - gm);
      float gprob = 1.0f / gs;
      float el[4];
#pragma unroll
      for (int e = 0; e < 4; ++e) {
        float v0 = ar[e], v1 = ar[4 + e], v2 = ar[8 + e], v3 = ar[12 + e];
        el[e] = (gi == 0) ? v0 : (gi == 1) ? v1 : (gi == 2) ? v2 : v3;
      }
      int i0 = 0; float m0 = el[0];
#pragma unroll
      for (int e = 1; e < 4; ++e) if (el[e] > m0) { m0 = el[e]; i0 = e; }
      int i1 = -1; float m1 = -3.0e38f;
#pragma unroll
      for (int e = 0; e < 4; ++e) if (e != i0 && el[e] > m1) { m1 = el[e]; i1 = e; }
      float e1 = expf(m1 - m0);
      float w0 = gprob / (1.0f + e1), w1 = gprob * e1 / (1.0f + e1);
      int lo = (i0 < i1) ? i0 : i1, hi = (i0 < i1) ? i1 : i0;
      float wlo = (i0 < i1) ? w0 : w1, whi = (i0 < i1) ? w1 : w0;
      int pair = (lo == 0) ? (hi - 1) : (lo == 1) ? (hi + 1) : 5;
      int cls = gi * 6 + pair;
      if (lane == 0) {
        int pos = atomicAdd(p.moe_cnt + (p.layer * 2) * NCLS + cls, 1);
        p.moe_list[(size_t)cls * T + pos] = r;
        p.moe_tw[(size_t)r * 2 + 0] = wlo;
        p.moe_tw[(size_t)r * 2 + 1] = whi;
      }
    }
  }
}

constexpr int LDT = 72;
constexpr int GEMM_STAGE = 128 * LDT;
constexpr int GEMM_SMEM = 2 * 2 * GEMM_STAGE * 2;

struct GemmRegs { u32x4 a[4], b[4]; };

template <class AF, class BF>
__device__ __forceinline__ void gemm_gload(GemmRegs& g, AF aptr, BF bptr, int k0) {
#pragma unroll
  for (int i = 0; i < 4; ++i) {
    int c = threadIdx.x + i * 256; int row = c >> 3, kc = (c & 7) * 8;
    g.a[i] = *(const u32x4*)(aptr(row, k0) + kc);
    g.b[i] = *(const u32x4*)(bptr(row, k0) + kc);
  }
}
__device__ __forceinline__ void gemm_sstore(const GemmRegs& g, bf16_t* sA, bf16_t* sB) {
#pragma unroll
  for (int i = 0; i < 4; ++i) {
    int c = threadIdx.x + i * 256; int row = c >> 3, kc = (c & 7) * 8;
    *(u32x4*)(sA + row * LDT + kc) = g.a[i];
    *(u32x4*)(sB + row * LDT + kc) = g.b[i];
  }
}
__device__ __forceinline__ void gemm_mma(f32x4 (&acc)[4][4], const bf16_t* sA, const bf16_t* sB, int wr, int wc) {
  const int lane = threadIdx.x & 63, fr = lane & 15, fq = lane >> 4;
#pragma unroll
  for (int ks = 0; ks < 2; ++ks) {
    bf16x8 af[4], bfr[4];
#pragma unroll
    for (int m = 0; m < 4; ++m) af[m] = *(const bf16x8*)(sA + (wr * 64 + m * 16 + fr) * LDT + ks * 32 + fq * 8);
#pragma unroll
    for (int n = 0; n < 4; ++n) bfr[n] = *(const bf16x8*)(sB + (wc * 64 + n * 16 + fr) * LDT + ks * 32 + fq * 8);
#pragma unroll
    for (int m = 0; m < 4; ++m)
#pragma unroll
      for (int n = 0; n < 4; ++n) acc[m][n] = MFMA16(bfr[n], af[m], acc[m][n]);
  }
}
template <class AF, class BF>
__device__ __forceinline__ void gemm_kloop(f32x4 (&acc)[4][4], AF aptr, BF bptr, int K, bf16_t* smem) {
  const int wid = threadIdx.x >> 6, wr = wid >> 1, wc = wid & 1;
  bf16_t* sA[2] = {smem, smem + 2 * GEMM_STAGE};
  bf16_t* sB[2] = {smem + GEMM_STAGE, smem + 3 * GEMM_STAGE};
  GemmRegs g;
  gemm_gload(g, aptr, bptr, 0);
  __syncthreads();
  gemm_sstore(g, sA[0], sB[0]);
  __syncthreads();
  const int nk = K / 64;
  for (int kt = 0; kt < nk; ++kt) {
    int cur = kt & 1;
    if (kt + 1 < nk) gemm_gload(g, aptr, bptr, (kt + 1) * 64);
    gemm_mma(acc, sA[cur], sB[cur], wr, wc);
    if (kt + 1 < nk) gemm_sstore(g, sA[cur ^ 1], sB[cur ^ 1]);
    __syncthreads();
  }
}
#define ACC_ZERO(acc) _Pragma("unroll") for (int m_ = 0; m_ < 4; ++m_) _Pragma("unroll") for (int n_ = 0; n_ < 4; ++n_) acc[m_][n_] = f32x4{0.f, 0.f, 0.f, 0.f}

__device__ void phase_inproj(const Params& p, char* smem_) {
  bf16_t* smem = (bf16_t*)smem_;
  const int lane = threadIdx.x & 63, wid = threadIdx.x >> 6, wr = wid >> 1, wc = wid & 1, fr = lane & 15, fq = lane >> 4;
  const int ntn = PW / 128;
  for (int t = blockIdx.x; t < MT * ntn; t += gridDim.x) {
    int tm = t / ntn, tn = t % ntn;
    const bf16_t* A = p.h + (size_t)tm * 128 * D;
    const bf16_t* B = p.WinT + (size_t)tn * 128 * D;
    f32x4 acc[4][4]; ACC_ZERO(acc);
    gemm_kloop(acc, [&](int row, int k0) { return A + (size_t)row * D + k0; },
               [&](int row, int k0) { return B + (size_t)row * D + k0; }, D, smem);
#pragma unroll
    for (int m = 0; m < 4; ++m)
#pragma unroll
      for (int n = 0; n < 4; ++n) {
        int row = tm * 128 + wr * 64 + m * 16 + fr, col = tn * 128 + wc * 64 + n * 16 + fq * 4;
        u32x2 o; o[0] = pack2(acc[m][n][0], acc[m][n][1]); o[1] = pack2(acc[m][n][2], acc[m][n][3]);
        *(u32x2*)(p.P + (size_t)row * PW + col) = o;
      }
  }
}


__device__ __forceinline__ int proc_tile(int dir, int idx) { return dir == 0 ? idx : (idx < CT ? CT - 1 - idx : NT - 1 - (idx - CT)); }

constexpr int LRU_LD = 264;
constexpr int LRU_SMEM = 128 * LRU_LD * 2;
template <bool FINAL, int dir>
__device__ __forceinline__ void lru_dir(const Params& p, const bf16_t* su, int b, int tile, int hh, int nt, f32x4 (&hsum)[8]) {
  const int lane = threadIdx.x & 63, fr = lane & 15, fq = lane >> 4;
  const int l = p.layer;
  const int c = hh * 64 + nt * 16 + fr;
        f32x4 ar[8], ai[8];
#pragma unroll
        for (int m = 0; m < 8; ++m) { ar[m] = f32x4{0.f, 0.f, 0.f, 0.f}; ai[m] = f32x4{0.f, 0.f, 0.f, 0.f}; }
        const float* wr_ = p.a_gate_w + ((((size_t)(l * 2 + dir) * 2 + 0) * NH + hh) * 64) * 64;
        const float* wi_ = p.a_gate_w + ((((size_t)(l * 2 + dir) * 2 + 1) * NH + hh) * 64) * 64;
#pragma unroll
        for (int ks = 0; ks < 2; ++ks) {
          bf16x8 br, bi;
#pragma unroll
          for (int e = 0; e < 8; ++e) {
            int k = ks * 32 + fq * 8 + e;
            br[e] = (short)f2bf(wr_[k * 64 + nt * 16 + fr]);
            bi[e] = (short)f2bf(wi_[k * 64 + nt * 16 + fr]);
          }
#pragma unroll
          for (int m = 0; m < 8; ++m) {
            bf16x8 af = *(const bf16x8*)(su + (m * 16 + fr) * LRU_LD + hh * 64 + ks * 32 + fq * 8);
            ar[m] = MFMA16(af, br, ar[m]);
            ai[m] = MFMA16(af, bi, ai[m]);
          }
        }
        const float b_r = p.a_gate_b[((l * 2 + dir) * 2 + 0) * MW + c], b_i = p.a_gate_b[((l * 2 + dir) * 2 + 1) * MW + c];
        const float lsl = 8.0f * logsigf_(p.a_lambda[(l * 2 + dir) * MW + c]);
#pragma unroll
        for (int m = 0; m < 8; ++m)
#pragma unroll
          for (int r = 0; r < 4; ++r) {
            int i = m * 16 + fq * 4 + r;
            float rg = sigmoidf_(ar[m][r] + b_r), ig = sigmoidf_(ai[m][r] + b_i);
            float la = lsl * rg;
            float uv = bf2f(su[i * LRU_LD + c]);
            ar[m][r] = expf(la);
            ai[m][r] = sqrtf(-expm1f(2.0f * la)) * ig * uv;
          }
        float carry = 0.f, atot = 1.f;
        if (FINAL) carry = p.lruC[(((size_t)b * 2 + dir) * NT + tile) * 256 + c];
#pragma unroll
        for (int mm = 0; mm < 8; ++mm) {
          const int m = dir ? 7 - mm : mm;
          float pa[4], hl[4];
          if (dir == 0) {
            pa[0] = ar[m][0]; hl[0] = ai[m][0];
#pragma unroll
            for (int r = 1; r < 4; ++r) { pa[r] = pa[r - 1] * ar[m][r]; hl[r] = ar[m][r] * hl[r - 1] + ai[m][r]; }
          } else {
            pa[3] = ar[m][3]; hl[3] = ai[m][3];
#pragma unroll
            for (int r = 2; r >= 0; --r) { pa[r] = pa[r + 1] * ar[m][r]; hl[r] = ar[m][r] * hl[r + 1] + ai[m][r]; }
          }
          const float gp = dir ? pa[0] : pa[3], gh = dir ? hl[0] : hl[3];
          float Pg[4], Hg[4];
#pragma unroll
          for (int g = 0; g < 4; ++g) { Pg[g] = __shfl(gp, fr + 16 * g, 64); Hg[g] = __shfl(gh, fr + 16 * g, 64); }
          float cin = carry;
#pragma unroll
          for (int gg = 0; gg < 4; ++gg) {
            const int g = dir ? 3 - gg : gg;
            bool before = dir ? (g > fq) : (g < fq);
            if (before) cin = Pg[g] * cin + Hg[g];
            carry = Pg[g] * carry + Hg[g];
            atot *= Pg[g];
          }
          if (FINAL) {
#pragma unroll
            for (int r = 0; r < 4; ++r) hsum[m][r] += hl[r] + pa[r] * cin;
          }
        }
        if (!FINAL && fq == 0) {
          float* S = p.lruS + ((((size_t)b * 2 + dir) * NT + tile) * 2) * 256;
          S[c] = atot; S[256 + c] = carry;
        }
      }
template <bool FINAL>
__device__ void phase_lru(const Params& p, char* smem_) {
  bf16_t* su = (bf16_t*)smem_;
  const int lane = threadIdx.x & 63, hh = threadIdx.x >> 6, fr = lane & 15, fq = lane >> 4;
  const int l = p.layer;
  for (int t = blockIdx.x; t < NB * NT; t += gridDim.x) {
    const int b = t / NT, tile = t % NT;
    const int s0 = tile * 128;
    const int seg_lo = (tile < CT) ? 0 : CTX, seg_hi = (tile < CT) ? CTX : TS;
    __syncthreads();
    {
      const int cc = threadIdx.x & 31, tg = threadIdx.x >> 5;
      const int c0 = cc * 8;
      float w[4][8], bias[8];
#pragma unroll
      for (int k = 0; k < 4; ++k)
#pragma unroll
        for (int j = 0; j < 8; ++j) w[k][j] = p.a_conv_w[(l * 4 + k) * MW + c0 + j];
#pragma unroll
      for (int j = 0; j < 8; ++j) bias[j] = p.a_conv_b[l * MW + c0 + j];
      float win[4][8];
      auto loadrow = [&](int s, float (&dst)[8]) {
        if (s >= seg_lo && s < seg_hi) {
          u32x4 v = *(const u32x4*)(p.P + ((size_t)b * TS + s) * PW + C_AX * 256 + c0);
#pragma unroll
          for (int j = 0; j < 4; ++j) { dst[2 * j] = u2f(v[j] << 16); dst[2 * j + 1] = u2f(v[j] & 0xFFFF0000u); }
        } else {
#pragma unroll
          for (int j = 0; j < 8; ++j) dst[j] = 0.f;
        }
      };
      const int i0 = tg * 16;
      loadrow(s0 + i0 - 2, win[0]); loadrow(s0 + i0 - 1, win[1]); loadrow(s0 + i0, win[2]);
#pragma unroll
      for (int i = 0; i < 16; ++i) {
        loadrow(s0 + i0 + i + 1, win[3]);
        float o[8];
#pragma unroll
        for (int j = 0; j < 8; ++j) o[j] = bias[j] + w[0][j] * win[0][j] + w[1][j] * win[1][j] + w[2][j] * win[2][j] + w[3][j] * win[3][j];
        u32x4 ov; ov[0] = pack2(o[0], o[1]); ov[1] = pack2(o[2], o[3]); ov[2] = pack2(o[4], o[5]); ov[3] = pack2(o[6], o[7]);
        *(u32x4*)(su + (i0 + i) * LRU_LD + c0) = ov;
#pragma unroll
        for (int j = 0; j < 8; ++j) { win[0][j] = win[1][j]; win[1][j] = win[2][j]; win[2][j] = win[3][j]; }
      }
    }
    __syncthreads();
#pragma unroll 1
    for (int nt = 0; nt < 4; ++nt) {
      const int c = hh * 64 + nt * 16 + fr;
      f32x4 hsum[8];
#pragma unroll
      for (int m = 0; m < 8; ++m) hsum[m] = f32x4{0.f, 0.f, 0.f, 0.f};
      lru_dir<FINAL, 0>(p, su, b, tile, hh, nt, hsum);
      lru_dir<FINAL, 1>(p, su, b, tile, hh, nt, hsum);
      if (FINAL) {
#pragma unroll
        for (int m = 0; m < 8; ++m)
#pragma unroll
          for (int r = 0; r < 4; ++r) {
            int i = m * 16 + fq * 4 + r;
            size_t row = (size_t)b * TS + s0 + i;
            float ag = bf2f(p.P[row * PW + C_AG * 256 + c]);
            p.y[row * (4 * MW) + 0 * MW + c] = f2bf(geluf_(ag) * hsum[m][r]);
          }
      }
    }
  }
}
__device__ void phase_lru_carry(const Params& p) {
  for (int i = blockIdx.x * blockDim.x + threadIdx.x; i < NB * 2 * 256; i += gridDim.x * blockDim.x) {
    int c = i & 255, dir = (i >> 8) & 1, b = i >> 9;
    float hcar = 0.f;
    for (int k = 0; k < NT; ++k) {
      int tile = proc_tile(dir, k);
      size_t base = ((size_t)b * 2 + dir) * NT + tile;
      p.lruC[base * 256 + c] = hcar;
      hcar = p.lruS[base * 512 + c] * hcar + p.lruS[base * 512 + 256 + c];
    }
  }
}


constexpr int LDV = 136;
__device__ __forceinline__ void unpack8(u32x4 v, float* dst) {
#pragma unroll
  for (int j = 0; j < 4; ++j) { dst[2 * j] = u2f(v[j] << 16); dst[2 * j + 1] = u2f(v[j] & 0xFFFF0000u); }
}
__device__ __forceinline__ void load_rope_row(const bf16_t* src, int s, int half, float scale, float* o) {
  unpack8(*(const u32x4*)(src + half * 16), o);
  unpack8(*(const u32x4*)(src + half * 16 + 8), o + 8);
  unpack8(*(const u32x4*)(src + 32 + half * 16), o + 16);
  unpack8(*(const u32x4*)(src + 32 + half * 16 + 8), o + 24);
  if (s >= CTX) {
    int tt = s - CTX;
    float pos = (float)(half ? (tt % GRIDW) : (tt / GRIDW));
#pragma unroll
    for (int i = 0; i < 16; ++i) {
      float inv = exp2f(-(float)i * (13.287712379549449f / 16.0f));
      float sn, cs; sincosf(pos * inv, &sn, &cs);
      float t1 = o[i], t2 = o[16 + i];
      o[i] = (t1 * cs - t2 * sn) * scale; o[16 + i] = (t1 * sn + t2 * cs) * scale;
    }
  } else {
#pragma unroll
    for (int i = 0; i < 32; ++i) o[i] *= scale;
  }
}
constexpr int RETA_SMEM = 3 * 64 * LDV * 2;
__device__ void phase_ret_a(const Params& p, char* smem_) {
  bf16_t* Vt = (bf16_t*)smem_; bf16_t* Ktf = Vt + 64 * LDV; bf16_t* Ktb = Ktf + 64 * LDV;
  const int lane = threadIdx.x & 63, wid = threadIdx.x >> 6, fr = lane & 15, fq = lane >> 4;
  const int l = p.layer;
  for (int t = blockIdx.x; t < NB * NH * NT; t += gridDim.x) {
    const int tile = t % NT, hh = (t / NT) % NH, b = t / (NT * NH);
    const float lgf = logsigf_(p.b_theta[(l * 2 + 0) * NH + hh]) * 1.4426950408889634f;
    const float lgb = logsigf_(p.b_theta[(l * 2 + 1) * NH + hh]) * 1.4426950408889634f;
    __syncthreads();
    {
      const int j = threadIdx.x >> 1, half = threadIdx.x & 1;
      const int s = tile * 128 + j;
      const bf16_t* prow = p.P + ((size_t)b * TS + s) * PW;
      float k[32];
      load_rope_row(prow + C_BK * 256 + hh * 64, s, half, 0.125f, k);
      const float wf = exp2f(lgf * (float)(127 - j)), wb = exp2f(lgb * (float)j);
#pragma unroll
      for (int i = 0; i < 32; ++i) {
        int d = (i < 16) ? (half * 16 + i) : (32 + half * 16 + i - 16);
        Ktf[d * LDV + j] = f2bf(k[i] * wf); Ktb[d * LDV + j] = f2bf(k[i] * wb);
      }
      float v[32];
      unpack8(*(const u32x4*)(prow + C_BV * 256 + hh * 64 + half * 32), v);
      unpack8(*(const u32x4*)(prow + C_BV * 256 + hh * 64 + half * 32 + 8), v + 8);
      unpack8(*(const u32x4*)(prow + C_BV * 256 + hh * 64 + half * 32 + 16), v + 16);
      unpack8(*(const u32x4*)(prow + C_BV * 256 + hh * 64 + half * 32 + 24), v + 24);
#pragma unroll
      for (int i = 0; i < 32; ++i) Vt[(half * 32 + i) * LDV + j] = f2bf(v[i]);
    }
    __syncthreads();
    f32x4 acc[2][4];
#pragma unroll
    for (int d = 0; d < 2; ++d)
#pragma unroll
      for (int n = 0; n < 4; ++n) acc[d][n] = f32x4{0.f, 0.f, 0.f, 0.f};
#pragma unroll
    for (int ks = 0; ks < 4; ++ks) {
      bf16x8 af = *(const bf16x8*)(Vt + (wid * 16 + fr) * LDV + ks * 32 + fq * 8);
#pragma unroll
      for (int n = 0; n < 4; ++n) {
        bf16x8 b0 = *(const bf16x8*)(Ktf + (n * 16 + fr) * LDV + ks * 32 + fq * 8);
        bf16x8 b1 = *(const bf16x8*)(Ktb + (n * 16 + fr) * LDV + ks * 32 + fq * 8);
        acc[0][n] = MFMA16(af, b0, acc[0][n]);
        acc[1][n] = MFMA16(af, b1, acc[1][n]);
      }
    }
#pragma unroll
    for (int d = 0; d < 2; ++d) {
      float* dst = p.retKV + ((((size_t)b * NH + hh) * 2 + d) * NT + tile) * 4096;
#pragma unroll
      for (int n = 0; n < 4; ++n)
#pragma unroll
        for (int r = 0; r < 4; ++r) dst[(wid * 16 + fq * 4 + r) * 64 + n * 16 + fr] = acc[d][n][r];
    }
  }
}
__device__ void phase_ret_b(const Params& p) {
  const int l = p.layer;
  for (int i = blockIdx.x * blockDim.x + threadIdx.x; i < NB * NH * 2 * 4096; i += gridDim.x * blockDim.x) {
    int el = i & 4095, dir = (i >> 12) & 1, hh = (i >> 13) % NH, b = i / (8192 * NH);
    float g = expf(128.0f * logsigf_(p.b_theta[(l * 2 + dir) * NH + hh]));
    size_t base = (((size_t)b * NH + hh) * 2 + dir) * NT;
    float S = 0.f;
    for (int k = 0; k < NT; ++k) {
      int tile = proc_tile(dir, k);
      p.retSp[(base + tile) * 4096 + el] = f2bf(S);
      S = g * S + p.retKV[(base + tile) * 4096 + el];
    }
  }
}
constexpr int RETC_SMEM = (2 * 128 * LDT + 64 * LDV + 128 * LDV + 2 * 64 * LDT) * 2;
__device__ void phase_ret_c(const Params& p, char* smem_) {
  bf16_t* Qs = (bf16_t*)smem_; bf16_t* Ks = Qs + 128 * LDT; bf16_t* Vt = Ks + 128 * LDT; bf16_t* Ss = Vt + 64 * LDV;
  bf16_t* Spf = Ss + 128 * LDV; bf16_t* Spb = Spf + 64 * LDT;
  const int lane = threadIdx.x & 63, wid = threadIdx.x >> 6, fr = lane & 15, fq = lane >> 4;
  const int l = p.layer;
  for (int t = blockIdx.x; t < NB * NH * NT; t += gridDim.x) {
    const int tile = t % NT, hh = (t / NT) % NH, b = t / (NT * NH);
    const float lgf = logsigf_(p.b_theta[(l * 2 + 0) * NH + hh]) * 1.4426950408889634f;
    const float lgb = logsigf_(p.b_theta[(l * 2 + 1) * NH + hh]) * 1.4426950408889634f;
    __syncthreads();
    {
      const int j = threadIdx.x >> 1, half = threadIdx.x & 1;
      const int s = tile * 128 + j;
      const bf16_t* prow = p.P + ((size_t)b * TS + s) * PW;
      float k[32];
      load_rope_row(prow + C_BQ * 256 + hh * 64, s, half, 1.0f, k);
#pragma unroll
      for (int c = 0; c < 4; ++c) {
        u32x4 v; v[0] = pack2(k[c * 8 + 0], k[c * 8 + 1]); v[1] = pack2(k[c * 8 + 2], k[c * 8 + 3]); v[2] = pack2(k[c * 8 + 4], k[c * 8 + 5]); v[3] = pack2(k[c * 8 + 6], k[c * 8 + 7]);
        int d0 = (c < 2) ? (half * 16 + c * 8) : (32 + half * 16 + (c - 2) * 8);
        *(u32x4*)(Qs + j * LDT + d0) = v;
      }
      load_rope_row(prow + C_BK * 256 + hh * 64, s, half, 0.125f, k);
#pragma unroll
      for (int c = 0; c < 4; ++c) {
        u32x4 v; v[0] = pack2(k[c * 8 + 0], k[c * 8 + 1]); v[1] = pack2(k[c * 8 + 2], k[c * 8 + 3]); v[2] = pack2(k[c * 8 + 4], k[c * 8 + 5]); v[3] = pack2(k[c * 8 + 6], k[c * 8 + 7]);
        int d0 = (c < 2) ? (half * 16 + c * 8) : (32 + half * 16 + (c - 2) * 8);
        *(u32x4*)(Ks + j * LDT + d0) = v;
      }
#pragma unroll
      for (int c = 0; c < 4; ++c) {
        u32x4 v = *(const u32x4*)(prow + C_BV * 256 + hh * 64 + half * 32 + c * 8);
#pragma unroll
        for (int q = 0; q < 4; ++q) {
          Vt[(half * 32 + c * 8 + 2 * q) * LDV + j] = (bf16_t)(v[q] & 0xFFFFu);
          Vt[(half * 32 + c * 8 + 2 * q + 1) * LDV + j] = (bf16_t)(v[q] >> 16);
        }
      }
      const bf16_t* spf = p.retSp + ((((size_t)b * NH + hh) * 2 + 0) * NT + tile) * 4096;
      const bf16_t* spb = p.retSp + ((((size_t)b * NH + hh) * 2 + 1) * NT + tile) * 4096;
#pragma unroll
      for (int i = 0; i < 2; ++i) {
        int c = threadIdx.x + i * 256; int e = c >> 3, d0 = (c & 7) * 8;
        *(u32x4*)(Spf + e * LDT + d0) = *(const u32x4*)(spf + e * 64 + d0);
        *(u32x4*)(Spb + e * LDT + d0) = *(const u32x4*)(spb + e * 64 + d0);
      }
    }
    __syncthreads();
    {
      f32x4 sc[2][8];
#pragma unroll
      for (int mi = 0; mi < 2; ++mi)
#pragma unroll
        for (int nj = 0; nj < 8; ++nj) sc[mi][nj] = f32x4{0.f, 0.f, 0.f, 0.f};
#pragma unroll
      for (int ks = 0; ks < 2; ++ks) {
        bf16x8 qf[2];
#pragma unroll
        for (int mi = 0; mi < 2; ++mi) qf[mi] = *(const bf16x8*)(Qs + (wid * 32 + mi * 16 + fr) * LDT + ks * 32 + fq * 8);
#pragma unroll
        for (int nj = 0; nj < 8; ++nj) {
          bf16x8 kf = *(const bf16x8*)(Ks + (nj * 16 + fr) * LDT + ks * 32 + fq * 8);
#pragma unroll
          for (int mi = 0; mi < 2; ++mi) sc[mi][nj] = MFMA16(kf, qf[mi], sc[mi][nj]);
        }
      }
#pragma unroll
      for (int mi = 0; mi < 2; ++mi) {
        const int i = wid * 32 + mi * 16 + fr;
#pragma unroll
        for (int nj = 0; nj < 8; ++nj) {
          float v[4];
#pragma unroll
          for (int r = 0; r < 4; ++r) {
            int j = nj * 16 + fq * 4 + r;
            float dec = (i >= j) ? exp2f(lgf * (float)(i - j)) : exp2f(lgb * (float)(j - i));
            v[r] = sc[mi][nj][r] * dec;
          }
          u32x2 o; o[0] = pack2(v[0], v[1]); o[1] = pack2(v[2], v[3]);
          *(u32x2*)(Ss + i * LDV + nj * 16 + fq * 4) = o;
        }
      }
    }
    __syncthreads();
    f32x4 ao[2][4], af_[2][4], ab_[2][4];
#pragma unroll
    for (int mi = 0; mi < 2; ++mi)
#pragma unroll
      for (int n = 0; n < 4; ++n) { ao[mi][n] = f32x4{0.f, 0.f, 0.f, 0.f}; af_[mi][n] = ao[mi][n]; ab_[mi][n] = ao[mi][n]; }
#pragma unroll
    for (int ks = 0; ks < 4; ++ks) {
      bf16x8 sf[2];
#pragma unroll
      for (int mi = 0; mi < 2; ++mi) sf[mi] = *(const bf16x8*)(Ss + (wid * 32 + mi * 16 + fr) * LDV + ks * 32 + fq * 8);
#pragma unroll
      for (int n = 0; n < 4; ++n) {
        bf16x8 vf = *(const bf16x8*)(Vt + (n * 16 + fr) * LDV + ks * 32 + fq * 8);
#pragma unroll
        for (int mi = 0; mi < 2; ++mi) ao[mi][n] = MFMA16(vf, sf[mi], ao[mi][n]);
      }
    }
#pragma unroll
    for (int ks = 0; ks < 2; ++ks) {
      bf16x8 qf[2];
#pragma unroll
      for (int mi = 0; mi < 2; ++mi) qf[mi] = *(const bf16x8*)(Qs + (wid * 32 + mi * 16 + fr) * LDT + ks * 32 + fq * 8);
#pragma unroll
      for (int n = 0; n < 4; ++n) {
        bf16x8 s0 = *(const bf16x8*)(Spf + (n * 16 + fr) * LDT + ks * 32 + fq * 8);
        bf16x8 s1 = *(const bf16x8*)(Spb + (n * 16 + fr) * LDT + ks * 32 + fq * 8);
#pragma unroll
        for (int mi = 0; mi < 2; ++mi) { af_[mi][n] = MFMA16(s0, qf[mi], af_[mi][n]); ab_[mi][n] = MFMA16(s1, qf[mi], ab_[mi][n]); }
      }
    }
#pragma unroll
    for (int mi = 0; mi < 2; ++mi) {
      const int i = wid * 32 + mi * 16 + fr;
      const float sfw = exp2f(lgf * (float)(i + 1)), sbw = exp2f(lgb * (float)(128 - i));
      float o[4][4]; float sum = 0.f;
#pragma unroll
      for (int n = 0; n < 4; ++n)
#pragma unroll
        for (int r = 0; r < 4; ++r) { o[n][r] = ao[mi][n][r] + sfw * af_[mi][n][r] + sbw * ab_[mi][n][r]; sum += o[n][r]; }
      sum += __shfl_xor(sum, 16, 64); sum += __shfl_xor(sum, 32, 64);
      const float mean = sum * (1.0f / 64.0f);
      float var = 0.f;
#pragma unroll
      for (int n = 0; n < 4; ++n)
#pragma unroll
        for (int r = 0; r < 4; ++r) { o[n][r] -= mean; var += o[n][r] * o[n][r]; }
      var += __shfl_xor(var, 16, 64); var += __shfl_xor(var, 32, 64);
      const float rs = rsqrtf(var * (1.0f / 64.0f) + EPS);
      const size_t row = (size_t)b * TS + tile * 128 + i;
#pragma unroll
      for (int n = 0; n < 4; ++n) {
        int e = n * 16 + fq * 4;
        u32x2 gv = *(const u32x2*)(p.P + row * PW + C_BG * 256 + hh * 64 + e);
        float g0 = u2f(gv[0] << 16), g1 = u2f(gv[0] & 0xFFFF0000u), g2 = u2f(gv[1] << 16), g3 = u2f(gv[1] & 0xFFFF0000u);
        u32x2 ov; ov[0] = pack2(o[n][0] * rs * siluf_(g0), o[n][1] * rs * siluf_(g1)); ov[1] = pack2(o[n][2] * rs * siluf_(g2), o[n][3] * rs * siluf_(g3));
        *(u32x2*)(p.y + row * (4 * MW) + 1 * MW + hh * 64 + e) = ov;
      }
    }
  }
}


__device__ __forceinline__ void conv_silu_row32(const Params& p, int b, int s, int seg_lo, int seg_hi, int cb, int cw, int hh, int half, float scale, float* o) {
  const int l = p.layer;
  const int ch0 = hh * 64 + half * 32;
#pragma unroll
  for (int i = 0; i < 32; ++i) o[i] = p.c_conv_b[l * 512 + cw + ch0 + i];
#pragma unroll
  for (int k = 0; k < 4; ++k) {
    int sk = s + k - 2;
    if (sk >= seg_lo && sk < seg_hi) {
      const bf16_t* src = p.P + ((size_t)b * TS + sk) * PW + cb * 256 + ch0;
      const float* w = p.c_conv_w + (size_t)(l * 4 + k) * 512 + cw + ch0;
#pragma unroll
      for (int c = 0; c < 4; ++c) {
        float v[8]; unpack8(*(const u32x4*)(src + c * 8), v);
#pragma unroll
        for (int j = 0; j < 8; ++j) o[c * 8 + j] += w[c * 8 + j] * v[j];
      }
    }
  }
#pragma unroll
  for (int i = 0; i < 32; ++i) o[i] = siluf_(o[i]) * scale;
}
__device__ __forceinline__ void mls_gates(const Params& p, int b, int tile, int hh, float* cumf, float* cumb, float* lif, float* lib) {
  const int tdx = threadIdx.x;
  {
    int i = tdx & 127; const float* g = p.cg + ((size_t)b * TS + tile * 128 + i) * 16;
    if (tdx < 128) { lif[i] = g[0 * 4 + hh]; cumf[i] = logsigf_(g[1 * 4 + hh]); }
    else { lib[i] = g[2 * 4 + hh]; cumb[i] = logsigf_(g[3 * 4 + hh]); }
  }
  __syncthreads();
  for (int off = 1; off < 128; off <<= 1) {
    float v = 0.f; int i = tdx & 127;
    if (tdx < 128) { if (i >= off) v = cumf[i - off]; } else { if (i + off < 128) v = cumb[i + off]; }
    __syncthreads();
    if (tdx < 128) cumf[i] += v; else cumb[i] += v;
    __syncthreads();
  }
}
constexpr int MLSA_SMEM = (80 * LDV + 2 * 64 * LDV) * 2 + 4 * 128 * 4;
__device__ void phase_mls_a(const Params& p, char* smem_) {
  bf16_t* Vt = (bf16_t*)smem_; bf16_t* Ktf = Vt + 80 * LDV; bf16_t* Ktb = Ktf + 64 * LDV;
  float* cumf = (float*)(Ktb + 64 * LDV); float* cumb = cumf + 128; float* lif = cumb + 128; float* lib = lif + 128;
  const int lane = threadIdx.x & 63, wid = threadIdx.x >> 6, fr = lane & 15, fq = lane >> 4;
  for (int t = blockIdx.x; t < NB * NH * NT; t += gridDim.x) {
    const int tile = t % NT, hh = (t / NT) % NH, b = t / (NT * NH);
    const int seg_lo = (tile < CT) ? 0 : CTX, seg_hi = (tile < CT) ? CTX : TS;
    __syncthreads();
    mls_gates(p, b, tile, hh, cumf, cumb, lif, lib);
    {
      const int j = threadIdx.x >> 1, half = threadIdx.x & 1;
      const int s = tile * 128 + j;
      float k[32];
      conv_silu_row32(p, b, s, seg_lo, seg_hi, C_CK, 256, hh, half, 0.125f, k);
      const float wf = expf(cumf[127] - cumf[j] + lif[j]), wb = expf(cumb[0] - cumb[j] + lib[j]);
#pragma unroll
      for (int i = 0; i < 32; ++i) { Ktf[(half * 32 + i) * LDV + j] = f2bf(k[i] * wf); Ktb[(half * 32 + i) * LDV + j] = f2bf(k[i] * wb); }
      const bf16_t* prow = p.P + ((size_t)b * TS + s) * PW + C_CV * 256 + hh * 64 + half * 32;
#pragma unroll
      for (int c = 0; c < 4; ++c) {
        u32x4 v = *(const u32x4*)(prow + c * 8);
#pragma unroll
        for (int q = 0; q < 4; ++q) {
          Vt[(half * 32 + c * 8 + 2 * q) * LDV + j] = (bf16_t)(v[q] & 0xFFFFu);
          Vt[(half * 32 + c * 8 + 2 * q + 1) * LDV + j] = (bf16_t)(v[q] >> 16);
        }
      }
#pragma unroll
      for (int e = 0; e < 8; ++e) Vt[(64 + half * 8 + e) * LDV + j] = (half == 0 && e == 0) ? (bf16_t)0x3F80 : (bf16_t)0;
    }
    __syncthreads();
    for (int mt = wid; mt < 5; mt += 4) {
      f32x4 acc[2][4];
#pragma unroll
      for (int d = 0; d < 2; ++d)
#pragma unroll
        for (int n = 0; n < 4; ++n) acc[d][n] = f32x4{0.f, 0.f, 0.f, 0.f};
#pragma unroll
      for (int ks = 0; ks < 4; ++ks) {
        bf16x8 af = *(const bf16x8*)(Vt + (mt * 16 + fr) * LDV + ks * 32 + fq * 8);
#pragma unroll
        for (int n = 0; n < 4; ++n) {
          bf16x8 b0 = *(const bf16x8*)(Ktf + (n * 16 + fr) * LDV + ks * 32 + fq * 8);
          bf16x8 b1 = *(const bf16x8*)(Ktb + (n * 16 + fr) * LDV + ks * 32 + fq * 8);
          acc[0][n] = MFMA16(af, b0, acc[0][n]);
          acc[1][n] = MFMA16(af, b1, acc[1][n]);
        }
      }
#pragma unroll
      for (int d = 0; d < 2; ++d) {
        float* dst = p.mlC + ((((size_t)b * NH + hh) * 2 + d) * NT + tile) * (80 * 64);
#pragma unroll
        for (int n = 0; n < 4; ++n)
#pragma unroll
          for (int r = 0; r < 4; ++r) dst[(mt * 16 + fq * 4 + r) * 64 + n * 16 + fr] = acc[d][n][r];
      }
    }
    if (threadIdx.x < 2) p.mlCe[(((size_t)b * NH + hh) * 2 + threadIdx.x) * NT + tile] = threadIdx.x ? cumb[0] : cumf[127];
  }
}
__device__ void phase_mls_b(const Params& p) {
  const int NE = 80 * 64;
  for (int i = blockIdx.x * blockDim.x + threadIdx.x; i < NB * NH * 2 * NE; i += gridDim.x * blockDim.x) {
    int el = i % NE, chain = i / NE;
    int dir = chain & 1;
    size_t base = (size_t)chain * NT;
    float S = 0.f;
    for (int k = 0; k < NT; ++k) {
      int tile = proc_tile(dir, k);
      p.mlSp[(base + tile) * NE + el] = f2bf(S);
      S = expf(p.mlCe[base + tile]) * S + p.mlC[(base + tile) * NE + el];
    }
  }
}
constexpr int MLSC_SMEM = (2 * 128 * LDT + 80 * LDV + 128 * LDV + 2 * 80 * LDT) * 2 + 4 * 128 * 4;
__device__ void phase_mls_c(const Params& p, char* smem_) {
  bf16_t* Qs = (bf16_t*)smem_; bf16_t* Ks = Qs + 128 * LDT; bf16_t* Vt = Ks + 128 * LDT; bf16_t* Ss = Vt + 80 * LDV;
  bf16_t* Cpf = Ss + 128 * LDV; bf16_t* Cpb = Cpf + 80 * LDT;
  float* cumf = (float*)(Cpb + 80 * LDT); float* cumb = cumf + 128; float* lif = cumb + 128; float* lib = lif + 128;
  const int lane = threadIdx.x & 63, wid = threadIdx.x >> 6, fr = lane & 15, fq = lane >> 4;
  for (int t = blockIdx.x; t < NB * NH * NT; t += gridDim.x) {
    const int tile = t % NT, hh = (t / NT) % NH, b = t / (NT * NH);
    const int seg_lo = (tile < CT) ? 0 : CTX, seg_hi = (tile < CT) ? CTX : TS;
    __syncthreads();
    mls_gates(p, b, tile, hh, cumf, cumb, lif, lib);
    {
      const int j = threadIdx.x >> 1, half = threadIdx.x & 1;
      const int s = tile * 128 + j;
      float k[32];
      conv_silu_row32(p, b, s, seg_lo, seg_hi, C_CQ, 0, hh, half, 1.0f, k);
#pragma unroll
      for (int c = 0; c < 4; ++c) {
        u32x4 v; v[0] = pack2(k[c * 8 + 0], k[c * 8 + 1]); v[1] = pack2(k[c * 8 + 2], k[c * 8 + 3]); v[2] = pack2(k[c * 8 + 4], k[c * 8 + 5]); v[3] = pack2(k[c * 8 + 6], k[c * 8 + 7]);
        *(u32x4*)(Qs + j * LDT + half * 32 + c * 8) = v;
      }
      conv_silu_row32(p, b, s, seg_lo, seg_hi, C_CK, 256, hh, half, 0.125f, k);
#pragma unroll
      for (int c = 0; c < 4; ++c) {
        u32x4 v; v[0] = pack2(k[c * 8 + 0], k[c * 8 + 1]); v[1] = pack2(k[c * 8 + 2], k[c * 8 + 3]); v[2] = pack2(k[c * 8 + 4], k[c * 8 + 5]); v[3] = pack2(k[c * 8 + 6], k[c * 8 + 7]);
        *(u32x4*)(Ks + j * LDT + half * 32 + c * 8) = v;
      }
      const bf16_t* prow = p.P + ((size_t)b * TS + s) * PW + C_CV * 256 + hh * 64 + half * 32;
#pragma unroll
      for (int c = 0; c < 4; ++c) {
        u32x4 v = *(const u32x4*)(prow + c * 8);
#pragma unroll
        for (int q = 0; q < 4; ++q) {
          Vt[(half * 32 + c * 8 + 2 * q) * LDV + j] = (bf16_t)(v[q] & 0xFFFFu);
          Vt[(half * 32 + c * 8 + 2 * q + 1) * LDV + j] = (bf16_t)(v[q] >> 16);
        }
      }
#pragma unroll
      for (int e = 0; e < 8; ++e) Vt[(64 + half * 8 + e) * LDV + j] = (half == 0 && e == 0) ? (bf16_t)0x3F80 : (bf16_t)0;
      const bf16_t* spf = p.mlSp + ((((size_t)b * NH + hh) * 2 + 0) * NT + tile) * (80 * 64);
      const bf16_t* spb = p.mlSp + ((((size_t)b * NH + hh) * 2 + 1) * NT + tile) * (80 * 64);
      for (int c = threadIdx.x; c < 80 * 8; c += 256) {
        int e = c >> 3, d0 = (c & 7) * 8;
        *(u32x4*)(Cpf + e * LDT + d0) = *(const u32x4*)(spf + e * 64 + d0);
        *(u32x4*)(Cpb + e * LDT + d0) = *(const u32x4*)(spb + e * 64 + d0);
      }
    }
    __syncthreads();
    f32x4 sc[2][8];
#pragma unroll
    for (int mi = 0; mi < 2; ++mi)
#pragma unroll
      for (int nj = 0; nj < 8; ++nj) sc[mi][nj] = f32x4{0.f, 0.f, 0.f, 0.f};
#pragma unroll
    for (int ks = 0; ks < 2; ++ks) {
      bf16x8 qf[2];
#pragma unroll
      for (int mi = 0; mi < 2; ++mi) qf[mi] = *(const bf16x8*)(Qs + (wid * 32 + mi * 16 + fr) * LDT + ks * 32 + fq * 8);
#pragma unroll
      for (int nj = 0; nj < 8; ++nj) {
        bf16x8 kf = *(const bf16x8*)(Ks + (nj * 16 + fr) * LDT + ks * 32 + fq * 8);
#pragma unroll
        for (int mi = 0; mi < 2; ++mi) sc[mi][nj] = MFMA16(kf, qf[mi], sc[mi][nj]);
      }
    }
    float hsum[2][4][4];
#pragma unroll
    for (int dir = 0; dir < 2; ++dir) {
      const float* cum = dir ? cumb : cumf; const float* li = dir ? lib : lif; const bf16_t* Cp = dir ? Cpb : Cpf;
      if (dir) __syncthreads();
#pragma unroll
      for (int mi = 0; mi < 2; ++mi) {
        const int i = wid * 32 + mi * 16 + fr;
        const float ci = cum[i];
#pragma unroll
        for (int nj = 0; nj < 8; ++nj) {
          float v[4];
#pragma unroll
          for (int r = 0; r < 4; ++r) {
            int j = nj * 16 + fq * 4 + r;
            bool on = dir ? (j >= i) : (j <= i);
            v[r] = on ? sc[mi][nj][r] * expf(ci - cum[j] + li[j]) : 0.f;
          }
          u32x2 o; o[0] = pack2(v[0], v[1]); o[1] = pack2(v[2], v[3]);
          *(u32x2*)(Ss + i * LDV + nj * 16 + fq * 4) = o;
        }
      }
      __syncthreads();
      f32x4 an[2][5], ai[2][5];
#pragma unroll
      for (int mi = 0; mi < 2; ++mi)
#pragma unroll
        for (int n = 0; n < 5; ++n) { an[mi][n] = f32x4{0.f, 0.f, 0.f, 0.f}; ai[mi][n] = an[mi][n]; }
#pragma unroll
      for (int ks = 0; ks < 4; ++ks) {
        bf16x8 sf[2];
#pragma unroll
        for (int mi = 0; mi < 2; ++mi) sf[mi] = *(const bf16x8*)(Ss + (wid * 32 + mi * 16 + fr) * LDV + ks * 32 + fq * 8);
#pragma unroll
        for (int n = 0; n < 5; ++n) {
          bf16x8 vf = *(const bf16x8*)(Vt + (n * 16 + fr) * LDV + ks * 32 + fq * 8);
#pragma unroll
          for (int mi = 0; mi < 2; ++mi) an[mi][n] = MFMA16(vf, sf[mi], an[mi][n]);
        }
      }
#pragma unroll
      for (int ks = 0; ks < 2; ++ks) {
        bf16x8 qf[2];
#pragma unroll
        for (int mi = 0; mi < 2; ++mi) qf[mi] = *(const bf16x8*)(Qs + (wid * 32 + mi * 16 + fr) * LDT + ks * 32 + fq * 8);
#pragma unroll
        for (int n = 0; n < 5; ++n) {
          bf16x8 cf = *(const bf16x8*)(Cp + (n * 16 + fr) * LDT + ks * 32 + fq * 8);
#pragma unroll
          for (int mi = 0; mi < 2; ++mi) ai[mi][n] = MFMA16(cf, qf[mi], ai[mi][n]);
        }
      }
#pragma unroll
      for (int mi = 0; mi < 2; ++mi) {
        const int i = wid * 32 + mi * 16 + fr;
        const float ec = expf(cum[i]);
        float den = an[mi][4][0] + ec * ai[mi][4][0];
        den = __shfl(den, fr, 64);
        const float inv = 1.0f / fmaxf(fabsf(den), 1.0f);
#pragma unroll
        for (int n = 0; n < 4; ++n)
#pragma unroll
          for (int r = 0; r < 4; ++r) {
            float hv = (an[mi][n][r] + ec * ai[mi][n][r]) * inv;
            if (dir == 0) hsum[mi][n][r] = hv; else hsum[mi][n][r] += hv;
          }
      }
    }
#pragma unroll
    for (int mi = 0; mi < 2; ++mi) {
      const int i = wid * 32 + mi * 16 + fr;
      float sum = 0.f;
#pragma unroll
      for (int n = 0; n < 4; ++n)
#pragma unroll
        for (int r = 0; r < 4; ++r) sum += hsum[mi][n][r];
      sum += __shfl_xor(sum, 16, 64); sum += __shfl_xor(sum, 32, 64);
      const float mean = sum * (1.0f / 64.0f);
      float var = 0.f;
#pragma unroll
      for (int n = 0; n < 4; ++n)
#pragma unroll
        for (int r = 0; r < 4; ++r) { hsum[mi][n][r] -= mean; var += hsum[mi][n][r] * hsum[mi][n][r]; }
      var += __shfl_xor(var, 16, 64); var += __shfl_xor(var, 32, 64);
      const float rs = rsqrtf(var * (1.0f / 64.0f) + EPS);
      const size_t row = (size_t)b * TS + tile * 128 + i;
#pragma unroll
      for (int n = 0; n < 4; ++n) {
        int e = n * 16 + fq * 4;
        u32x2 gv = *(const u32x2*)(p.P + row * PW + C_CO * 256 + hh * 64 + e);
        float g0 = u2f(gv[0] << 16), g1 = u2f(gv[0] & 0xFFFF0000u), g2 = u2f(gv[1] << 16), g3 = u2f(gv[1] & 0xFFFF0000u);
        u32x2 ov; ov[0] = pack2(hsum[mi][n][0] * rs * sigmoidf_(g0), hsum[mi][n][1] * rs * sigmoidf_(g1));
        ov[1] = pack2(hsum[mi][n][2] * rs * sigmoidf_(g2), hsum[mi][n][3] * rs * sigmoidf_(g3));
        *(u32x2*)(p.y + row * (4 * MW) + 2 * MW + hh * 64 + e) = ov;
      }
    }
  }
}


constexpr int GL_LD = 65;
constexpr int GLA_SMEM = (128 * GL_LD + 7 * 16 * GL_LD + 16 * 17 + 4 * 16 * 64 + 128) * 4;
template <bool FINAL>
__device__ void phase_gla(const Params& p, char* smem_) {
  float* oacc = (float*)smem_; float* lgf = oacc + 128 * GL_LD; float* cum = lgf + 16 * GL_LD; float* kk = cum + 16 * GL_LD;
  float* qq = kk + 16 * GL_LD; float* vv = qq + 16 * GL_LD; float* qe = vv + 16 * GL_LD; float* kd = qe + 16 * GL_LD;
  float* scs = kd + 16 * GL_LD; float* part = scs + 16 * 17; float* Ec = part + 4 * 16 * 64; float* Et = Ec + 64;
  const int tdx = threadIdx.x;
  const int l = p.layer;
  for (int t = blockIdx.x; t < NB * NH * NT; t += gridDim.x) {
    const int tile = t % NT, hh = (t / NT) % NH, b = t / (NT * NH);
    const int pi = tdx >> 4, pc4 = (tdx & 15) * 4;
    float lb4[4];
#pragma unroll
    for (int j = 0; j < 4; ++j) {
      int c = hh * 64 + pc4 + j;
      float mx = -3.0e38f;
      for (int q = 0; q < DEPTH; ++q) mx = fmaxf(mx, p.d_lb[q * MW + c]);
      float den = 0.f, num = 0.f;
      for (int q = 0; q < DEPTH; ++q) { float e = expf(p.d_lb[q * MW + c] - mx); den += e; if (q >= 1 && q <= l) num += e; }
      lb4[j] = num / den;
    }
    __syncthreads();
    for (int dir = 0; dir < 2; ++dir) {
      float S[16];
      const int se = tdx & 63, scq = tdx >> 6;
      const size_t chain = (((size_t)b * NH + hh) * 2 + dir) * NT + tile;
#pragma unroll
      for (int m = 0; m < 16; ++m) S[m] = FINAL ? p.glSp[chain * 4096 + (scq * 16 + m) * 64 + se] : 0.f;
      if (tdx < 64) Et[tdx] = 1.0f;
      u32x2 rq, rf, rv;
      auto gload = [&](int k) {
        int sc_ = dir ? 7 - k : k; int i = dir ? 15 - pi : pi;
        const bf16_t* prow = p.P + ((size_t)b * TS + tile * 128 + sc_ * 16 + i) * PW + hh * 64 + pc4;
        rq = *(const u32x2*)(prow + C_DQ * 256); rf = *(const u32x2*)(prow + (dir ? C_DFB : C_DFF) * 256); rv = *(const u32x2*)(prow + C_DI * 256);
      };
      gload(0);
      for (int k = 0; k < 8; ++k) {
        const int sc_ = dir ? 7 - k : k;
        {
          float zq[4] = {u2f(rq[0] << 16), u2f(rq[0] & 0xFFFF0000u), u2f(rq[1] << 16), u2f(rq[1] & 0xFFFF0000u)};
          float zf[4] = {u2f(rf[0] << 16), u2f(rf[0] & 0xFFFF0000u), u2f(rf[1] << 16), u2f(rf[1] & 0xFFFF0000u)};
          float zv[4] = {u2f(rv[0] << 16), u2f(rv[0] & 0xFFFF0000u), u2f(rv[1] << 16), u2f(rv[1] & 0xFFFF0000u)};
#pragma unroll
          for (int j = 0; j < 4; ++j) {
            float f = lb4[j] + (1.0f - lb4[j]) * sigmoidf_(zf[j]);
            lgf[pi * GL_LD + pc4 + j] = logf(f);
            kk[pi * GL_LD + pc4 + j] = 1.0f - f;
            qq[pi * GL_LD + pc4 + j] = siluf_(zq[j]);
            vv[pi * GL_LD + pc4 + j] = zv[j];
          }
        }
        if (k + 1 < 8) gload(k + 1);
        __syncthreads();
        {
          float cs[4] = {0.f, 0.f, 0.f, 0.f}, ce[4] = {0.f, 0.f, 0.f, 0.f};
          for (int q = 0; q < 16; ++q)
#pragma unroll
            for (int j = 0; j < 4; ++j) { float v = lgf[q * GL_LD + pc4 + j]; ce[j] += v; if (q <= pi) cs[j] += v; }
#pragma unroll
          for (int j = 0; j < 4; ++j) {
            cum[pi * GL_LD + pc4 + j] = cs[j];
            qe[pi * GL_LD + pc4 + j] = qq[pi * GL_LD + pc4 + j] * expf(cs[j]);
            kd[pi * GL_LD + pc4 + j] = kk[pi * GL_LD + pc4 + j] * expf(ce[j] - cs[j]);
            if (pi == 0) { float e = expf(ce[j]); Ec[pc4 + j] = e; Et[pc4 + j] *= e; }
          }
        }
        __syncthreads();
        if (FINAL) {
          const int i = tdx >> 4, j = tdx & 15;
          float s = 0.f;
          if (j <= i) {
            for (int c = 0; c < 64; ++c) s += qq[i * GL_LD + c] * kk[j * GL_LD + c] * expf(cum[i * GL_LD + c] - cum[j * GL_LD + c]);
          }
          scs[i * 17 + j] = s;
#pragma unroll
          for (int i2 = 0; i2 < 16; ++i2) {
            float a = 0.f;
#pragma unroll
            for (int m = 0; m < 16; ++m) a += qe[i2 * GL_LD + scq * 16 + m] * S[m];
            part[(scq * 16 + i2) * 64 + se] = a;
          }
        }
        {
          float vj[16];
#pragma unroll
          for (int j = 0; j < 16; ++j) vj[j] = vv[j * GL_LD + se];
#pragma unroll
          for (int m = 0; m < 16; ++m) {
            float a = Ec[scq * 16 + m] * S[m];
#pragma unroll
            for (int j = 0; j < 16; ++j) a += kd[j * GL_LD + scq * 16 + m] * vj[j];
            S[m] = a;
          }
        }
        __syncthreads();
        if (FINAL) {
#pragma unroll
          for (int q = 0; q < 4; ++q) {
            const int i = scq * 4 + q;
            float o = part[(0 * 16 + i) * 64 + se] + part[(1 * 16 + i) * 64 + se] + part[(2 * 16 + i) * 64 + se] + part[(3 * 16 + i) * 64 + se];
            for (int j = 0; j <= i; ++j) o += scs[i * 17 + j] * vv[j * GL_LD + se];
            const int tok = sc_ * 16 + (dir ? 15 - i : i);
            if (dir == 0) oacc[tok * GL_LD + se] = o; else oacc[tok * GL_LD + se] += o;
          }
        }
        __syncthreads();
      }
      if (!FINAL) {
#pragma unroll
        for (int m = 0; m < 16; ++m) p.glKV[chain * 4096 + (scq * 16 + m) * 64 + se] = S[m];
        if (tdx < 64) p.glE[chain * 64 + tdx] = Et[tdx];
      }
      __syncthreads();
    }
    if (FINAL) {
      const int row = tdx >> 1, half = tdx & 1;
      float ss = 0.f;
#pragma unroll
      for (int e = 0; e < 32; ++e) { float v = oacc[row * GL_LD + half * 32 + e]; ss += v * v; }
      ss += __shfl_xor(ss, 1, 64);
      const float rs = rsqrtf(ss * (1.0f / 64.0f) + EPS);
      const size_t grow = (size_t)b * TS + tile * 128 + row;
#pragma unroll
      for (int c = 0; c < 4; ++c) {
        float g[8]; unpack8(*(const u32x4*)(p.P + grow * PW + C_DG * 256 + hh * 64 + half * 32 + c * 8), g);
        u32x4 ov;
#pragma unroll
        for (int q = 0; q < 4; ++q) {
          int e = half * 32 + c * 8 + 2 * q;
          ov[q] = pack2(oacc[row * GL_LD + e] * rs * siluf_(g[2 * q]), oacc[row * GL_LD + e + 1] * rs * siluf_(g[2 * q + 1]));
        }
        *(u32x4*)(p.y + grow * (4 * MW) + 3 * MW + hh * 64 + half * 32 + c * 8) = ov;
      }
    }
  }
}
__device__ void phase_gla_b(const Params& p) {
  for (int i = blockIdx.x * blockDim.x + threadIdx.x; i < NB * NH * 2 * 4096; i += gridDim.x * blockDim.x) {
    int el = i & 4095, chain = i >> 12; int dir = chain & 1; int c = el >> 6;
    size_t base = (size_t)chain * NT;
    float S = 0.f;
    for (int k = 0; k < NT; ++k) {
      int tile = proc_tile(dir, k);
      p.glSp[(base + tile) * 4096 + el] = S;
      S = p.glE[(base + tile) * 64 + c] * S + p.glKV[(base + tile) * 4096 + el];
    }
  }
}


constexpr int MRG_SMEM = 2 * (128 + 64) * LDT * 2;
__device__ void phase_merge(const Params& p, char* smem_) {
  bf16_t* smem = (bf16_t*)smem_;
  bf16_t* sA[2] = {smem, smem + (128 + 64) * LDT};
  bf16_t* sB[2] = {smem + 128 * LDT, smem + (128 + 64) * LDT + 128 * LDT};
  const int lane = threadIdx.x & 63, wid = threadIdx.x >> 6, fr = lane & 15, fq = lane >> 4;
  const bool last = (p.layer == DEPTH - 1);
  constexpr int KG = D / 64, KS = KG + 4, NSTEP = 4 * KS;
  const int ntn = D / 64;
  for (int t = blockIdx.x; t < MT * ntn; t += gridDim.x) {
    const int tm = t / ntn, tn = t % ntn;
    if (last && (tm % NT) < CT) continue;
    const size_t row0 = (size_t)tm * 128; const int col0 = tn * 64;
    u32x4 ra[4], rb[2];
    auto gload = [&](int s) {
      int n = s / KS, r = s % KS;
#pragma unroll
      for (int i = 0; i < 4; ++i) {
        int c = threadIdx.x + i * 256; int row = c >> 3, kc = (c & 7) * 8;
        const bf16_t* src = (r < KG) ? (p.h + (row0 + row) * D + r * 64 + kc) : (p.y + (row0 + row) * (4 * MW) + n * MW + (r - KG) * 64 + kc);
        ra[i] = *(const u32x4*)src;
      }
#pragma unroll
      for (int i = 0; i < 2; ++i) {
        int c = threadIdx.x + i * 256; int row = c >> 3, kc = (c & 7) * 8;
        const bf16_t* src = (r < KG) ? (p.WmT + ((size_t)n * D + col0 + row) * D + r * 64 + kc) : (p.WbT + ((size_t)n * D + col0 + row) * MW + (r - KG) * 64 + kc);
        rb[i] = *(const u32x4*)src;
      }
    };
    auto sstore = [&](int buf) {
#pragma unroll
      for (int i = 0; i < 4; ++i) { int c = threadIdx.x + i * 256; int row = c >> 3, kc = (c & 7) * 8; *(u32x4*)(sA[buf] + row * LDT + kc) = ra[i]; }
#pragma unroll
      for (int i = 0; i < 2; ++i) { int c = threadIdx.x + i * 256; int row = c >> 3, kc = (c & 7) * 8; *(u32x4*)(sB[buf] + row * LDT + kc) = rb[i]; }
    };
    f32x4 aG[2][4], aY[2][4], aZ[2][4];
#pragma unroll
    for (int m = 0; m < 2; ++m)
#pragma unroll
      for (int n = 0; n < 4; ++n) { aG[m][n] = f32x4{0.f, 0.f, 0.f, 0.f}; aY[m][n] = aG[m][n]; aZ[m][n] = aG[m][n]; }
    gload(0);
    __syncthreads();
    sstore(0);
    __syncthreads();
    for (int s = 0; s < NSTEP; ++s) {
      const int cur = s & 1, r = s % KS;
      if (s + 1 < NSTEP) gload(s + 1);
      const bool isG = r < KG;
#pragma unroll
      for (int ks = 0; ks < 2; ++ks) {
        bf16x8 af[2], bfr[4];
#pragma unroll
        for (int m = 0; m < 2; ++m) af[m] = *(const bf16x8*)(sA[cur] + (wid * 32 + m * 16 + fr) * LDT + ks * 32 + fq * 8);
#pragma unroll
        for (int n = 0; n < 4; ++n) bfr[n] = *(const bf16x8*)(sB[cur] + (n * 16 + fr) * LDT + ks * 32 + fq * 8);
        if (isG) {
#pragma unroll
          for (int m = 0; m < 2; ++m)
#pragma unroll
            for (int n = 0; n < 4; ++n) aG[m][n] = MFMA16(bfr[n], af[m], aG[m][n]);
        } else {
#pragma unroll
          for (int m = 0; m < 2; ++m)
#pragma unroll
            for (int n = 0; n < 4; ++n) aY[m][n] = MFMA16(bfr[n], af[m], aY[m][n]);
        }
      }
      if (r == KS - 1) {
#pragma unroll
        for (int m = 0; m < 2; ++m)
#pragma unroll
          for (int n = 0; n < 4; ++n)
#pragma unroll
            for (int q = 0; q < 4; ++q) { aZ[m][n][q] += sigmoidf_(aG[m][n][q]) * aY[m][n][q]; aG[m][n][q] = 0.f; aY[m][n][q] = 0.f; }
      }
      if (s + 1 < NSTEP) sstore(cur ^ 1);
      __syncthreads();
    }
#pragma unroll
    for (int m = 0; m < 2; ++m)
#pragma unroll
      for (int n = 0; n < 4; ++n) {
        size_t row = row0 + wid * 32 + m * 16 + fr; int col = col0 + n * 16 + fq * 4;
        u32x2 o; o[0] = pack2(aZ[m][n][0], aZ[m][n][1]); o[1] = pack2(aZ[m][n][2], aZ[m][n][3]);
        *(u32x2*)(p.z + row * D + col) = o;
      }
  }
}
__device__ void phase_outproj(const Params& p, char* smem_) {
  bf16_t* smem = (bf16_t*)smem_;
  const int lane = threadIdx.x & 63, wid = threadIdx.x >> 6, wr = wid >> 1, wc = wid & 1, fr = lane & 15, fq = lane >> 4;
  const bool last = (p.layer == DEPTH - 1);
  const int ntn = D / 128;
  for (int t = blockIdx.x; t < MT * ntn; t += gridDim.x) {
    int tm = t / ntn, tn = t % ntn;
    if (last && (tm % NT) < CT) continue;
    const bf16_t* A = p.z + (size_t)tm * 128 * D;
    const bf16_t* B = p.WoT + (size_t)tn * 128 * D;
    f32x4 acc[4][4]; ACC_ZERO(acc);
    gemm_kloop(acc, [&](int row, int k0) { return A + (size_t)row * D + k0; },
               [&](int row, int k0) { return B + (size_t)row * D + k0; }, D, smem);
#pragma unroll
    for (int m = 0; m < 4; ++m) {
      int row = tm * 128 + wr * 64 + m * 16 + fr;
      float* xr = xrow(p, row); const float* g = modrow(p, row, 2);
#pragma unroll
      for (int n = 0; n < 4; ++n) {
        int col = tn * 128 + wc * 64 + n * 16 + fq * 4;
        f32x4 xv = *(f32x4*)(xr + col); f32x4 gv = *(const f32x4*)(g + col);
#pragma unroll
        for (int q = 0; q < 4; ++q) xv[q] += gv[q] * acc[m][n][q];
        *(f32x4*)(xr + col) = xv;
      }
    }
  }
}
__device__ __forceinline__ void cls_experts(int cls, int& e_lo, int& e_hi) {
  int gi = cls / 6, pr = cls % 6;
  int lo = (pr < 3) ? 0 : (pr < 5) ? 1 : 2;
  int hi = (pr < 3) ? pr + 1 : (pr < 5) ? pr - 1 : 3;
  e_lo = gi * 4 + lo; e_hi = gi * 4 + hi;
}
__device__ __forceinline__ bool moe_find(const int* cnt, int mt, int& cls, int& mloc, int& total) {
  int acc = 0; bool found = false;
  for (int c = 0; c < NCLS; ++c) {
    int n = (cnt[c] + 127) >> 7;
    if (!found && mt < acc + n) { cls = c; mloc = mt - acc; found = true; }
    acc += n;
  }
  total = acc; return found;
}
__device__ void phase_moe_up(const Params& p, char* smem_) {
  bf16_t* smem = (bf16_t*)smem_;
  __shared__ int stok[128];
  const int lane = threadIdx.x & 63, wid = threadIdx.x >> 6, wr = wid >> 1, wc = wid & 1, fr = lane & 15, fq = lane >> 4;
  const int* cnt = p.moe_cnt + (p.layer * 2) * NCLS;
  constexpr int NCB = 2 * DE / 64;
  int total_mt = 0;
  { int c_, m_; moe_find(cnt, 0, c_, m_, total_mt); }
  for (int t = blockIdx.x; t < total_mt * NCB; t += gridDim.x) {
    const int mt = t / NCB, cb = t % NCB;
    int cls = 0, mloc = 0, tot_;
    moe_find(cnt, mt, cls, mloc, tot_);
    int e_lo, e_hi; cls_experts(cls, e_lo, e_hi);
    const int slot = (cb * 64) / DE, cbase = (cb * 64) % DE;
    const int ex = slot ? e_hi : e_lo;
    const int nvalid = imin(128, cnt[cls] - mloc * 128);
    __syncthreads();
    if (threadIdx.x < 128) stok[threadIdx.x] = p.moe_list[(size_t)cls * T + mloc * 128 + imin((int)threadIdx.x, nvalid - 1)];
    __syncthreads();
    const bf16_t* W1 = p.W1T + (size_t)ex * DE * D; const bf16_t* W3 = p.W3T + (size_t)ex * DE * D;
    f32x4 acc[4][4]; ACC_ZERO(acc);
    gemm_kloop(acc, [&](int row, int k0) { return p.h + (size_t)stok[row] * D + k0; },
               [&](int row, int k0) { int wcc = row >> 6, within = row & 63; int col = cbase + wcc * 32 + (within & 31);
                                      return ((within >= 32) ? W3 : W1) + (size_t)col * D + k0; }, D, smem);
#pragma unroll
    for (int m = 0; m < 4; ++m) {
      int rl = wr * 64 + m * 16 + fr;
      if (rl < nvalid) {
        int tok = stok[rl]; float tw = p.moe_tw[(size_t)tok * 2 + slot];
#pragma unroll
        for (int n = 0; n < 2; ++n) {
          int col = slot * DE + cbase + wc * 32 + n * 16 + fq * 4;
          float v[4];
#pragma unroll
          for (int q = 0; q < 4; ++q) v[q] = siluf_(acc[m][n][q]) * acc[m][n + 2][q] * tw;
          u32x2 o; o[0] = pack2(v[0], v[1]); o[1] = pack2(v[2], v[3]);
          *(u32x2*)(p.mid + (size_t)tok * (2 * DE) + col) = o;
        }
      }
    }
  }
}
__device__ void phase_moe_down(const Params& p, char* smem_) {
  bf16_t* smem = (bf16_t*)smem_;
  __shared__ int stok[128];
  const int lane = threadIdx.x & 63, wid = threadIdx.x >> 6, wr = wid >> 1, wc = wid & 1, fr = lane & 15, fq = lane >> 4;
  const int* cnt = p.moe_cnt + (p.layer * 2) * NCLS;
  constexpr int NCB = D / 128;
  int total_mt = 0;
  { int c_, m_; moe_find(cnt, 0, c_, m_, total_mt); }
  for (int t = blockIdx.x; t < total_mt * NCB; t += gridDim.x) {
    const int mt = t / NCB, cb = t % NCB;
    int cls = 0, mloc = 0, tot_;
    moe_find(cnt, mt, cls, mloc, tot_);
    int e_lo, e_hi; cls_experts(cls, e_lo, e_hi);
    const int nvalid = imin(128, cnt[cls] - mloc * 128);
    __syncthreads();
    if (threadIdx.x < 128) stok[threadIdx.x] = p.moe_list[(size_t)cls * T + mloc * 128 + imin((int)threadIdx.x, nvalid - 1)];
    __syncthreads();
    f32x4 acc[4][4]; ACC_ZERO(acc);
    gemm_kloop(acc, [&](int row, int k0) { return p.mid + (size_t)stok[row] * (2 * DE) + k0; },
               [&](int row, int k0) { int ex = (k0 < DE) ? e_lo : e_hi; int kk = (k0 < DE) ? k0 : k0 - DE;
                                      return p.W2T + ((size_t)ex * D + cb * 128 + row) * DE + kk; }, 2 * DE, smem);
#pragma unroll
    for (int m = 0; m < 4; ++m) {
      int rl = wr * 64 + m * 16 + fr;
      if (rl < nvalid) {
        int tok = stok[rl];
        float* xr = xrow(p, tok); const float* g = modrow(p, tok, 5);
#pragma unroll
        for (int n = 0; n < 4; ++n) {
          int col = cb * 128 + wc * 64 + n * 16 + fq * 4;
          f32x4 xv = *(f32x4*)(xr + col); f32x4 gv = *(const f32x4*)(g + col);
#pragma unroll
          for (int q = 0; q < 4; ++q) xv[q] += gv[q] * acc[m][n][q];
          *(f32x4*)(xr + col) = xv;
        }
      }
    }
  }
}
__device__ void phase_final(const Params& p) {
  const int lane = threadIdx.x & 63, wid = threadIdx.x >> 6, nw = blockDim.x >> 6;
  for (int r = blockIdx.x * nw + wid; r < NB * SEQ; r += gridDim.x * nw) {
    float* xr = p.out + (size_t)r * D;
    f32x4 v[D / 256]; float ss = 0.f;
#pragma unroll
    for (int i = 0; i < D / 256; ++i) { v[i] = *(const f32x4*)(xr + i * 256 + lane * 4); ss += v[i][0] * v[i][0] + v[i][1] * v[i][1] + v[i][2] * v[i][2] + v[i][3] * v[i][3]; }
    ss = wave_sum(ss);
    float rs = rsqrtf(ss * (1.0f / D) + EPS);
#pragma unroll
    for (int i = 0; i < D / 256; ++i) {
      f32x4 w4 = *(const f32x4*)(p.final_norm_w + i * 256 + lane * 4);
#pragma unroll
      for (int q = 0; q < 4; ++q) v[i][q] = v[i][q] * rs * w4[q];
      *(f32x4*)(xr + i * 256 + lane * 4) = v[i];
    }
  }
}

__global__ void __launch_bounds__(256) k_init(Params p) { phase_init(p); }
__global__ void __launch_bounds__(256) k_modv(Params p) { phase_modv(p); }
__global__ void __launch_bounds__(256) k_convw(Params p, int part) { phase_convw(p, part); }
__global__ void __launch_bounds__(256) k_norm(Params p, int which) { phase_norm(p, which); }
__global__ void __launch_bounds__(256) k_inproj(Params p) { DYN_SMEM(smem); phase_inproj(p, smem); }
__global__ void __launch_bounds__(256) k_ret_a(Params p) { DYN_SMEM(smem); phase_ret_a(p, smem); }
__global__ void __launch_bounds__(256) k_ret_b(Params p) { phase_ret_b(p); }
__global__ void __launch_bounds__(256) k_ret_c(Params p) { DYN_SMEM(smem); phase_ret_c(p, smem); }
__global__ void __launch_bounds__(256) k_mls_a(Params p) { DYN_SMEM(smem); phase_mls_a(p, smem); }
__global__ void __launch_bounds__(256) k_mls_b(Params p) { phase_mls_b(p); }
__global__ void __launch_bounds__(256) k_mls_c(Params p) { DYN_SMEM(smem); phase_mls_c(p, smem); }
__global__ void __launch_bounds__(256) k_gla_a(Params p) { DYN_SMEM(smem); phase_gla<false>(p, smem); }
__global__ void __launch_bounds__(256) k_gla_b(Params p) { phase_gla_b(p); }
__global__ void __launch_bounds__(256) k_gla_c(Params p) { DYN_SMEM(smem); phase_gla<true>(p, smem); }
__global__ void __launch_bounds__(256) k_merge(Params p) { DYN_SMEM(smem); phase_merge(p, smem); }
__global__ void __launch_bounds__(256) k_outproj(Params p) { DYN_SMEM(smem); phase_outproj(p, smem); }
__global__ void __launch_bounds__(256) k_moe_up(Params p) { DYN_SMEM(smem); phase_moe_up(p, smem); }
__global__ void __launch_bounds__(256) k_moe_down(Params p) { DYN_SMEM(smem); phase_moe_down(p, smem); }
__global__ void __launch_bounds__(256) k_final(Params p) { phase_final(p); }
__global__ void __launch_bounds__(256) k_lru_a(Params p) { DYN_SMEM(smem); phase_lru<false>(p, smem); }
__global__ void __launch_bounds__(256) k_lru_b(Params p) { phase_lru_carry(p); }
__global__ void __launch_bounds__(256) k_lru_c(Params p) { DYN_SMEM(smem); phase_lru<true>(p, smem); }

static size_t align_up(size_t v, size_t a) { return (v + a - 1) / a * a; }

extern "C" void kernel_launch(void* const* d_in, const int* in_sizes, int n_in, void* d_out, int out_size, void* d_ws,
                              size_t ws_size, hipStream_t stream) {
  Params p{};
  const float* const* in = (const float* const*)d_in;
  p.x = in[0]; p.c = in[1]; p.ctx = in[2]; p.c_ctx = in[3]; p.w_mod = in[4]; p.b_mod = in[5]; p.w_in = in[6];
  p.a_conv_w = in[7]; p.a_conv_b = in[8]; p.a_gate_w = in[9]; p.a_gate_b = in[10]; p.a_lambda = in[11]; p.b_theta = in[12];
  p.c_conv_w = in[13]; p.c_conv_b = in[14]; p.c_gate_b = in[15]; p.d_lb = in[16]; p.w_branch = in[17]; p.w_out = in[18];
  p.moe_w_group = in[19]; p.moe_b_group = in[20]; p.moe_w_router = in[21]; p.moe_b_router = in[22];
  p.moe_w1 = in[23]; p.moe_w3 = in[24]; p.moe_w2 = in[25]; p.final_norm_w = in[26];
  p.out = (float*)d_out;
  char* w = (char*)d_ws; size_t off = 0;
  auto take = [&](size_t bytes) { char* r = w + off; off = align_up(off + bytes, 256); return r; };
  p.modv = (float*)take((size_t)DEPTH * (NB + 1) * NMOD * D * 4);
  p.xc = (float*)take((size_t)NB * CTX * D * 4);
  p.h = (bf16_t*)take((size_t)T * D * 2);
  p.cg = (float*)take((size_t)T * 16 * 4);
  p.y = (bf16_t*)take((size_t)T * 4 * MW * 2);
  p.WinT = (bf16_t*)take((size_t)PW * D * 2);
  p.WmT = (bf16_t*)take((size_t)4 * D * D * 2);
  p.WbT = (bf16_t*)take((size_t)4 * D * MW * 2);
  p.WoT = (bf16_t*)take((size_t)D * D * 2);
  p.retKV = (float*)take((size_t)NB * NH * 2 * NT * 64 * 64 * 4);
  p.retSp = (bf16_t*)take((size_t)NB * NH * 2 * NT * 64 * 64 * 2);
  p.mlC = (float*)take((size_t)NB * NH * 2 * NT * 80 * 64 * 4);
  p.mlCe = (float*)take((size_t)NB * NH * 2 * NT * 4);
  p.mlSp = (bf16_t*)take((size_t)NB * NH * 2 * NT * 80 * 64 * 2);
  p.glKV = (float*)take((size_t)NB * NH * 2 * NT * 64 * 64 * 4);
  p.glE = (float*)take((size_t)NB * NH * 2 * NT * 64 * 4);
  p.glSp = (float*)take((size_t)NB * NH * 2 * NT * 64 * 64 * 4);
  p.lruS = (float*)take((size_t)NB * 2 * NT * 2 * 256 * 4);
  p.lruC = (float*)take((size_t)NB * 2 * NT * 256 * 4);
  p.moe_cnt = (int*)take((size_t)DEPTH * 2 * NCLS * 4);
  p.moe_list = (int*)take((size_t)NCLS * T * 4);
  p.moe_tw = (float*)take((size_t)T * 2 * 4);
  char* preg = take((size_t)T * PW * 2);
  p.P = (bf16_t*)preg;
  {
    size_t o2 = 0;
    auto take2 = [&](size_t bytes) { char* r = preg + o2; o2 = align_up(o2 + bytes, 256); return r; };
    p.z = (bf16_t*)take2((size_t)T * D * 2);
    p.mid = (bf16_t*)take2((size_t)T * 2 * DE * 2);
    p.W1T = (bf16_t*)take2((size_t)16 * DE * D * 2);
    p.W3T = (bf16_t*)take2((size_t)16 * DE * D * 2);
    p.W2T = (bf16_t*)take2((size_t)16 * D * DE * 2);
  }
#ifdef EMU
  extern Params g_params; g_params = p;
  const int G = 8;
#else
  const int G = 1024;
  hipFuncSetAttribute((const void*)k_inproj, hipFuncAttributeMaxDynamicSharedMemorySize, GEMM_SMEM);
  hipFuncSetAttribute((const void*)k_ret_a, hipFuncAttributeMaxDynamicSharedMemorySize, RETA_SMEM);
  hipFuncSetAttribute((const void*)k_ret_c, hipFuncAttributeMaxDynamicSharedMemorySize, RETC_SMEM);
  hipFuncSetAttribute((const void*)k_mls_a, hipFuncAttributeMaxDynamicSharedMemorySize, MLSA_SMEM);
  hipFuncSetAttribute((const void*)k_mls_c, hipFuncAttributeMaxDynamicSharedMemorySize, MLSC_SMEM);
  hipFuncSetAttribute((const void*)k_gla_a, hipFuncAttributeMaxDynamicSharedMemorySize, GLA_SMEM);
  hipFuncSetAttribute((const void*)k_gla_c, hipFuncAttributeMaxDynamicSharedMemorySize, GLA_SMEM);
  hipFuncSetAttribute((const void*)k_merge, hipFuncAttributeMaxDynamicSharedMemorySize, MRG_SMEM);
  hipFuncSetAttribute((const void*)k_outproj, hipFuncAttributeMaxDynamicSharedMemorySize, GEMM_SMEM);
  hipFuncSetAttribute((const void*)k_moe_up, hipFuncAttributeMaxDynamicSharedMemorySize, GEMM_SMEM);
  hipFuncSetAttribute((const void*)k_moe_down, hipFuncAttributeMaxDynamicSharedMemorySize, GEMM_SMEM);
  hipFuncSetAttribute((const void*)k_lru_a, hipFuncAttributeMaxDynamicSharedMemorySize, LRU_SMEM);
  hipFuncSetAttribute((const void*)k_lru_c, hipFuncAttributeMaxDynamicSharedMemorySize, LRU_SMEM);
#endif
  LAUNCH(k_init, G, 256, 0, stream, p);
  LAUNCH(k_modv, (DEPTH * NMOD * D + 255) / 256, 256, 0, stream, p);
#ifdef EMU
  const int nlayers = getenv("EMU_LAYERS") ? atoi(getenv("EMU_LAYERS")) : DEPTH;
  const int stop_after = getenv("EMU_STOP") ? atoi(getenv("EMU_STOP")) : 99;
#else
  const int nlayers = DEPTH, stop_after = 99;
#endif
  for (int l = 0; l < nlayers; ++l) {
    p.layer = l;
    const bool lastl = (l == nlayers - 1);
    LAUNCH(k_convw, G, 256, 0, stream, p, 0);
    LAUNCH(k_norm, G, 256, 0, stream, p, 0);
    LAUNCH(k_inproj, G, 256, GEMM_SMEM, stream, p);
    if (lastl && stop_after < 1) break;
    LAUNCH(k_lru_a, G, 256, LRU_SMEM, stream, p);
    LAUNCH(k_ret_a, G, 256, RETA_SMEM, stream, p);
    LAUNCH(k_mls_a, G, 256, MLSA_SMEM, stream, p);
    LAUNCH(k_gla_a, G, 256, GLA_SMEM, stream, p);
    LAUNCH(k_lru_b, G, 256, 0, stream, p);
    LAUNCH(k_ret_b, G, 256, 0, stream, p);
    LAUNCH(k_mls_b, G, 256, 0, stream, p);
    LAUNCH(k_gla_b, G, 256, 0, stream, p);
    LAUNCH(k_lru_c, G, 256, LRU_SMEM, stream, p);
    LAUNCH(k_ret_c, G, 256, RETC_SMEM, stream, p);
    LAUNCH(k_mls_c, G, 256, MLSC_SMEM, stream, p);
    LAUNCH(k_gla_c, G, 256, GLA_SMEM, stream, p);
    if (lastl && stop_after < 2) break;
    LAUNCH(k_convw, G, 256, 0, stream, p, 1);
    LAUNCH(k_merge, G, 256, MRG_SMEM, stream, p);
    if (lastl && stop_after < 3) break;
    LAUNCH(k_outproj, G, 256, GEMM_SMEM, stream, p);
    if (lastl && stop_after < 4) break;
    LAUNCH(k_norm, G, 256, 0, stream, p, 1);
    LAUNCH(k_moe_up, G, 256, GEMM_SMEM, stream, p);
    LAUNCH(k_moe_down, G, 256, GEMM_SMEM, stream, p);
  }
  if (nlayers == DEPTH && stop_after >= 99) LAUNCH(k_final, G, 256, 0, stream, p);

}
```

```cpp
#ifndef EMU
#include <hip/hip_runtime.h>
#include <hip/hip_cooperative_groups.h>
#include <cstdio>
typedef short bf16x8 __attribute__((ext_vector_type(8)));
typedef float f32x4 __attribute__((ext_vector_type(4)));
#define MFMA16(a, b, c) __builtin_amdgcn_mfma_f32_16x16x32_bf16(a, b, c, 0, 0, 0)
#define LAUNCH(kern, grid, block, smem, stream, ...) hipLaunchKernelGGL(kern, dim3(grid), dim3(block), smem, stream, __VA_ARGS__)
#define DYN_SMEM(name) extern __shared__ __attribute__((aligned(16))) char name[]
#define WAVE_SYNC() __builtin_amdgcn_wave_barrier()
#define NO_HOIST() asm volatile("" ::: "memory")
#else
#define MFMA16(a, b, c) emu_mfma16(a, b, c)
#define LAUNCH(kern, grid, block, smem, stream, ...) emu::launch(dim3(grid), dim3(block), false, [=]() { kern(__VA_ARGS__); })
#define DYN_SMEM(name) char* name = emu::tl_blk->dyn_smem
#define WAVE_SYNC() emu::wave_barrier()
#define NO_HOIST()
#endif

typedef unsigned short bf16_t;
typedef unsigned u32x4 __attribute__((ext_vector_type(4)));
typedef unsigned u32x2 __attribute__((ext_vector_type(2)));
typedef float f32x2 __attribute__((ext_vector_type(2)));

#ifdef EMU_SMALL
constexpr int D = 256, NB = 2, SEQ = 256, CTX = 128, DE = 128;
#else
constexpr int D = 1024, NB = 4, SEQ = 4096, CTX = 256, DE = 512;
#endif
constexpr int DEPTH = 2, NH = 4, HD = 64, MW = 256;
constexpr int TS = CTX + SEQ;
constexpr int T = NB * TS;
constexpr int NT = TS / 128;
constexpr int CT = CTX / 128;
constexpr int MT = T / 128;
constexpr int INW = 15 * MW + 16 + 4 * D;
constexpr int PW = 15 * MW;
constexpr int NMOD = 6;
constexpr int GRIDW = 64;
constexpr int NCLS = 24;
constexpr float EPS = 1e-6f;
enum { C_AX = 0, C_AG = 1, C_BQ = 2, C_BK = 3, C_BV = 4, C_BG = 5, C_CQ = 6, C_CK = 7, C_CV = 8, C_CO = 9,
       C_DQ = 10, C_DFF = 11, C_DFB = 12, C_DI = 13, C_DG = 14 };

constexpr size_t A256(size_t v) { return (v + 255) / 256 * 256; }
constexpr size_t O_modv = 0;
constexpr size_t O_xc = O_modv + A256((size_t)DEPTH * (NB + 1) * NMOD * D * 4);
constexpr size_t O_h = O_xc + A256((size_t)NB * CTX * D * 4);
constexpr size_t O_cg = O_h + A256((size_t)T * D * 2);
constexpr size_t O_y = O_cg + A256((size_t)T * 16 * 4);
constexpr size_t O_WinT = O_y + A256((size_t)T * 4 * MW * 2);
constexpr size_t O_WmT = O_WinT + A256((size_t)PW * D * 2);
constexpr size_t O_WbT = O_WmT + A256((size_t)4 * D * D * 2);
constexpr size_t O_WoT = O_WbT + A256((size_t)4 * D * MW * 2);
constexpr size_t O_WcgT = O_WoT + A256((size_t)D * D * 2);
constexpr size_t O_WrtT = O_WcgT + A256((size_t)16 * D * 2);
constexpr size_t O_retKV = O_WrtT + A256((size_t)32 * D * 2);
constexpr size_t O_retSp = O_retKV + A256((size_t)NB * NH * 2 * NT * 64 * 64 * 4);
constexpr size_t O_mlC = O_retSp + A256((size_t)NB * NH * 2 * NT * 64 * 64 * 2);
constexpr size_t O_mlCe = O_mlC + A256((size_t)NB * NH * 2 * NT * 80 * 64 * 4);
constexpr size_t O_mlSp = O_mlCe + A256((size_t)NB * NH * 2 * NT * 4);
constexpr size_t O_glKV = O_mlSp + A256((size_t)NB * NH * 2 * NT * 80 * 64 * 2);
constexpr size_t O_glE = O_glKV + A256((size_t)NB * NH * 2 * NT * 64 * 64 * 4);
constexpr size_t O_glSp = O_glE + A256((size_t)NB * NH * 2 * NT * 64 * 4);
constexpr size_t O_lruS = O_glSp + A256((size_t)NB * NH * 2 * NT * 64 * 64 * 4);
constexpr size_t O_lruC = O_lruS + A256((size_t)NB * 2 * (TS / 64) * 2 * 256 * 4);
constexpr size_t O_moe_cnt = O_lruC + A256((size_t)NB * 2 * (TS / 64) * 256 * 4);
constexpr size_t O_moe_list = O_moe_cnt + A256((size_t)DEPTH * 2 * NCLS * 4);
constexpr size_t O_moe_tw = O_moe_list + A256((size_t)NCLS * T * 4);
constexpr size_t O_rope = O_moe_tw + A256((size_t)T * 2 * 4);
constexpr size_t O_P = O_rope + A256((size_t)SEQ * 32 * 2 * 4);
constexpr size_t WS_TOTAL = O_P + A256((size_t)T * PW * 2);
constexpr size_t O_z = O_P;
constexpr size_t O_mid = O_z + A256((size_t)T * D * 2);
constexpr size_t O_W1T = O_mid + A256((size_t)T * 2 * DE * 2);
constexpr size_t O_W3T = O_W1T + A256((size_t)16 * DE * D * 2);
constexpr size_t O_W2T = O_W3T + A256((size_t)16 * DE * D * 2);
static_assert(O_W2T + A256((size_t)16 * D * DE * 2) <= WS_TOTAL, "P-region aliases overflow");
struct Params {
  const float *x, *c, *ctx, *c_ctx, *w_mod, *b_mod, *w_in, *a_conv_w, *a_conv_b, *a_gate_w, *a_gate_b, *a_lambda,
      *b_theta, *c_conv_w, *c_conv_b, *c_gate_b, *d_lb, *w_branch, *w_out, *moe_w_group, *moe_b_group,
      *moe_w_router, *moe_b_router, *moe_w1, *moe_w3, *moe_w2, *final_norm_w;
  float* out;
  char* ws;
  __device__ __host__ __forceinline__ float* modv() const { return (float*)(ws + O_modv); }
  __device__ __host__ __forceinline__ float* xc() const { return (float*)(ws + O_xc); }
  __device__ __host__ __forceinline__ bf16_t* h() const { return (bf16_t*)(ws + O_h); }
  __device__ __host__ __forceinline__ float* cg() const { return (float*)(ws + O_cg); }
  __device__ __host__ __forceinline__ bf16_t* y() const { return (bf16_t*)(ws + O_y); }
  __device__ __host__ __forceinline__ bf16_t* WinT() const { return (bf16_t*)(ws + O_WinT); }
  __device__ __host__ __forceinline__ bf16_t* WmT() const { return (bf16_t*)(ws + O_WmT); }
  __device__ __host__ __forceinline__ bf16_t* WbT() const { return (bf16_t*)(ws + O_WbT); }
  __device__ __host__ __forceinline__ bf16_t* WoT() const { return (bf16_t*)(ws + O_WoT); }
  __device__ __host__ __forceinline__ bf16_t* WcgT() const { return (bf16_t*)(ws + O_WcgT); }
  __device__ __host__ __forceinline__ bf16_t* WrtT() const { return (bf16_t*)(ws + O_WrtT); }
  __device__ __host__ __forceinline__ float* retKV() const { return (float*)(ws + O_retKV); }
  __device__ __host__ __forceinline__ bf16_t* retSp() const { return (bf16_t*)(ws + O_retSp); }
  __device__ __host__ __forceinline__ float* mlC() const { return (float*)(ws + O_mlC); }
  __device__ __host__ __forceinline__ float* mlCe() const { return (float*)(ws + O_mlCe); }
  __device__ __host__ __forceinline__ bf16_t* mlSp() const { return (bf16_t*)(ws + O_mlSp); }
  __device__ __host__ __forceinline__ float* glKV() const { return (float*)(ws + O_glKV); }
  __device__ __host__ __forceinline__ float* glE() const { return (float*)(ws + O_glE); }
  __device__ __host__ __forceinline__ float* glSp() const { return (float*)(ws + O_glSp); }
  __device__ __host__ __forceinline__ float* lruS() const { return (float*)(ws + O_lruS); }
  __device__ __host__ __forceinline__ float* lruC() const { return (float*)(ws + O_lruC); }
  __device__ __host__ __forceinline__ int* moe_cnt() const { return (int*)(ws + O_moe_cnt); }
  __device__ __host__ __forceinline__ int* moe_list() const { return (int*)(ws + O_moe_list); }
  __device__ __host__ __forceinline__ float* moe_tw() const { return (float*)(ws + O_moe_tw); }
  __device__ __host__ __forceinline__ float* rope() const { return (float*)(ws + O_rope); }
  __device__ __host__ __forceinline__ bf16_t* P() const { return (bf16_t*)(ws + O_P); }
  __device__ __host__ __forceinline__ bf16_t* z() const { return (bf16_t*)(ws + O_z); }
  __device__ __host__ __forceinline__ bf16_t* mid() const { return (bf16_t*)(ws + O_mid); }
  __device__ __host__ __forceinline__ bf16_t* W1T() const { return (bf16_t*)(ws + O_W1T); }
  __device__ __host__ __forceinline__ bf16_t* W3T() const { return (bf16_t*)(ws + O_W3T); }
  __device__ __host__ __forceinline__ bf16_t* W2T() const { return (bf16_t*)(ws + O_W2T); }
  int layer;
  int wave;
};


#ifndef EMU
typedef __attribute__((address_space(4))) const Params* KParamsPtr;
__device__ __forceinline__ Params load_params(int layer, int wave) {
  auto kp0 = __builtin_amdgcn_kernarg_segment_ptr();
  asm volatile("" : "+s"(kp0));
  KParamsPtr kp = (KParamsPtr)kp0;
  Params p;
  p.x = kp->x; p.c = kp->c; p.ctx = kp->ctx; p.c_ctx = kp->c_ctx; p.w_mod = kp->w_mod; p.b_mod = kp->b_mod; p.w_in = kp->w_in; p.a_conv_w = kp->a_conv_w; p.a_conv_b = kp->a_conv_b; p.a_gate_w = kp->a_gate_w; p.a_gate_b = kp->a_gate_b; p.a_lambda = kp->a_lambda; p.b_theta = kp->b_theta; p.c_conv_w = kp->c_conv_w; p.c_conv_b = kp->c_conv_b; p.c_gate_b = kp->c_gate_b; p.d_lb = kp->d_lb; p.w_branch = kp->w_branch; p.w_out = kp->w_out; p.moe_w_group = kp->moe_w_group; p.moe_b_group = kp->moe_b_group; p.moe_w_router = kp->moe_w_router; p.moe_b_router = kp->moe_b_router; p.moe_w1 = kp->moe_w1; p.moe_w3 = kp->moe_w3; p.moe_w2 = kp->moe_w2; p.final_norm_w = kp->final_norm_w; p.out = kp->out; p.ws = kp->ws;
  p.layer = layer; p.wave = wave;
  return p;
}
#else
static Params g_kp;
static inline Params load_params(int layer, int wave) { Params p = g_kp; p.layer = layer; p.wave = wave; return p; }
#endif

__device__ __forceinline__ unsigned f2u(float f) { return __builtin_bit_cast(unsigned, f); }
__device__ __forceinline__ float u2f(unsigned u) { return __builtin_bit_cast(float, u); }
__device__ __forceinline__ bf16_t f2bf(float f) {
  unsigned u = f2u(f);
  u += 0x7FFFu + ((u >> 16) & 1u);
  return (bf16_t)(u >> 16);
}
__device__ __forceinline__ float bf2f(bf16_t b) { return u2f(((unsigned)b) << 16); }
__device__ __forceinline__ unsigned pack2(float lo, float hi) { return (unsigned)f2bf(lo) | ((unsigned)f2bf(hi) << 16); }
#ifndef EMU
__device__ __forceinline__ float fexp(float x) { return __expf(x); }
__device__ __forceinline__ float fexp2(float x) { return __builtin_amdgcn_exp2f(x); }
__device__ __forceinline__ float frcp(float x) { return __builtin_amdgcn_rcpf(x); }
__device__ __forceinline__ float fsqrt(float x) { return __builtin_amdgcn_sqrtf(x); }
__device__ __forceinline__ float flog(float x) { return __logf(x); }
#else
__device__ __forceinline__ float fexp(float x) { return expf(x); }
__device__ __forceinline__ float fexp2(float x) { return exp2f(x); }
__device__ __forceinline__ float frcp(float x) { return 1.0f / x; }
__device__ __forceinline__ float fsqrt(float x) { return sqrtf(x); }
__device__ __forceinline__ float flog(float x) { return logf(x); }
#endif
__device__ __forceinline__ float fsigmoid(float x) { return frcp(1.0f + fexp(-x)); }
__device__ __forceinline__ float fsilu(float x) { return x * frcp(1.0f + fexp(-x)); }
__device__ __forceinline__ float sigmoidf_(float x) { return 1.0f / (1.0f + expf(-x)); }
__device__ __forceinline__ float siluf_(float x) { return x / (1.0f + expf(-x)); }
__device__ __forceinline__ float logsigf_(float x) {
  return (x >= 0.f) ? -log1pf(expf(-x)) : (x - log1pf(expf(x)));
}
__device__ __forceinline__ float geluf_(float x) {
  return 0.5f * x * (1.0f + tanhf(0.7978845608028654f * (x + 0.044715f * x * x * x)));
}
__device__ __forceinline__ float* xrow(const Params& p, int r) {
  int b = r / TS, s = r - b * TS;
  return (s < CTX) ? (p.xc() + ((size_t)b * CTX + s) * D) : (p.out + ((size_t)b * SEQ + (s - CTX)) * D);
}
__device__ __forceinline__ const float* modrow(const Params& p, int r, int m) {
  int b = r / TS, s = r - b * TS;
  int mr = (s < CTX) ? NB : b;
  return p.modv() + ((size_t)p.layer * (NB + 1) + mr) * (NMOD * D) + m * D;
}
__device__ __forceinline__ int tidx(const Params& p) {
#ifdef EMU
  return threadIdx.x;
#else
  int z; asm volatile("v_mov_b32 %0, 0" : "=v"(z));
  return (p.wave << 6) + (int)__builtin_amdgcn_mbcnt_hi(~0u, __builtin_amdgcn_mbcnt_lo(~0u, 0u)) + z;
#endif
}
__device__ __forceinline__ int imin(int a, int b) { return a < b ? a : b; }
__device__ __forceinline__ float wave_sum(float v) {
#pragma unroll
  for (int o = 32; o > 0; o >>= 1) v += __shfl_xor(v, o, 64);
  return v;
}

__device__ void phase_init(const Params& p) {
  const int tid = tidx(p);
  int gt = blockIdx.x * blockDim.x + tid, gn = gridDim.x * blockDim.x;
  const f32x4* xs = (const f32x4*)p.x;
  f32x4* xd = (f32x4*)p.out;
  for (size_t i = gt; i < (size_t)NB * SEQ * D / 4; i += gn) xd[i] = xs[i];
  const f32x4* cs = (const f32x4*)p.ctx;
  f32x4* cd = (f32x4*)p.xc();
  for (size_t i = gt; i < (size_t)NB * CTX * D / 4; i += gn) cd[i] = cs[i];
  for (int i = gt; i < DEPTH * 2 * NCLS; i += gn) p.moe_cnt()[i] = 0;
  for (int i = gt; i < SEQ * 32; i += gn) {
    int tt = i >> 5, pp = i & 31;
    float pos = (float)(pp < 16 ? (tt / GRIDW) : (tt % GRIDW));
    float inv = exp2f(-(float)(pp & 15) * (13.287712379549449f / 16.0f));
    float sn, cs; sincosf(pos * inv, &sn, &cs);
    p.rope()[2 * i] = cs; p.rope()[2 * i + 1] = sn;
  }
}

__device__ void phase_modv(const Params& p, char* smem_) {
  const int tid = tidx(p);
  float* sc = (float*)smem_;
  __syncthreads();
  for (int i = tid; i < (NB + 1) * D; i += blockDim.x) {
    int r = i / D, k = i - r * D;
    float v = (r < NB) ? p.c[r * D + k] : p.c_ctx[k];
    sc[i] = siluf_(v);
  }
  __syncthreads();
  const int ncols = DEPTH * NMOD * D;
  for (int col = blockIdx.x * blockDim.x + tid; col < ncols; col += gridDim.x * blockDim.x) {
    int l = col / (NMOD * D), n = col - l * (NMOD * D);
    const float* w = p.w_mod + (size_t)l * D * (NMOD * D) + n;
    float acc[NB + 1];
#pragma unroll
    for (int r = 0; r <= NB; ++r) acc[r] = 0.f;
    for (int k = 0; k < D; ++k) {
      float wv = w[(size_t)k * (NMOD * D)];
#pragma unroll
      for (int r = 0; r <= NB; ++r) acc[r] += sc[r * D + k] * wv;
    }
    float bb = p.b_mod[l * (NMOD * D) + n];
#pragma unroll
    for (int r = 0; r <= NB; ++r) p.modv()[((size_t)l * (NB + 1) + r) * (NMOD * D) + n] = acc[r] + bb;
  }
}

__device__ __forceinline__ void convT_tile(int tid, const float* src, int ld_src, bf16_t* dst, int ld_dst, int k0, int n0, float* tile  ) {
  int tx = tid & 63, ty = tid >> 6;
  for (int kk = ty; kk < 64; kk += 4) tile[kk * 65 + tx] = src[(size_t)(k0 + kk) * ld_src + n0 + tx];
  __syncthreads();
  for (int c = tid; c < 512; c += 256) {
    int n = c >> 3, kc = (c & 7) * 8;
    u32x4 v;
    v[0] = pack2(tile[(kc + 0) * 65 + n], tile[(kc + 1) * 65 + n]);
    v[1] = pack2(tile[(kc + 2) * 65 + n], tile[(kc + 3) * 65 + n]);
    v[2] = pack2(tile[(kc + 4) * 65 + n], tile[(kc + 5) * 65 + n]);
    v[3] = pack2(tile[(kc + 6) * 65 + n], tile[(kc + 7) * 65 + n]);
    *(u32x4*)(dst + (size_t)(n0 + n) * ld_dst + k0 + kc) = v;
  }
  __syncthreads();
}
__device__ void phase_convw(const Params& p, int part, char* smem_) {
  const int tid = tidx(p);
  float* tile = (float*)smem_;
  __syncthreads();
  const int l = p.layer;
  const int tA = (D / 64) * (2560 / 64), tB = (D / 64) * (1280 / 64), tM = (D / 64) * (4 * D / 64);
  const int tWb = 4 * (MW / 64) * (D / 64), tWo = (D / 64) * (D / 64);
  const int tE = 16 * (D / 64) * (DE / 64);
  const int total = tA + tB + tM + tWb + tWo + 3 * tE;
  {
    for (int i = blockIdx.x * blockDim.x + tid; i < (part ? 32 : 16) * D; i += gridDim.x * blockDim.x) {
      int n = i / D, k = i - n * D;
      if (part == 0) p.WcgT()[(size_t)n * D + k] = f2bf(p.w_in[((size_t)l * D + k) * INW + 2560 + n]);
      else {
        float v = 0.f;
        if (n < 16) v = p.moe_w_router[((size_t)l * D + k) * 16 + n]; else if (n < 20) v = p.moe_w_group[((size_t)l * D + k) * 4 + (n - 16)];
        p.WrtT()[(size_t)n * D + k] = f2bf(v);
      }
    }
  }
  const int nA = tA + tB + tM + tWb + tWo;
  const int lo = part ? nA : 0, hi = part ? total : nA;
  for (int t = lo + blockIdx.x; t < hi; t += gridDim.x) {
    int u = t;
    const float* win = p.w_in + (size_t)l * D * INW;
    if (u < tA) { int kt = u / (2560 / 64), nt = u % (2560 / 64); convT_tile(tid, win, INW, p.WinT(), D, kt * 64, nt * 64, tile); continue; }
    u -= tA;
    if (u < tB) { int kt = u / (1280 / 64), nt = u % (1280 / 64); convT_tile(tid, win + 2576, INW, p.WinT() + (size_t)2560 * D, D, kt * 64, nt * 64, tile); continue; }
    u -= tB;
    if (u < tM) { int kt = u / (4 * D / 64), nt = u % (4 * D / 64); convT_tile(tid, win + 3856, INW, p.WmT(), D, kt * 64, nt * 64, tile); continue; }
    u -= tM;
    if (u < tWb) {
      int n = u / ((MW / 64) * (D / 64)), r = u % ((MW / 64) * (D / 64)); int kt = r / (D / 64), nt = r % (D / 64);
      convT_tile(tid, p.w_branch + ((size_t)l * 4 + n) * MW * D, D, p.WbT() + (size_t)n * D * MW, MW, kt * 64, nt * 64, tile); continue;
    }
    u -= tWb;
    if (u < tWo) { int kt = u / (D / 64), nt = u % (D / 64); convT_tile(tid, p.w_out + (size_t)l * D * D, D, p.WoT(), D, kt * 64, nt * 64, tile); continue; }
    u -= tWo;
    if (u < 2 * tE) {
      int which = u / tE; int v = u % tE; int e = v / ((D / 64) * (DE / 64)), r = v % ((D / 64) * (DE / 64)); int kt = r / (DE / 64), nt = r % (DE / 64);
      const float* src = (which ? p.moe_w3 : p.moe_w1) + ((size_t)l * 16 + e) * D * DE;
      bf16_t* dst = (which ? p.W3T() : p.W1T()) + (size_t)e * DE * D;
      convT_tile(tid, src, DE, dst, D, kt * 64, nt * 64, tile); continue;
    }
    u -= 2 * tE;
    { int e = u / ((DE / 64) * (D / 64)), r = u % ((DE / 64) * (D / 64)); int kt = r / (D / 64), nt = r % (D / 64);
      convT_tile(tid, p.moe_w2 + ((size_t)l * 16 + e) * DE * D, D, p.W2T() + (size_t)e * D * DE, DE, kt * 64, nt * 64, tile); }
  }
}

__device__ void phase_norm(const Params& p, int which, char* smem_) {
  const int tid = tidx(p);
  const int lane = tid & 63, wid = tid >> 6, nw = blockDim.x >> 6, fr = lane & 15, fq = lane >> 4;
  const bool last = (p.layer == DEPTH - 1);
  float* slog = (float*)smem_ + wid * (16 * 33);
  for (int rt = blockIdx.x * nw + wid; rt < T / 16; rt += gridDim.x * nw) {
    const int r0 = rt * 16;
    { int s = r0 % TS; if (which == 1 && last && s < CTX) continue; }
    const int row = r0 + fr;
    const float* xr = xrow(p, row);
    float ss = 0.f;
#pragma unroll 4
    for (int ks = 0; ks < D / 32; ++ks) {
      f32x4 a = *(const f32x4*)(xr + ks * 32 + fq * 8), b = *(const f32x4*)(xr + ks * 32 + fq * 8 + 4);
      ss += a[0] * a[0] + a[1] * a[1] + a[2] * a[2] + a[3] * a[3] + b[0] * b[0] + b[1] * b[1] + b[2] * b[2] + b[3] * b[3];
    }
    ss += __shfl_xor(ss, 16, 64); ss += __shfl_xor(ss, 32, 64);
    const float rs = rsqrtf(ss * (1.0f / D) + EPS);
    const float* sh = modrow(p, r0, which ? 3 : 0);
    const float* sc = modrow(p, r0, which ? 4 : 1);
    const bf16_t* W = which ? p.WrtT() : p.WcgT();
    f32x4 acc0 = {0.f, 0.f, 0.f, 0.f}, acc1 = {0.f, 0.f, 0.f, 0.f};
#pragma unroll 2
    for (int ks = 0; ks < D / 32; ++ks) {
      const int k = ks * 32 + fq * 8;
      f32x4 a = *(const f32x4*)(xr + k), b = *(const f32x4*)(xr + k + 4);
      f32x4 s0 = *(const f32x4*)(sh + k), s1 = *(const f32x4*)(sh + k + 4);
      f32x4 c0 = *(const f32x4*)(sc + k), c1 = *(const f32x4*)(sc + k + 4);
      float hv[8];
#pragma unroll
      for (int j = 0; j < 4; ++j) { hv[j] = a[j] * rs * (1.0f + c0[j]) + s0[j]; hv[4 + j] = b[j] * rs * (1.0f + c1[j]) + s1[j]; }
      u32x4 hp; hp[0] = pack2(hv[0], hv[1]); hp[1] = pack2(hv[2], hv[3]); hp[2] = pack2(hv[4], hv[5]); hp[3] = pack2(hv[6], hv[7]);
      *(u32x4*)(p.h() + (size_t)row * D + k) = hp;
      bf16x8 af = __builtin_bit_cast(bf16x8, hp);
      bf16x8 w0 = *(const bf16x8*)(W + (size_t)fr * D + k);
      acc0 = MFMA16(af, w0, acc0);
      if (which) { bf16x8 w1 = *(const bf16x8*)(W + (size_t)(16 + fr) * D + k); acc1 = MFMA16(af, w1, acc1); }
    }
    if (which == 0) {
      const float bias = p.c_gate_b[p.layer * 16 + fr];
#pragma unroll
      for (int r = 0; r < 4; ++r) p.cg()[(size_t)(r0 + fq * 4 + r) * 16 + fr] = acc0[r] + bias;
    } else {
#pragma unroll
      for (int r = 0; r < 4; ++r) { slog[(fq * 4 + r) * 33 + fr] = acc0[r]; slog[(fq * 4 + r) * 33 + 16 + fr] = acc1[r]; }
      WAVE_SYNC();
      if (lane < 16) {
        const float* lg = slog + lane * 33;
        const int r = r0 + lane;
        float ag[4];
#pragma unroll
        for (int g = 0; g < 4; ++g) ag[g] = lg[16 + g] + p.moe_b_group[p.layer * 4 + g];
        int gi = 0; float gm = ag[0];
#pragma unroll
        for (int g = 1; g < 4; ++g) if (ag[g] > gm) { gm = ag[g]; gi = g; }
        float gs = 0.f;
#pragma unroll
        for (int g = 0; g < 4; ++g) gs += expf(ag[g] - gm);
        const float gprob = 1.0f / gs;
        float el[4];
#pragma unroll
        for (int e = 0; e < 4; ++e) el[e] = lg[gi * 4 + e] + p.moe_b_router[p.layer * 16 + gi * 4 + e];
        int i0 = 0; float m0 = el[0];
#pragma unroll
        for (int e = 1; e < 4; ++e) if (el[e] > m0) { m0 = el[e]; i0 = e; }
        int i1 = -1; float m1 = -3.0e38f;
#pragma unroll
        for (int e = 0; e < 4; ++e) if (e != i0 && el[e] > m1) { m1 = el[e]; i1 = e; }
        const float e1 = expf(m1 - m0);
        const float w0 = gprob / (1.0f + e1), w1 = gprob * e1 / (1.0f + e1);
        const int lo = (i0 < i1) ? i0 : i1, hi = (i0 < i1) ? i1 : i0;
        const float wlo = (i0 < i1) ? w0 : w1, whi = (i0 < i1) ? w1 : w0;
        const int pair = (lo == 0) ? (hi - 1) : (lo == 1) ? (hi + 1) : 5;
        const int cls = gi * 6 + pair;
        const int pos = atomicAdd(p.moe_cnt() + (p.layer * 2) * NCLS + cls, 1);
        p.moe_list()[(size_t)cls * T + pos] = r;
        p.moe_tw()[(size_t)r * 2 + 0] = wlo;
        p.moe_tw()[(size_t)r * 2 + 1] = whi;
      }
      WAVE_SYNC();
    }
  }
}

constexpr int LDT = 72;
constexpr int GEMM_STAGE = 128 * LDT;
constexpr int GEMM_SMEM = 2 * 2 * GEMM_STAGE * 2;

struct GemmRegs { u32x4 a[4], b[4]; };

template <class AF, class BF>
__device__ __forceinline__ void gemm_gload(int tid, GemmRegs& g, AF aptr, BF bptr, int k0) {
#pragma unroll
  for (int i = 0; i < 4; ++i) {
    int c = tid + i * 256; int row = c >> 3, kc = (c & 7) * 8;
    g.a[i] = *(const u32x4*)(aptr(row, k0) + kc);
    g.b[i] = *(const u32x4*)(bptr(row, k0) + kc);
  }
}
__device__ __forceinline__ void gemm_sstore(int tid, const GemmRegs& g, bf16_t* sA, bf16_t* sB) {
#pragma unroll
  for (int i = 0; i < 4; ++i) {
    int c = tid + i * 256; int row = c >> 3, kc = (c & 7) * 8;
    *(u32x4*)(sA + row * LDT + kc) = g.a[i];
    *(u32x4*)(sB + row * LDT + kc) = g.b[i];
  }
}
__device__ __forceinline__ void gemm_mma(int tid, f32x4 (&acc)[4][4], const bf16_t* sA, const bf16_t* sB, int wr, int wc) {
  const int lane = tid & 63, fr = lane & 15, fq = lane >> 4;
#pragma unroll
  for (int ks = 0; ks < 2; ++ks) {
    bf16x8 af[4], bfr[4];
#pragma unroll
    for (int m = 0; m < 4; ++m) af[m] = *(const bf16x8*)(sA + (wr * 64 + m * 16 + fr) * LDT + ks * 32 + fq * 8);
#pragma unroll
    for (int n = 0; n < 4; ++n) bfr[n] = *(const bf16x8*)(sB + (wc * 64 + n * 16 + fr) * LDT + ks * 32 + fq * 8);
#pragma unroll
    for (int m = 0; m < 4; ++m)
#pragma unroll
      for (int n = 0; n < 4; ++n) acc[m][n] = MFMA16(bfr[n], af[m], acc[m][n]);
  }
}
template <class AF, class BF>
__device__ __forceinline__ void gemm_kloop(int tid, f32x4 (&acc)[4][4], AF aptr, BF bptr, int K, bf16_t* smem) {
  const int wid = tid >> 6, wr = wid >> 1, wc = wid & 1;
  bf16_t* sA[2] = {smem, smem + 2 * GEMM_STAGE};
  bf16_t* sB[2] = {smem + GEMM_STAGE, smem + 3 * GEMM_STAGE};
  GemmRegs g;
  gemm_gload(tid, g, aptr, bptr, 0);
  __syncthreads();
  gemm_sstore(tid, g, sA[0], sB[0]);
  __syncthreads();
  const int nk = K / 64;
  for (int kt = 0; kt < nk; ++kt) {
    int cur = kt & 1;
    if (kt + 1 < nk) gemm_gload(tid, g, aptr, bptr, (kt + 1) * 64);
    gemm_mma(tid, acc, sA[cur], sB[cur], wr, wc);
    if (kt + 1 < nk) gemm_sstore(tid, g, sA[cur ^ 1], sB[cur ^ 1]);
    __syncthreads();
  }
}
#define ACC_ZERO(acc) _Pragma("unroll") for (int m_ = 0; m_ < 4; ++m_) _Pragma("unroll") for (int n_ = 0; n_ < 4; ++n_) acc[m_][n_] = f32x4{0.f, 0.f, 0.f, 0.f}

__device__ void phase_inproj(const Params& p, char* smem_) {
  const int tid = tidx(p);
  bf16_t* smem = (bf16_t*)smem_;
  const int lane = tid & 63, wid = tid >> 6, wr = wid >> 1, wc = wid & 1, fr = lane & 15, fq = lane >> 4;
  const int ntn = PW / 128;
  for (int t = blockIdx.x; t < MT * ntn; t += gridDim.x) {
    int tm = t / ntn, tn = t % ntn;
    const bf16_t* A = p.h() + (size_t)tm * 128 * D;
    const bf16_t* B = p.WinT() + (size_t)tn * 128 * D;
    f32x4 acc[4][4]; ACC_ZERO(acc);
    gemm_kloop(tid, acc, [&](int row, int k0) { return A + (size_t)row * D + k0; },
               [&](int row, int k0) { return B + (size_t)row * D + k0; }, D, smem);
#pragma unroll
    for (int m = 0; m < 4; ++m)
#pragma unroll
      for (int n = 0; n < 4; ++n) {
        int row = tm * 128 + wr * 64 + m * 16 + fr, col = tn * 128 + wc * 64 + n * 16 + fq * 4;
        u32x2 o; o[0] = pack2(acc[m][n][0], acc[m][n][1]); o[1] = pack2(acc[m][n][2], acc[m][n][3]);
        *(u32x2*)(p.P() + (size_t)row * PW + col) = o;
      }
  }
}


__device__ __forceinline__ void unpack8(u32x4 v, float* dst) {
#pragma unroll
  for (int j = 0; j < 4; ++j) { dst[2 * j] = u2f(v[j] << 16); dst[2 * j + 1] = u2f(v[j] & 0xFFFF0000u); }
}
__device__ __forceinline__ int proc_tile(int dir, int idx) { return dir == 0 ? idx : (idx < CT ? CT - 1 - idx : NT - 1 - (idx - CT)); }

constexpr int LT = 64;
constexpr int NLT = TS / LT, CLT = CTX / LT;
__device__ __forceinline__ int proc_ltile(int dir, int idx) { return dir == 0 ? idx : (idx < CLT ? CLT - 1 - idx : NLT - 1 - (idx - CLT)); }
constexpr int LRU_LD = 264;
constexpr int LRU_SMEM = 2 * LT * LRU_LD * 2;
template <bool FINAL, int dir>
__device__ __forceinline__ void lru_dir(int tid, const Params& p, const bf16_t* su, int b, int tile, int hh, int nt, f32x4 (&hsum)[4]) {
  const int lane = tid & 63, fr = lane & 15, fq = lane >> 4;
  const int l = p.layer;
  const int c = hh * 64 + nt * 16 + fr;
  f32x4 ar[4], ai[4];
#pragma unroll
  for (int m = 0; m < 4; ++m) { ar[m] = f32x4{0.f, 0.f, 0.f, 0.f}; ai[m] = f32x4{0.f, 0.f, 0.f, 0.f}; }
  const float* wr_ = p.a_gate_w + ((((size_t)(l * 2 + dir) * 2 + 0) * NH + hh) * 64) * 64;
  const float* wi_ = p.a_gate_w + ((((size_t)(l * 2 + dir) * 2 + 1) * NH + hh) * 64) * 64;
#pragma unroll
  for (int ks = 0; ks < 2; ++ks) {
    bf16x8 br, bi;
#pragma unroll
    for (int e = 0; e < 8; ++e) {
      int k = ks * 32 + fq * 8 + e;
      br[e] = (short)f2bf(wr_[k * 64 + nt * 16 + fr]);
      bi[e] = (short)f2bf(wi_[k * 64 + nt * 16 + fr]);
    }
#pragma unroll
    for (int m = 0; m < 4; ++m) {
      bf16x8 af = *(const bf16x8*)(su + (m * 16 + fr) * LRU_LD + hh * 64 + ks * 32 + fq * 8);
      ar[m] = MFMA16(af, br, ar[m]);
      ai[m] = MFMA16(af, bi, ai[m]);
    }
  }
  const float b_r = p.a_gate_b[((l * 2 + dir) * 2 + 0) * MW + c], b_i = p.a_gate_b[((l * 2 + dir) * 2 + 1) * MW + c];
  const float lsl = 8.0f * logsigf_(p.a_lambda[(l * 2 + dir) * MW + c]);
#pragma unroll
  for (int m = 0; m < 4; ++m)
#pragma unroll
    for (int r = 0; r < 4; ++r) {
      int i = m * 16 + fq * 4 + r;
      float rg = fsigmoid(ar[m][r] + b_r), ig = fsigmoid(ai[m][r] + b_i);
      float la = lsl * rg;
      float uv = bf2f(su[i * LRU_LD + c]);
      float t2 = 2.0f * la;
      float om_s = -t2 * (1.0f + t2 * (0.5f + t2 * (0.16666667f + t2 * (0.041666668f + t2 * 0.0083333338f)))), om_e = 1.0f - fexp(t2);
      float om = (t2 > -0.25f) ? om_s : om_e;
      ar[m][r] = fexp(la);
      ai[m][r] = fsqrt(om) * ig * uv;
    }
  float carry = 0.f, atot = 1.f;
  if (FINAL) carry = p.lruC()[(((size_t)b * 2 + dir) * NLT + tile) * 256 + c];
#pragma unroll
  for (int mm = 0; mm < 4; ++mm) {
    const int m = dir ? 3 - mm : mm;
    float pa[4], hl[4];
    if (dir == 0) {
      pa[0] = ar[m][0]; hl[0] = ai[m][0];
#pragma unroll
      for (int r = 1; r < 4; ++r) { pa[r] = pa[r - 1] * ar[m][r]; hl[r] = ar[m][r] * hl[r - 1] + ai[m][r]; }
    } else {
      pa[3] = ar[m][3]; hl[3] = ai[m][3];
#pragma unroll
      for (int r = 2; r >= 0; --r) { pa[r] = pa[r + 1] * ar[m][r]; hl[r] = ar[m][r] * hl[r + 1] + ai[m][r]; }
    }
    const float gp = dir ? pa[0] : pa[3], gh = dir ? hl[0] : hl[3];
    float Pg[4], Hg[4];
#pragma unroll
    for (int g = 0; g < 4; ++g) { Pg[g] = __shfl(gp, fr + 16 * g, 64); Hg[g] = __shfl(gh, fr + 16 * g, 64); }
    float cin = carry;
#pragma unroll
    for (int gg = 0; gg < 4; ++gg) {
      const int g = dir ? 3 - gg : gg;
      bool before = dir ? (g > fq) : (g < fq);
      if (before) cin = Pg[g] * cin + Hg[g];
      carry = Pg[g] * carry + Hg[g];
      atot *= Pg[g];
    }
    if (FINAL) {
#pragma unroll
      for (int r = 0; r < 4; ++r) hsum[m][r] += hl[r] + pa[r] * cin;
    }
  }
  if (!FINAL && fq == 0) {
    float* S = p.lruS() + ((((size_t)b * 2 + dir) * NLT + tile) * 2) * 256;
    S[c] = atot; S[256 + c] = carry;
  }
}
template <bool FINAL>
__device__ void phase_lru(const Params& p, char* smem_) {
  const int tid = tidx(p);
  bf16_t* su = (bf16_t*)smem_;
  bf16_t* gy = su + LT * LRU_LD;
  const int lane = tid & 63, hh = tid >> 6, fr = lane & 15, fq = lane >> 4;
  const int l = p.layer;
  for (int t = blockIdx.x; t < NB * NLT; t += gridDim.x) {
    const int b = t / NLT, tile = t % NLT;
    const int s0 = tile * LT;
    const int seg_lo = (tile < CLT) ? 0 : CTX, seg_hi = (tile < CLT) ? CTX : TS;
    __syncthreads();
    {
      const int cc = tid & 31, tg = tid >> 5;
      const int c0 = cc * 8;
      float w[4][8], bias[8];
#pragma unroll
      for (int k = 0; k < 4; ++k)
#pragma unroll
        for (int j = 0; j < 8; ++j) w[k][j] = p.a_conv_w[(l * 4 + k) * MW + c0 + j];
#pragma unroll
      for (int j = 0; j < 8; ++j) bias[j] = p.a_conv_b[l * MW + c0 + j];
      float win[4][8];
      auto loadrow = [&](int s, float (&dst)[8]) {
        const bool ok = (s >= seg_lo && s < seg_hi);
        const int sc_ = s < seg_lo ? seg_lo : (s >= seg_hi ? seg_hi - 1 : s);
        u32x4 v = *(const u32x4*)(p.P() + ((size_t)b * TS + sc_) * PW + C_AX * 256 + c0);
#pragma unroll
        for (int j = 0; j < 4; ++j) { if (!ok) v[j] = 0u; dst[2 * j] = u2f(v[j] << 16); dst[2 * j + 1] = u2f(v[j] & 0xFFFF0000u); }
      };
      const int i0 = tg * 8;
      loadrow(s0 + i0 - 2, win[0]); loadrow(s0 + i0 - 1, win[1]); loadrow(s0 + i0, win[2]);
#pragma unroll
      for (int i = 0; i < 8; ++i) {
        loadrow(s0 + i0 + i + 1, win[3]);
        float o[8];
#pragma unroll
        for (int j = 0; j < 8; ++j) o[j] = bias[j] + w[0][j] * win[0][j] + w[1][j] * win[1][j] + w[2][j] * win[2][j] + w[3][j] * win[3][j];
        u32x4 ov; ov[0] = pack2(o[0], o[1]); ov[1] = pack2(o[2], o[3]); ov[2] = pack2(o[4], o[5]); ov[3] = pack2(o[6], o[7]);
        *(u32x4*)(su + (i0 + i) * LRU_LD + c0) = ov;
#pragma unroll
        for (int j = 0; j < 8; ++j) { win[0][j] = win[1][j]; win[1][j] = win[2][j]; win[2][j] = win[3][j]; }
        if (FINAL) {
          float g[8]; unpack8(*(const u32x4*)(p.P() + ((size_t)b * TS + s0 + i0 + i) * PW + C_AG * 256 + c0), g);
          u32x4 gv; gv[0] = pack2(geluf_(g[0]), geluf_(g[1])); gv[1] = pack2(geluf_(g[2]), geluf_(g[3])); gv[2] = pack2(geluf_(g[4]), geluf_(g[5])); gv[3] = pack2(geluf_(g[6]), geluf_(g[7]));
          *(u32x4*)(gy + (i0 + i) * LRU_LD + c0) = gv;
        }
      }
    }
    __syncthreads();
#pragma unroll 1
    for (int nt = 0; nt < 4; ++nt) {
      const int c = hh * 64 + nt * 16 + fr;
      f32x4 hsum[4];
#pragma unroll
      for (int m = 0; m < 4; ++m) hsum[m] = f32x4{0.f, 0.f, 0.f, 0.f};
      lru_dir<FINAL, 0>(tid, p, su, b, tile, hh, nt, hsum);
      lru_dir<FINAL, 1>(tid, p, su, b, tile, hh, nt, hsum);
      if (FINAL) {
#pragma unroll
        for (int m = 0; m < 4; ++m)
#pragma unroll
          for (int r = 0; r < 4; ++r) {
            int i = m * 16 + fq * 4 + r;
            gy[i * LRU_LD + c] = f2bf(bf2f(gy[i * LRU_LD + c]) * hsum[m][r]);
          }
      }
    }
    if (FINAL) {
      __syncthreads();
#pragma unroll
      for (int q = 0; q < 8; ++q) {
        int ch = tid + q * 256; int i = ch >> 5, c0 = (ch & 31) * 8;
        *(u32x4*)(p.y() + ((size_t)b * TS + s0 + i) * (4 * MW) + c0) = *(const u32x4*)(gy + i * LRU_LD + c0);
      }
    }
  }
}
__device__ void phase_lru_carry(const Params& p) {
  const int tid = tidx(p);
  for (int i = blockIdx.x * blockDim.x + tid; i < NB * 2 * 256; i += gridDim.x * blockDim.x) {
    int c = i & 255, dir = (i >> 8) & 1, b = i >> 9;
    float hcar = 0.f;
    for (int k = 0; k < NLT; ++k) {
      int tile = proc_ltile(dir, k);
      size_t base = ((size_t)b * 2 + dir) * NLT + tile;
      p.lruC()[base * 256 + c] = hcar;
      hcar = p.lruS()[base * 512 + c] * hcar + p.lruS()[base * 512 + 256 + c];
    }
  }
}

constexpr int LDV = 136;
__device__ __forceinline__ void load_rope_row(const Params& p, const bf16_t* src, int s, int half, float scale, float* o) {
  unpack8(*(const u32x4*)(src + half * 16), o);
  unpack8(*(const u32x4*)(src + half * 16 + 8), o + 8);
  unpack8(*(const u32x4*)(src + 32 + half * 16), o + 16);
  unpack8(*(const u32x4*)(src + 32 + half * 16 + 8), o + 24);
  if (s >= CTX) {
    const f32x4* tb = (const f32x4*)(p.rope() + ((size_t)(s - CTX) * 32 + half * 16) * 2);
#pragma unroll
    for (int i = 0; i < 8; ++i) {
      f32x4 cs = tb[i];
      float t1 = o[2 * i], t2 = o[16 + 2 * i];
      o[2 * i] = (t1 * cs[0] - t2 * cs[1]) * scale; o[16 + 2 * i] = (t1 * cs[1] + t2 * cs[0]) * scale;
      t1 = o[2 * i + 1]; t2 = o[16 + 2 * i + 1];
      o[2 * i + 1] = (t1 * cs[2] - t2 * cs[3]) * scale; o[16 + 2 * i + 1] = (t1 * cs[3] + t2 * cs[2]) * scale;
    }
  } else {
#pragma unroll
    for (int i = 0; i < 32; ++i) o[i] *= scale;
  }
}
constexpr int RETA_SMEM = 3 * 64 * LDV * 2;
__device__ void phase_ret_a(const Params& p, char* smem_) {
  const int tid = tidx(p);
  bf16_t* Vt = (bf16_t*)smem_; bf16_t* Ktf = Vt + 64 * LDV; bf16_t* Ktb = Ktf + 64 * LDV;
  const int lane = tid & 63, wid = tid >> 6, fr = lane & 15, fq = lane >> 4;
  const int l = p.layer;
  for (int t = blockIdx.x; t < NB * NH * NT; t += gridDim.x) {
    const int tile = t % NT, hh = (t / NT) % NH, b = t / (NT * NH);
    const float lgf = logsigf_(p.b_theta[(l * 2 + 0) * NH + hh]) * 1.4426950408889634f;
    const float lgb = logsigf_(p.b_theta[(l * 2 + 1) * NH + hh]) * 1.4426950408889634f;
    __syncthreads();
    {
      const int j = tid >> 1, half = tid & 1;
      const int s = tile * 128 + j;
      const bf16_t* prow = p.P() + ((size_t)b * TS + s) * PW;
      float k[32];
      load_rope_row(p, prow + C_BK * 256 + hh * 64, s, half, 0.125f, k);
      const float wf = exp2f(lgf * (float)(127 - j)), wb = exp2f(lgb * (float)j);
#pragma unroll
      for (int i = 0; i < 32; ++i) {
        int d = (i < 16) ? (half * 16 + i) : (32 + half * 16 + i - 16);
        Ktf[d * LDV + j] = f2bf(k[i] * wf); Ktb[d * LDV + j] = f2bf(k[i] * wb);
      }
      float v[32];
      unpack8(*(const u32x4*)(prow + C_BV * 256 + hh * 64 + half * 32), v);
      unpack8(*(const u32x4*)(prow + C_BV * 256 + hh * 64 + half * 32 + 8), v + 8);
      unpack8(*(const u32x4*)(prow + C_BV * 256 + hh * 64 + half * 32 + 16), v + 16);
      unpack8(*(const u32x4*)(prow + C_BV * 256 + hh * 64 + half * 32 + 24), v + 24);
#pragma unroll
      for (int i = 0; i < 32; ++i) Vt[(half * 32 + i) * LDV + j] = f2bf(v[i]);
    }
    __syncthreads();
    f32x4 acc[2][4];
#pragma unroll
    for (int d = 0; d < 2; ++d)
#pragma unroll
      for (int n = 0; n < 4; ++n) acc[d][n] = f32x4{0.f, 0.f, 0.f, 0.f};
#pragma unroll
    for (int ks = 0; ks < 4; ++ks) {
      bf16x8 af = *(const bf16x8*)(Vt + (wid * 16 + fr) * LDV + ks * 32 + fq * 8);
#pragma unroll
      for (int n = 0; n < 4; ++n) {
        bf16x8 b0 = *(const bf16x8*)(Ktf + (n * 16 + fr) * LDV + ks * 32 + fq * 8);
        bf16x8 b1 = *(const bf16x8*)(Ktb + (n * 16 + fr) * LDV + ks * 32 + fq * 8);
        acc[0][n] = MFMA16(af, b0, acc[0][n]);
        acc[1][n] = MFMA16(af, b1, acc[1][n]);
      }
    }
#pragma unroll
    for (int d = 0; d < 2; ++d) {
      float* dst = p.retKV() + ((((size_t)b * NH + hh) * 2 + d) * NT + tile) * 4096;
#pragma unroll
      for (int n = 0; n < 4; ++n)
#pragma unroll
        for (int r = 0; r < 4; ++r) dst[(wid * 16 + fq * 4 + r) * 64 + n * 16 + fr] = acc[d][n][r];
    }
  }
}
__device__ void phase_ret_b(const Params& p) {
  const int tid = tidx(p);
  const int l = p.layer;
  for (int i = blockIdx.x * blockDim.x + tid; i < NB * NH * 2 * 4096; i += gridDim.x * blockDim.x) {
    int el = i & 4095, dir = (i >> 12) & 1, hh = (i >> 13) % NH, b = i / (8192 * NH);
    float g = expf(128.0f * logsigf_(p.b_theta[(l * 2 + dir) * NH + hh]));
    size_t base = (((size_t)b * NH + hh) * 2 + dir) * NT;
    float S = 0.f;
    for (int k = 0; k < NT; ++k) {
      int tile = proc_tile(dir, k);
      p.retSp()[(base + tile) * 4096 + el] = f2bf(S);
      S = g * S + p.retKV()[(base + tile) * 4096 + el];
    }
  }
}
__device__ __forceinline__ bf16x8 frag_perm8(const bf16_t* base, int fq) {
  u32x2 lo = *(const u32x2*)(base + 4 * fq), hi = *(const u32x2*)(base + 16 + 4 * fq);
  u32x4 v; v[0] = lo[0]; v[1] = lo[1]; v[2] = hi[0]; v[3] = hi[1];
  return __builtin_bit_cast(bf16x8, v);
}
__device__ __forceinline__ bf16x8 pack_frag(f32x4 a, f32x4 b) {
  u32x4 v; v[0] = pack2(a[0], a[1]); v[1] = pack2(a[2], a[3]); v[2] = pack2(b[0], b[1]); v[3] = pack2(b[2], b[3]);
  return __builtin_bit_cast(bf16x8, v);
}
constexpr int RETC_SMEM = (2 * 128 * LDT + 64 * LDV + 2 * 64 * LDT) * 2;
__device__ void phase_ret_c(const Params& p, char* smem_) {
  const int tid = tidx(p);
  bf16_t* Qs = (bf16_t*)smem_; bf16_t* Ks = Qs + 128 * LDT; bf16_t* Vt = Ks + 128 * LDT;
  bf16_t* Spf = Vt + 64 * LDV; bf16_t* Spb = Spf + 64 * LDT;
  const int lane = tid & 63, wid = tid >> 6, fr = lane & 15, fq = lane >> 4;
  const int l = p.layer;
  for (int t = blockIdx.x; t < NB * NH * NT; t += gridDim.x) {
    const int tile = t % NT, hh = (t / NT) % NH, b = t / (NT * NH);
    const float lgf = logsigf_(p.b_theta[(l * 2 + 0) * NH + hh]) * 1.4426950408889634f;
    const float lgb = logsigf_(p.b_theta[(l * 2 + 1) * NH + hh]) * 1.4426950408889634f;
    __syncthreads();
    {
      const int j = tid >> 1, half = tid & 1;
      const int s = tile * 128 + j;
      const bf16_t* prow = p.P() + ((size_t)b * TS + s) * PW;
      float k[32];
      load_rope_row(p, prow + C_BQ * 256 + hh * 64, s, half, 1.0f, k);
#pragma unroll
      for (int c = 0; c < 4; ++c) {
        u32x4 v; v[0] = pack2(k[c * 8 + 0], k[c * 8 + 1]); v[1] = pack2(k[c * 8 + 2], k[c * 8 + 3]); v[2] = pack2(k[c * 8 + 4], k[c * 8 + 5]); v[3] = pack2(k[c * 8 + 6], k[c * 8 + 7]);
        int d0 = (c < 2) ? (half * 16 + c * 8) : (32 + half * 16 + (c - 2) * 8);
        *(u32x4*)(Qs + j * LDT + d0) = v;
      }
      load_rope_row(p, prow + C_BK * 256 + hh * 64, s, half, 0.125f, k);
#pragma unroll
      for (int c = 0; c < 4; ++c) {
        u32x4 v; v[0] = pack2(k[c * 8 + 0], k[c * 8 + 1]); v[1] = pack2(k[c * 8 + 2], k[c * 8 + 3]); v[2] = pack2(k[c * 8 + 4], k[c * 8 + 5]); v[3] = pack2(k[c * 8 + 6], k[c * 8 + 7]);
        int d0 = (c < 2) ? (half * 16 + c * 8) : (32 + half * 16 + (c - 2) * 8);
        *(u32x4*)(Ks + j * LDT + d0) = v;
      }
#pragma unroll
      for (int c = 0; c < 4; ++c) {
        u32x4 v = *(const u32x4*)(prow + C_BV * 256 + hh * 64 + half * 32 + c * 8);
#pragma unroll
        for (int q = 0; q < 4; ++q) {
          Vt[(half * 32 + c * 8 + 2 * q) * LDV + j] = (bf16_t)(v[q] & 0xFFFFu);
          Vt[(half * 32 + c * 8 + 2 * q + 1) * LDV + j] = (bf16_t)(v[q] >> 16);
        }
      }
      const bf16_t* spf = p.retSp() + ((((size_t)b * NH + hh) * 2 + 0) * NT + tile) * 4096;
      const bf16_t* spb = p.retSp() + ((((size_t)b * NH + hh) * 2 + 1) * NT + tile) * 4096;
#pragma unroll
      for (int i = 0; i < 2; ++i) {
        int c = tid + i * 256; int e = c >> 3, d0 = (c & 7) * 8;
        *(u32x4*)(Spf + e * LDT + d0) = *(const u32x4*)(spf + e * 64 + d0);
        *(u32x4*)(Spb + e * LDT + d0) = *(const u32x4*)(spb + e * 64 + d0);
      }
    }
    __syncthreads();
#pragma unroll 1
    for (int mi = 0; mi < 2; ++mi) {
      NO_HOIST();
      const int i = wid * 32 + mi * 16 + fr;
      f32x4 sc[8];
#pragma unroll
      for (int nj = 0; nj < 8; ++nj) sc[nj] = f32x4{0.f, 0.f, 0.f, 0.f};
      f32x4 ao[4], af_[4], ab_[4];
#pragma unroll
      for (int n = 0; n < 4; ++n) { ao[n] = f32x4{0.f, 0.f, 0.f, 0.f}; af_[n] = ao[n]; ab_[n] = ao[n]; }
#pragma unroll
      for (int ks = 0; ks < 2; ++ks) {
        bf16x8 qf = *(const bf16x8*)(Qs + i * LDT + ks * 32 + fq * 8);
#pragma unroll
        for (int nj = 0; nj < 8; ++nj) {
          bf16x8 kf = *(const bf16x8*)(Ks + (nj * 16 + fr) * LDT + ks * 32 + fq * 8);
          sc[nj] = MFMA16(kf, qf, sc[nj]);
        }
#pragma unroll
        for (int n = 0; n < 4; ++n) {
          bf16x8 s0 = *(const bf16x8*)(Spf + (n * 16 + fr) * LDT + ks * 32 + fq * 8);
          bf16x8 s1 = *(const bf16x8*)(Spb + (n * 16 + fr) * LDT + ks * 32 + fq * 8);
          af_[n] = MFMA16(s0, qf, af_[n]); ab_[n] = MFMA16(s1, qf, ab_[n]);
        }
      }
#pragma unroll
      for (int nj = 0; nj < 8; ++nj)
#pragma unroll
        for (int r = 0; r < 4; ++r) {
          int j = nj * 16 + fq * 4 + r;
          float fd = (float)(i - j);
          sc[nj][r] *= fexp2(fminf(lgf * fd, -lgb * fd));
        }
#pragma unroll
      for (int ks = 0; ks < 4; ++ks) {
        bf16x8 sf = pack_frag(sc[2 * ks], sc[2 * ks + 1]);
#pragma unroll
        for (int n = 0; n < 4; ++n) {
          bf16x8 vf = frag_perm8(Vt + (n * 16 + fr) * LDV + ks * 32, fq);
          ao[n] = MFMA16(vf, sf, ao[n]);
        }
      }
      const float sfw = fexp2(lgf * (float)(i + 1)), sbw = fexp2(lgb * (float)(128 - i));
      float o[4][4]; float sum = 0.f;
#pragma unroll
      for (int n = 0; n < 4; ++n)
#pragma unroll
        for (int r = 0; r < 4; ++r) { o[n][r] = ao[n][r] + sfw * af_[n][r] + sbw * ab_[n][r]; sum += o[n][r]; }
      sum += __shfl_xor(sum, 16, 64); sum += __shfl_xor(sum, 32, 64);
      const float mean = sum * (1.0f / 64.0f);
      float var = 0.f;
#pragma unroll
      for (int n = 0; n < 4; ++n)
#pragma unroll
        for (int r = 0; r < 4; ++r) { o[n][r] -= mean; var += o[n][r] * o[n][r]; }
      var += __shfl_xor(var, 16, 64); var += __shfl_xor(var, 32, 64);
      const float rs = rsqrtf(var * (1.0f / 64.0f) + EPS);
      const size_t row = (size_t)b * TS + tile * 128 + i;
#pragma unroll
      for (int n = 0; n < 4; ++n) {
        int e = n * 16 + fq * 4;
        u32x2 gv = *(const u32x2*)(p.P() + row * PW + C_BG * 256 + hh * 64 + e);
        float g0 = u2f(gv[0] << 16), g1 = u2f(gv[0] & 0xFFFF0000u), g2 = u2f(gv[1] << 16), g3 = u2f(gv[1] & 0xFFFF0000u);
        u32x2 ov; ov[0] = pack2(o[n][0] * rs * fsilu(g0), o[n][1] * rs * fsilu(g1)); ov[1] = pack2(o[n][2] * rs * fsilu(g2), o[n][3] * rs * fsilu(g3));
        *(u32x2*)(p.y() + row * (4 * MW) + 1 * MW + hh * 64 + e) = ov;
      }
    }
  }
}

__device__ __forceinline__ void conv_silu8(const Params& p, int b, int s, int seg_lo, int seg_hi, int cb, int cw, int ch0, float scale, float* o) {
  const int l = p.layer;
  {
    f32x4 b0 = *(const f32x4*)(p.c_conv_b + l * 512 + cw + ch0), b1 = *(const f32x4*)(p.c_conv_b + l * 512 + cw + ch0 + 4);
#pragma unroll
    for (int j = 0; j < 4; ++j) { o[j] = b0[j]; o[4 + j] = b1[j]; }
  }
#pragma unroll
  for (int k = 0; k < 4; ++k) {
    int sk = s + k - 2;
    const float msk = (sk >= seg_lo && sk < seg_hi) ? 1.0f : 0.0f;
    const int skc = sk < seg_lo ? seg_lo : (sk >= seg_hi ? seg_hi - 1 : sk);
    {
      float v[8]; unpack8(*(const u32x4*)(p.P() + ((size_t)b * TS + skc) * PW + cb * 256 + ch0), v);
      const float* w = p.c_conv_w + (size_t)(l * 4 + k) * 512 + cw + ch0;
      f32x4 w0 = *(const f32x4*)w * msk, w1 = *(const f32x4*)(w + 4) * msk;
#pragma unroll
      for (int j = 0; j < 4; ++j) { o[j] += w0[j] * v[j]; o[4 + j] += w1[j] * v[4 + j]; }
    }
  }
#pragma unroll
  for (int j = 0; j < 8; ++j) o[j] = fsilu(o[j]) * scale;
}
__device__ __forceinline__ void mls_gates(int tid, const Params& p, int b, int tile, int hh, float* cumf, float* cumb, float* lif, float* lib) {
  const int tdx = tid;
  {
    int i = tdx & 127; const float* g = p.cg() + ((size_t)b * TS + tile * 128 + i) * 16;
    if (tdx < 128) { lif[i] = g[0 * 4 + hh]; cumf[i] = logsigf_(g[1 * 4 + hh]); }
    else { lib[i] = g[2 * 4 + hh]; cumb[i] = logsigf_(g[3 * 4 + hh]); }
  }
  __syncthreads();
  for (int off = 1; off < 128; off <<= 1) {
    float v = 0.f; int i = tdx & 127;
    if (tdx < 128) { if (i >= off) v = cumf[i - off]; } else { if (i + off < 128) v = cumb[i + off]; }
    __syncthreads();
    if (tdx < 128) cumf[i] += v; else cumb[i] += v;
    __syncthreads();
  }
}
constexpr int MLSA_SMEM = (80 * LDV + 2 * 64 * LDV) * 2 + 4 * 128 * 4;
__device__ void phase_mls_a(const Params& p, char* smem_) {
  const int tid = tidx(p);
  bf16_t* Vt = (bf16_t*)smem_; bf16_t* Ktf = Vt + 80 * LDV; bf16_t* Ktb = Ktf + 64 * LDV;
  float* cumf = (float*)(Ktb + 64 * LDV); float* cumb = cumf + 128; float* lif = cumb + 128; float* lib = lif + 128;
  const int lane = tid & 63, wid = tid >> 6, fr = lane & 15, fq = lane >> 4;
  for (int t = blockIdx.x; t < NB * NH * NT; t += gridDim.x) {
    const int tile = t % NT, hh = (t / NT) % NH, b = t / (NT * NH);
    const int seg_lo = (tile < CT) ? 0 : CTX, seg_hi = (tile < CT) ? CTX : TS;
    __syncthreads();
    mls_gates(tid, p, b, tile, hh, cumf, cumb, lif, lib);
    {
      const int j = tid >> 1, half = tid & 1;
      const int s = tile * 128 + j;
      const float wf = expf(cumf[127] - cumf[j] + lif[j]), wb = expf(cumb[0] - cumb[j] + lib[j]);
#pragma unroll 1
      for (int c = 0; c < 4; ++c) {
        NO_HOIST();
        float k[8];
        conv_silu8(p, b, s, seg_lo, seg_hi, C_CK, 256, hh * 64 + half * 32 + c * 8, 0.125f, k);
#pragma unroll
        for (int i = 0; i < 8; ++i) { Ktf[(half * 32 + c * 8 + i) * LDV + j] = f2bf(k[i] * wf); Ktb[(half * 32 + c * 8 + i) * LDV + j] = f2bf(k[i] * wb); }
      }
      const bf16_t* prow = p.P() + ((size_t)b * TS + s) * PW + C_CV * 256 + hh * 64 + half * 32;
#pragma unroll
      for (int c = 0; c < 4; ++c) {
        u32x4 v = *(const u32x4*)(prow + c * 8);
#pragma unroll
        for (int q = 0; q < 4; ++q) {
          Vt[(half * 32 + c * 8 + 2 * q) * LDV + j] = (bf16_t)(v[q] & 0xFFFFu);
          Vt[(half * 32 + c * 8 + 2 * q + 1) * LDV + j] = (bf16_t)(v[q] >> 16);
        }
      }
#pragma unroll
      for (int e = 0; e < 8; ++e) Vt[(64 + half * 8 + e) * LDV + j] = (half == 0 && e == 0) ? (bf16_t)0x3F80 : (bf16_t)0;
    }
    __syncthreads();
    for (int mt = wid; mt < 5; mt += 4) {
      f32x4 acc[2][4];
#pragma unroll
      for (int d = 0; d < 2; ++d)
#pragma unroll
        for (int n = 0; n < 4; ++n) acc[d][n] = f32x4{0.f, 0.f, 0.f, 0.f};
#pragma unroll
      for (int ks = 0; ks < 4; ++ks) {
        bf16x8 af = *(const bf16x8*)(Vt + (mt * 16 + fr) * LDV + ks * 32 + fq * 8);
#pragma unroll
        for (int n = 0; n < 4; ++n) {
          bf16x8 b0 = *(const bf16x8*)(Ktf + (n * 16 + fr) * LDV + ks * 32 + fq * 8);
          bf16x8 b1 = *(const bf16x8*)(Ktb + (n * 16 + fr) * LDV + ks * 32 + fq * 8);
          acc[0][n] = MFMA16(af, b0, acc[0][n]);
          acc[1][n] = MFMA16(af, b1, acc[1][n]);
        }
      }
#pragma unroll
      for (int d = 0; d < 2; ++d) {
        float* dst = p.mlC() + ((((size_t)b * NH + hh) * 2 + d) * NT + tile) * (80 * 64);
#pragma unroll
        for (int n = 0; n < 4; ++n)
#pragma unroll
          for (int r = 0; r < 4; ++r) dst[(mt * 16 + fq * 4 + r) * 64 + n * 16 + fr] = acc[d][n][r];
      }
    }
    if (tid < 2) p.mlCe()[(((size_t)b * NH + hh) * 2 + tid) * NT + tile] = tid ? cumb[0] : cumf[127];
  }
}
__device__ void phase_mls_b(const Params& p) {
  const int tid = tidx(p);
  const int NE = 80 * 64;
  for (int i = blockIdx.x * blockDim.x + tid; i < NB * NH * 2 * NE; i += gridDim.x * blockDim.x) {
    int el = i % NE, chain = i / NE;
    int dir = chain & 1;
    size_t base = (size_t)chain * NT;
    float S = 0.f;
    for (int k = 0; k < NT; ++k) {
      int tile = proc_tile(dir, k);
      p.mlSp()[(base + tile) * NE + el] = f2bf(S);
      S = expf(p.mlCe()[base + tile]) * S + p.mlC()[(base + tile) * NE + el];
    }
  }
}
constexpr int MLSC_SMEM = (2 * 128 * LDT + 64 * LDV + 2 * 80 * LDT) * 2 + 4 * 128 * 4;
__device__ void phase_mls_c(const Params& p, char* smem_) {
  const int tid = tidx(p);
  bf16_t* Qs = (bf16_t*)smem_; bf16_t* Ks = Qs + 128 * LDT; bf16_t* Vt = Ks + 128 * LDT;
  bf16_t* Cpf = Vt + 64 * LDV; bf16_t* Cpb = Cpf + 80 * LDT;
  float* cumf = (float*)(Cpb + 80 * LDT); float* cumb = cumf + 128; float* lif = cumb + 128; float* lib = lif + 128;
  const int lane = tid & 63, wid = tid >> 6, fr = lane & 15, fq = lane >> 4;
  for (int t = blockIdx.x; t < NB * NH * NT; t += gridDim.x) {
    const int tile = t % NT, hh = (t / NT) % NH, b = t / (NT * NH);
    const int seg_lo = (tile < CT) ? 0 : CTX, seg_hi = (tile < CT) ? CTX : TS;
    __syncthreads();
    mls_gates(tid, p, b, tile, hh, cumf, cumb, lif, lib);
    if (tid < 128) lif[tid] -= cumf[tid]; else lib[tid - 128] -= cumb[tid - 128];
    {
      const int j = tid >> 1, half = tid & 1;
      const int s = tile * 128 + j;
#pragma unroll 1
      for (int c = 0; c < 8; ++c) {
        NO_HOIST();
        const int isk = c >> 2, cc = c & 3;
        float k[8];
        conv_silu8(p, b, s, seg_lo, seg_hi, isk ? C_CK : C_CQ, isk ? 256 : 0, hh * 64 + half * 32 + cc * 8, isk ? 0.125f : 1.0f, k);
        u32x4 v; v[0] = pack2(k[0], k[1]); v[1] = pack2(k[2], k[3]); v[2] = pack2(k[4], k[5]); v[3] = pack2(k[6], k[7]);
        *(u32x4*)((isk ? Ks : Qs) + j * LDT + half * 32 + cc * 8) = v;
      }
      const bf16_t* prow = p.P() + ((size_t)b * TS + s) * PW + C_CV * 256 + hh * 64 + half * 32;
#pragma unroll
      for (int c = 0; c < 4; ++c) {
        u32x4 v = *(const u32x4*)(prow + c * 8);
#pragma unroll
        for (int q = 0; q < 4; ++q) {
          Vt[(half * 32 + c * 8 + 2 * q) * LDV + j] = (bf16_t)(v[q] & 0xFFFFu);
          Vt[(half * 32 + c * 8 + 2 * q + 1) * LDV + j] = (bf16_t)(v[q] >> 16);
        }
      }
      const bf16_t* spf = p.mlSp() + ((((size_t)b * NH + hh) * 2 + 0) * NT + tile) * (80 * 64);
      const bf16_t* spb = p.mlSp() + ((((size_t)b * NH + hh) * 2 + 1) * NT + tile) * (80 * 64);
      for (int c = tid; c < 80 * 8; c += 256) {
        int e = c >> 3, d0 = (c & 7) * 8;
        *(u32x4*)(Cpf + e * LDT + d0) = *(const u32x4*)(spf + e * 64 + d0);
        *(u32x4*)(Cpb + e * LDT + d0) = *(const u32x4*)(spb + e * 64 + d0);
      }
    }
    __syncthreads();
#pragma unroll 1
    for (int mi = 0; mi < 2; ++mi) {
      NO_HOIST();
      const int i = wid * 32 + mi * 16 + fr;
      f32x4 sc[8];
#pragma unroll
      for (int nj = 0; nj < 8; ++nj) sc[nj] = f32x4{0.f, 0.f, 0.f, 0.f};
#pragma unroll
      for (int ks = 0; ks < 2; ++ks) {
        bf16x8 qf = *(const bf16x8*)(Qs + i * LDT + ks * 32 + fq * 8);
#pragma unroll
        for (int nj = 0; nj < 8; ++nj) {
          bf16x8 kf = *(const bf16x8*)(Ks + (nj * 16 + fr) * LDT + ks * 32 + fq * 8);
          sc[nj] = MFMA16(kf, qf, sc[nj]);
        }
      }
      float hsum[4][4];
#pragma unroll
      for (int n = 0; n < 4; ++n)
#pragma unroll
        for (int r = 0; r < 4; ++r) hsum[n][r] = 0.f;
#pragma unroll 1
      for (int dir = 0; dir < 2; ++dir) {
        NO_HOIST();
        const float* cum = dir ? cumb : cumf; const float* li = dir ? lib : lif; const bf16_t* Cp = dir ? Cpb : Cpf;
        const float ci = cum[i];
        f32x4 sd[8]; float dsum = 0.f;
#pragma unroll
        for (int nj = 0; nj < 8; ++nj)
#pragma unroll
          for (int r = 0; r < 4; ++r) {
            int j = nj * 16 + fq * 4 + r;
            int dd = dir ? (j - i) : (i - j);
            float v = sc[nj][r] * fexp(ci + li[j] + u2f((unsigned)(dd >> 31) & 0xF149F2CAu));
            sd[nj][r] = v; dsum += v;
          }
        dsum += __shfl_xor(dsum, 16, 64); dsum += __shfl_xor(dsum, 32, 64);
        f32x4 an[4];
#pragma unroll
        for (int n = 0; n < 4; ++n) an[n] = f32x4{0.f, 0.f, 0.f, 0.f};
#pragma unroll
        for (int ks = 0; ks < 4; ++ks) {
          bf16x8 sf = pack_frag(sd[2 * ks], sd[2 * ks + 1]);
#pragma unroll
          for (int n = 0; n < 4; ++n) {
            bf16x8 vf = frag_perm8(Vt + (n * 16 + fr) * LDV + ks * 32, fq);
            an[n] = MFMA16(vf, sf, an[n]);
          }
        }
        f32x4 ai[5];
#pragma unroll
        for (int n = 0; n < 5; ++n) ai[n] = f32x4{0.f, 0.f, 0.f, 0.f};
#pragma unroll
        for (int ks = 0; ks < 2; ++ks) {
          bf16x8 qf = *(const bf16x8*)(Qs + i * LDT + ks * 32 + fq * 8);
#pragma unroll
          for (int n = 0; n < 5; ++n) {
            bf16x8 cf = *(const bf16x8*)(Cp + (n * 16 + fr) * LDT + ks * 32 + fq * 8);
            ai[n] = MFMA16(cf, qf, ai[n]);
          }
        }
        const float ec = fexp(ci);
        float dinter = ai[4][0];
        dinter = __shfl(dinter, fr, 64);
        const float den = dsum + ec * dinter;
        const float inv = 1.0f / fmaxf(fabsf(den), 1.0f);
#pragma unroll
        for (int n = 0; n < 4; ++n)
#pragma unroll
          for (int r = 0; r < 4; ++r) {
            float hv = (an[n][r] + ec * ai[n][r]) * inv;
            hsum[n][r] += hv;
          }
      }
      float sum = 0.f;
#pragma unroll
      for (int n = 0; n < 4; ++n)
#pragma unroll
        for (int r = 0; r < 4; ++r) sum += hsum[n][r];
      sum += __shfl_xor(sum, 16, 64); sum += __shfl_xor(sum, 32, 64);
      const float mean = sum * (1.0f / 64.0f);
      float var = 0.f;
#pragma unroll
      for (int n = 0; n < 4; ++n)
#pragma unroll
        for (int r = 0; r < 4; ++r) { hsum[n][r] -= mean; var += hsum[n][r] * hsum[n][r]; }
      var += __shfl_xor(var, 16, 64); var += __shfl_xor(var, 32, 64);
      const float rs = rsqrtf(var * (1.0f / 64.0f) + EPS);
      const size_t row = (size_t)b * TS + tile * 128 + i;
#pragma unroll
      for (int n = 0; n < 4; ++n) {
        int e = n * 16 + fq * 4;
        u32x2 gv = *(const u32x2*)(p.P() + row * PW + C_CO * 256 + hh * 64 + e);
        float g0 = u2f(gv[0] << 16), g1 = u2f(gv[0] & 0xFFFF0000u), g2 = u2f(gv[1] << 16), g3 = u2f(gv[1] & 0xFFFF0000u);
        u32x2 ov; ov[0] = pack2(hsum[n][0] * rs * fsigmoid(g0), hsum[n][1] * rs * fsigmoid(g1));
        ov[1] = pack2(hsum[n][2] * rs * fsigmoid(g2), hsum[n][3] * rs * fsigmoid(g3));
        *(u32x2*)(p.y() + row * (4 * MW) + 2 * MW + hh * 64 + e) = ov;
      }
    }
  }
}

constexpr int GL_OLD = 68;
constexpr int GL_TLD = 24;
constexpr int GLA_SMEM = 128 * GL_OLD * 4 + 16 * GL_OLD * 4 + 2 * 64 * GL_TLD * 2 + 2 * 16 * LDT * 2 + 64 * GL_TLD * 2 + 3 * 64 * 4;
template <bool FINAL>
__device__ void phase_gla(const Params& p, char* smem_) {
  const int tid = tidx(p);
  float* oacc = (float*)smem_; float* lgf = oacc + 128 * GL_OLD;
  bf16_t* vvT = (bf16_t*)(lgf + 16 * GL_OLD); bf16_t* qe = vvT + 2 * 64 * GL_TLD; bf16_t* ki = qe + 16 * LDT; bf16_t* kdT = ki + 16 * LDT;
  float* Ec = (float*)(kdT + 64 * GL_TLD); float* Em = Ec + 64; float* Et = Em + 64;
  const int lane = tid & 63, wid = tid >> 6, fr = lane & 15, fq = lane >> 4;
  const int l = p.layer;
  const int pi = tid >> 4, pc4 = (tid & 15) * 4;
  for (int t = blockIdx.x; t < NB * NH * NT; t += gridDim.x) {
    const int tile = t % NT, hh = (t / NT) % NH, b = t / (NT * NH);
    float lb4[4];
#pragma unroll
    for (int j = 0; j < 4; ++j) {
      int c = hh * 64 + pc4 + j;
      float mx = -3.0e38f;
      for (int q = 0; q < DEPTH; ++q) mx = fmaxf(mx, p.d_lb[q * MW + c]);
      float den = 0.f, num = 0.f;
      for (int q = 0; q < DEPTH; ++q) { float e = expf(p.d_lb[q * MW + c] - mx); den += e; if (q >= 1 && q <= l) num += e; }
      lb4[j] = num / den;
    }
    __syncthreads();
#pragma unroll 1
    for (int dir = 0; dir < 2; ++dir) {
      const size_t chain = (((size_t)b * NH + hh) * 2 + dir) * NT + tile;
      f32x4 S[4];
#pragma unroll
      for (int mt = 0; mt < 4; ++mt)
#pragma unroll
        for (int r = 0; r < 4; ++r) S[mt][r] = FINAL ? p.glSp()[chain * 4096 + (mt * 16 + fq * 4 + r) * 64 + wid * 16 + fr] : 0.f;
      if (tid < 64) Et[tid] = 1.0f;
      u32x2 rq, rf, rv;
      auto gload = [&](int k) {
        int sc_ = dir ? 7 - k : k; int i = dir ? 15 - pi : pi;
        const bf16_t* prow = p.P() + ((size_t)b * TS + tile * 128 + sc_ * 16 + i) * PW + hh * 64 + pc4;
        rq = *(const u32x2*)(prow + C_DQ * 256); rf = *(const u32x2*)(prow + (dir ? C_DFB : C_DFF) * 256); rv = *(const u32x2*)(prow + C_DI * 256);
      };
      gload(0);
#pragma unroll 1
      for (int k = 0; k < 8; ++k) {
        const int sc_ = dir ? 7 - k : k;
        bf16_t* vT = vvT + (k & 1) * 64 * GL_TLD;
        float kk4[4], qq4[4];
        {
          float zq[4] = {u2f(rq[0] << 16), u2f(rq[0] & 0xFFFF0000u), u2f(rq[1] << 16), u2f(rq[1] & 0xFFFF0000u)};
          float zf[4] = {u2f(rf[0] << 16), u2f(rf[0] & 0xFFFF0000u), u2f(rf[1] << 16), u2f(rf[1] & 0xFFFF0000u)};
          f32x4 lg;
#pragma unroll
          for (int j = 0; j < 4; ++j) {
            float f = lb4[j] + (1.0f - lb4[j]) * fsigmoid(zf[j]);
            lg[j] = flog(f); kk4[j] = 1.0f - f; qq4[j] = fsilu(zq[j]);
          }
          *(f32x4*)(lgf + pi * GL_OLD + pc4) = lg;
          vT[(pc4 + 0) * GL_TLD + pi] = (bf16_t)(rv[0] & 0xFFFFu); vT[(pc4 + 1) * GL_TLD + pi] = (bf16_t)(rv[0] >> 16);
          vT[(pc4 + 2) * GL_TLD + pi] = (bf16_t)(rv[1] & 0xFFFFu); vT[(pc4 + 3) * GL_TLD + pi] = (bf16_t)(rv[1] >> 16);
        }
        if (k + 1 < 8) gload(k + 1);
        __syncthreads();
        {
          f32x4 cs = {0.f, 0.f, 0.f, 0.f}, ce = cs, cm = cs;
#pragma unroll
          for (int q = 0; q < 16; ++q) {
            f32x4 v = *(const f32x4*)(lgf + q * GL_OLD + pc4);
            ce += v; if (q <= pi) cs += v; if (q < 8) cm += v;
          }
          float a[4], bb[4];
#pragma unroll
          for (int j = 0; j < 4; ++j) {
            a[j] = qq4[j] * fexp(cs[j] - cm[j]); bb[j] = kk4[j] * fexp(cm[j] - cs[j]);
            kdT[(pc4 + j) * GL_TLD + pi] = f2bf(kk4[j] * fexp(ce[j] - cs[j]));
          }
          u32x2 av; av[0] = pack2(a[0], a[1]); av[1] = pack2(a[2], a[3]);
          u32x2 bv; bv[0] = pack2(bb[0], bb[1]); bv[1] = pack2(bb[2], bb[3]);
          *(u32x2*)(qe + pi * LDT + pc4) = av; *(u32x2*)(ki + pi * LDT + pc4) = bv;
          if (pi == 0) {
#pragma unroll
            for (int j = 0; j < 4; ++j) { float e = fexp(ce[j]); Ec[pc4 + j] = e; Em[pc4 + j] = fexp(cm[j]); Et[pc4 + j] *= e; }
          }
        }
        __syncthreads();
        const u32x4 zero4 = {0u, 0u, 0u, 0u};
        if (FINAL) {
          f32x4 sct = {0.f, 0.f, 0.f, 0.f}, oT = {0.f, 0.f, 0.f, 0.f};
#pragma unroll
          for (int ks = 0; ks < 2; ++ks) {
            bf16x8 kf = *(const bf16x8*)(ki + fr * LDT + ks * 32 + fq * 8);
            bf16x8 qf = *(const bf16x8*)(qe + fr * LDT + ks * 32 + fq * 8);
            sct = MFMA16(kf, qf, sct);
            f32x4 e0 = *(const f32x4*)(Em + (2 * ks) * 16 + fq * 4), e1 = *(const f32x4*)(Em + (2 * ks + 1) * 16 + fq * 4);
            f32x4 s0 = S[2 * ks] * e0, s1 = S[2 * ks + 1] * e1;
            bf16x8 sf = pack_frag(s0, s1);
            bf16x8 qp = frag_perm8(qe + fr * LDT + ks * 32, fq);
            oT = MFMA16(sf, qp, oT);
          }
#pragma unroll
          for (int r = 0; r < 4; ++r) if (fq * 4 + r > fr) sct[r] = 0.f;
          {
            u32x4 bs = zero4; bs[0] = pack2(sct[0], sct[1]); bs[1] = pack2(sct[2], sct[3]);
            u32x2 va = *(const u32x2*)(vT + (wid * 16 + fr) * GL_TLD + fq * 4);
            u32x4 as = zero4; as[0] = va[0]; as[1] = va[1];
            oT = MFMA16(__builtin_bit_cast(bf16x8, as), __builtin_bit_cast(bf16x8, bs), oT);
          }
          const int tok = sc_ * 16 + (dir ? 15 - fr : fr);
          float* od = oacc + tok * GL_OLD + wid * 16 + fq * 4;
          if (dir == 0) *(f32x4*)od = oT; else { f32x4 prev = *(const f32x4*)od; *(f32x4*)od = prev + oT; }
        }
        {
          u32x4 bsrc = (fq < 2) ? *(const u32x4*)(vT + (wid * 16 + fr) * GL_TLD + fq * 8) : zero4;
          bf16x8 bf_ = __builtin_bit_cast(bf16x8, bsrc);
#pragma unroll
          for (int mt = 0; mt < 4; ++mt) {
            f32x4 e4 = *(const f32x4*)(Ec + mt * 16 + fq * 4);
            u32x4 asrc = (fq < 2) ? *(const u32x4*)(kdT + (mt * 16 + fr) * GL_TLD + fq * 8) : zero4;
            S[mt] = MFMA16(__builtin_bit_cast(bf16x8, asrc), bf_, S[mt] * e4);
          }
        }
      }
      __syncthreads();
      if (!FINAL) {
#pragma unroll
        for (int mt = 0; mt < 4; ++mt)
#pragma unroll
          for (int r = 0; r < 4; ++r) p.glKV()[chain * 4096 + (mt * 16 + fq * 4 + r) * 64 + wid * 16 + fr] = S[mt][r];
        if (tid < 64) p.glE()[chain * 64 + tid] = Et[tid];
      }
      __syncthreads();
    }
    if (FINAL) {
      const int row = tid >> 1, half = tid & 1;
      float ss = 0.f;
#pragma unroll
      for (int e = 0; e < 32; e += 4) { f32x4 v = *(const f32x4*)(oacc + row * GL_OLD + half * 32 + e); ss += v[0] * v[0] + v[1] * v[1] + v[2] * v[2] + v[3] * v[3]; }
      ss += __shfl_xor(ss, 1, 64);
      const float rs = rsqrtf(ss * (1.0f / 64.0f) + EPS);
      const size_t grow = (size_t)b * TS + tile * 128 + row;
#pragma unroll
      for (int c = 0; c < 4; ++c) {
        float g[8]; unpack8(*(const u32x4*)(p.P() + grow * PW + C_DG * 256 + hh * 64 + half * 32 + c * 8), g);
        f32x4 o0 = *(const f32x4*)(oacc + row * GL_OLD + half * 32 + c * 8), o1 = *(const f32x4*)(oacc + row * GL_OLD + half * 32 + c * 8 + 4);
        u32x4 ov;
        ov[0] = pack2(o0[0] * rs * fsilu(g[0]), o0[1] * rs * fsilu(g[1])); ov[1] = pack2(o0[2] * rs * fsilu(g[2]), o0[3] * rs * fsilu(g[3]));
        ov[2] = pack2(o1[0] * rs * fsilu(g[4]), o1[1] * rs * fsilu(g[5])); ov[3] = pack2(o1[2] * rs * fsilu(g[6]), o1[3] * rs * fsilu(g[7]));
        *(u32x4*)(p.y() + grow * (4 * MW) + 3 * MW + hh * 64 + half * 32 + c * 8) = ov;
      }
    }
  }
}
__device__ void phase_gla_b(const Params& p) {
  const int tid = tidx(p);
  for (int i = blockIdx.x * blockDim.x + tid; i < NB * NH * 2 * 4096; i += gridDim.x * blockDim.x) {
    int el = i & 4095, chain = i >> 12; int dir = chain & 1; int c = el >> 6;
    size_t base = (size_t)chain * NT;
    float S = 0.f;
    for (int k = 0; k < NT; ++k) {
      int tile = proc_tile(dir, k);
      p.glSp()[(base + tile) * 4096 + el] = S;
      S = p.glE()[(base + tile) * 64 + c] * S + p.glKV()[(base + tile) * 4096 + el];
    }
  }
}


constexpr int MRG_SMEM = 2 * (128 + 64) * LDT * 2;
__device__ void phase_merge(const Params& p, char* smem_) {
  const int tid = tidx(p);
  bf16_t* smem = (bf16_t*)smem_;
  bf16_t* sA[2] = {smem, smem + (128 + 64) * LDT};
  bf16_t* sB[2] = {smem + 128 * LDT, smem + (128 + 64) * LDT + 128 * LDT};
  const int lane = tid & 63, wid = tid >> 6, fr = lane & 15, fq = lane >> 4;
  const bool last = (p.layer == DEPTH - 1);
  constexpr int KG = D / 64, KS = KG + 4, NSTEP = 4 * KS;
  const int ntn = D / 64;
  for (int t = blockIdx.x; t < MT * ntn; t += gridDim.x) {
    const int tm = t / ntn, tn = t % ntn;
    if (last && (tm % NT) < CT) continue;
    const size_t row0 = (size_t)tm * 128; const int col0 = tn * 64;
    u32x4 ra[4], rb[2];
    auto gload = [&](int s) {
      const int n = s / KS, r = s % KS;
      const bool isG = r < KG;
      const bf16_t* abase = isG ? (p.h() + row0 * D + r * 64) : (p.y() + row0 * (4 * MW) + n * MW + (r - KG) * 64);
      const bf16_t* bbase = isG ? (p.WmT() + ((size_t)n * D + col0) * D + r * 64) : (p.WbT() + ((size_t)n * D + col0) * MW + (r - KG) * 64);
      const int ald = isG ? D : 4 * MW, bld = isG ? D : MW;
#pragma unroll
      for (int i = 0; i < 4; ++i) {
        int c = tid + i * 256; int row = c >> 3, kc = (c & 7) * 8;
        ra[i] = *(const u32x4*)(abase + (unsigned)(row * ald + kc));
      }
#pragma unroll
      for (int i = 0; i < 2; ++i) {
        int c = tid + i * 256; int row = c >> 3, kc = (c & 7) * 8;
        rb[i] = *(const u32x4*)(bbase + (unsigned)(row * bld + kc));
      }
    };
    auto sstore = [&](int buf) {
#pragma unroll
      for (int i = 0; i < 4; ++i) { int c = tid + i * 256; int row = c >> 3, kc = (c & 7) * 8; *(u32x4*)(sA[buf] + row * LDT + kc) = ra[i]; }
#pragma unroll
      for (int i = 0; i < 2; ++i) { int c = tid + i * 256; int row = c >> 3, kc = (c & 7) * 8; *(u32x4*)(sB[buf] + row * LDT + kc) = rb[i]; }
    };
    f32x4 aG[2][4], aY[2][4], aZ[2][4];
#pragma unroll
    for (int m = 0; m < 2; ++m)
#pragma unroll
      for (int n = 0; n < 4; ++n) { aG[m][n] = f32x4{0.f, 0.f, 0.f, 0.f}; aY[m][n] = aG[m][n]; aZ[m][n] = aG[m][n]; }
    gload(0);
    __syncthreads();
    sstore(0);
    __syncthreads();
    for (int s = 0; s < NSTEP; ++s) {
      const int cur = s & 1, r = s % KS;
      if (s + 1 < NSTEP) gload(s + 1);
      const bool isG = r < KG;
#pragma unroll
      for (int ks = 0; ks < 2; ++ks) {
        bf16x8 af[2], bfr[4];
#pragma unroll
        for (int m = 0; m < 2; ++m) af[m] = *(const bf16x8*)(sA[cur] + (wid * 32 + m * 16 + fr) * LDT + ks * 32 + fq * 8);
#pragma unroll
        for (int n = 0; n < 4; ++n) bfr[n] = *(const bf16x8*)(sB[cur] + (n * 16 + fr) * LDT + ks * 32 + fq * 8);
        if (isG) {
#pragma unroll
          for (int m = 0; m < 2; ++m)
#pragma unroll
            for (int n = 0; n < 4; ++n) aG[m][n] = MFMA16(bfr[n], af[m], aG[m][n]);
        } else {
#pragma unroll
          for (int m = 0; m < 2; ++m)
#pragma unroll
            for (int n = 0; n < 4; ++n) aY[m][n] = MFMA16(bfr[n], af[m], aY[m][n]);
        }
      }
      if (r == KS - 1) {
#pragma unroll
        for (int m = 0; m < 2; ++m)
#pragma unroll
          for (int n = 0; n < 4; ++n)
#pragma unroll
            for (int q = 0; q < 4; ++q) { aZ[m][n][q] += sigmoidf_(aG[m][n][q]) * aY[m][n][q]; aG[m][n][q] = 0.f; aY[m][n][q] = 0.f; }
      }
      if (s + 1 < NSTEP) sstore(cur ^ 1);
      __syncthreads();
    }
#pragma unroll
    for (int m = 0; m < 2; ++m)
#pragma unroll
      for (int n = 0; n < 4; ++n) {
        size_t row = row0 + wid * 32 + m * 16 + fr; int col = col0 + n * 16 + fq * 4;
        u32x2 o; o[0] = pack2(aZ[m][n][0], aZ[m][n][1]); o[1] = pack2(aZ[m][n][2], aZ[m][n][3]);
        *(u32x2*)(p.z() + row * D + col) = o;
      }
  }
}
__device__ void phase_outproj(const Params& p, char* smem_) {
  const int tid = tidx(p);
  bf16_t* smem = (bf16_t*)smem_;
  const int lane = tid & 63, wid = tid >> 6, wr = wid >> 1, wc = wid & 1, fr = lane & 15, fq = lane >> 4;
  const bool last = (p.layer == DEPTH - 1);
  const int ntn = D / 128;
  for (int t = blockIdx.x; t < MT * ntn; t += gridDim.x) {
    int tm = t / ntn, tn = t % ntn;
    if (last && (tm % NT) < CT) continue;
    const bf16_t* A = p.z() + (size_t)tm * 128 * D;
    const bf16_t* B = p.WoT() + (size_t)tn * 128 * D;
    f32x4 acc[4][4]; ACC_ZERO(acc);
    gemm_kloop(tid, acc, [&](int row, int k0) { return A + (size_t)row * D + k0; },
               [&](int row, int k0) { return B + (size_t)row * D + k0; }, D, smem);
#pragma unroll
    for (int m = 0; m < 4; ++m) {
      int row = tm * 128 + wr * 64 + m * 16 + fr;
      float* xr = xrow(p, row); const float* g = modrow(p, row, 2);
#pragma unroll
      for (int n = 0; n < 4; ++n) {
        int col = tn * 128 + wc * 64 + n * 16 + fq * 4;
        f32x4 xv = *(f32x4*)(xr + col); f32x4 gv = *(const f32x4*)(g + col);
#pragma unroll
        for (int q = 0; q < 4; ++q) xv[q] += gv[q] * acc[m][n][q];
        *(f32x4*)(xr + col) = xv;
      }
    }
  }
}
__device__ __forceinline__ void cls_experts(int cls, int& e_lo, int& e_hi) {
  int gi = cls / 6, pr = cls % 6;
  int lo = (pr < 3) ? 0 : (pr < 5) ? 1 : 2;
  int hi = (pr < 3) ? pr + 1 : (pr < 5) ? pr - 1 : 3;
  e_lo = gi * 4 + lo; e_hi = gi * 4 + hi;
}
__device__ __forceinline__ bool moe_find(const int* cnt, int mt, int& cls, int& mloc, int& total) {
  int acc = 0; bool found = false;
  for (int c = 0; c < NCLS; ++c) {
    int n = (cnt[c] + 127) >> 7;
    if (!found && mt < acc + n) { cls = c; mloc = mt - acc; found = true; }
    acc += n;
  }
  total = acc; return found;
}
__device__ void phase_moe_up(const Params& p, char* smem_) {
  const int tid = tidx(p);
  bf16_t* smem = (bf16_t*)smem_;
  int* stok = (int*)(smem_ + GEMM_SMEM);
  const int lane = tid & 63, wid = tid >> 6, wr = wid >> 1, wc = wid & 1, fr = lane & 15, fq = lane >> 4;
  const int* cnt = p.moe_cnt() + (p.layer * 2) * NCLS;
  constexpr int NCB = 2 * DE / 64;
  int total_mt = 0;
  { int c_, m_; moe_find(cnt, 0, c_, m_, total_mt); }
  for (int t = blockIdx.x; t < total_mt * NCB; t += gridDim.x) {
    const int mt = t / NCB, cb = t % NCB;
    int cls = 0, mloc = 0, tot_;
    moe_find(cnt, mt, cls, mloc, tot_);
    int e_lo, e_hi; cls_experts(cls, e_lo, e_hi);
    const int slot = (cb * 64) / DE, cbase = (cb * 64) % DE;
    const int ex = slot ? e_hi : e_lo;
    const int nvalid = imin(128, cnt[cls] - mloc * 128);
    __syncthreads();
    if (tid < 128) stok[tid] = p.moe_list()[(size_t)cls * T + mloc * 128 + imin((int)tid, nvalid - 1)];
    __syncthreads();
    const bf16_t* W1 = p.W1T() + (size_t)ex * DE * D; const bf16_t* W3 = p.W3T() + (size_t)ex * DE * D;
    f32x4 acc[4][4]; ACC_ZERO(acc);
    gemm_kloop(tid, acc, [&](int row, int k0) { return p.h() + (size_t)stok[row] * D + k0; },
               [&](int row, int k0) { int wcc = row >> 6, within = row & 63; int col = cbase + wcc * 32 + (within & 31);
                                      return ((within >= 32) ? W3 : W1) + (size_t)col * D + k0; }, D, smem);
#pragma unroll
    for (int m = 0; m < 4; ++m) {
      int rl = wr * 64 + m * 16 + fr;
      if (rl < nvalid) {
        int tok = stok[rl]; float tw = p.moe_tw()[(size_t)tok * 2 + slot];
#pragma unroll
        for (int n = 0; n < 2; ++n) {
          int col = slot * DE + cbase + wc * 32 + n * 16 + fq * 4;
          float v[4];
#pragma unroll
          for (int q = 0; q < 4; ++q) v[q] = siluf_(acc[m][n][q]) * acc[m][n + 2][q] * tw;
          u32x2 o; o[0] = pack2(v[0], v[1]); o[1] = pack2(v[2], v[3]);
          *(u32x2*)(p.mid() + (size_t)tok * (2 * DE) + col) = o;
        }
      }
    }
  }
}
__device__ void phase_moe_down(const Params& p, char* smem_) {
  const int tid = tidx(p);
  bf16_t* smem = (bf16_t*)smem_;
  int* stok = (int*)(smem_ + GEMM_SMEM);
  const int lane = tid & 63, wid = tid >> 6, wr = wid >> 1, wc = wid & 1, fr = lane & 15, fq = lane >> 4;
  const int* cnt = p.moe_cnt() + (p.layer * 2) * NCLS;
  constexpr int NCB = D / 128;
  int total_mt = 0;
  { int c_, m_; moe_find(cnt, 0, c_, m_, total_mt); }
  for (int t = blockIdx.x; t < total_mt * NCB; t += gridDim.x) {
    const int mt = t / NCB, cb = t % NCB;
    int cls = 0, mloc = 0, tot_;
    moe_find(cnt, mt, cls, mloc, tot_);
    int e_lo, e_hi; cls_experts(cls, e_lo, e_hi);
    const int nvalid = imin(128, cnt[cls] - mloc * 128);
    __syncthreads();
    if (tid < 128) stok[tid] = p.moe_list()[(size_t)cls * T + mloc * 128 + imin((int)tid, nvalid - 1)];
    __syncthreads();
    f32x4 acc[4][4]; ACC_ZERO(acc);
    gemm_kloop(tid, acc, [&](int row, int k0) { return p.mid() + (size_t)stok[row] * (2 * DE) + k0; },
               [&](int row, int k0) { int ex = (k0 < DE) ? e_lo : e_hi; int kk = (k0 < DE) ? k0 : k0 - DE;
                                      return p.W2T() + ((size_t)ex * D + cb * 128 + row) * DE + kk; }, 2 * DE, smem);
#pragma unroll
    for (int m = 0; m < 4; ++m) {
      int rl = wr * 64 + m * 16 + fr;
      if (rl < nvalid) {
        int tok = stok[rl];
        float* xr = xrow(p, tok); const float* g = modrow(p, tok, 5);
#pragma unroll
        for (int n = 0; n < 4; ++n) {
          int col = cb * 128 + wc * 64 + n * 16 + fq * 4;
          f32x4 xv = *(f32x4*)(xr + col); f32x4 gv = *(const f32x4*)(g + col);
#pragma unroll
          for (int q = 0; q < 4; ++q) xv[q] += gv[q] * acc[m][n][q];
          *(f32x4*)(xr + col) = xv;
        }
      }
    }
  }
}
__device__ void phase_final(const Params& p) {
  const int tid = tidx(p);
  const int lane = tid & 63, wid = tid >> 6, nw = blockDim.x >> 6;
  for (int r = blockIdx.x * nw + wid; r < NB * SEQ; r += gridDim.x * nw) {
    float* xr = p.out + (size_t)r * D;
    f32x4 v[D / 256]; float ss = 0.f;
#pragma unroll
    for (int i = 0; i < D / 256; ++i) { v[i] = *(const f32x4*)(xr + i * 256 + lane * 4); ss += v[i][0] * v[i][0] + v[i][1] * v[i][1] + v[i][2] * v[i][2] + v[i][3] * v[i][3]; }
    ss = wave_sum(ss);
    float rs = rsqrtf(ss * (1.0f / D) + EPS);
#pragma unroll
    for (int i = 0; i < D / 256; ++i) {
      f32x4 w4 = *(const f32x4*)(p.final_norm_w + i * 256 + lane * 4);
#pragma unroll
      for (int q = 0; q < 4; ++q) v[i][q] = v[i][q] * rs * w4[q];
      *(f32x4*)(xr + i * 256 + lane * 4) = v[i];
    }
  }
}

#ifndef EMU
#define KWAVE(p) p.wave = __builtin_amdgcn_readfirstlane((int)(threadIdx.x >> 6))
#else
#define KWAVE(p)
#endif
__global__ void __launch_bounds__(256) k_init(Params p) { KWAVE(p); phase_init(p); }
__global__ void __launch_bounds__(256) k_modv(Params p) { KWAVE(p); DYN_SMEM(smem); phase_modv(p, smem); }
__global__ void __launch_bounds__(256) k_convw(Params p, int part) { KWAVE(p); DYN_SMEM(smem); phase_convw(p, part, smem); }
__global__ void __launch_bounds__(256) k_norm(Params p, int which) { KWAVE(p); DYN_SMEM(smem); phase_norm(p, which, smem); }
__global__ void __launch_bounds__(256) k_inproj(Params p) { KWAVE(p); DYN_SMEM(smem); phase_inproj(p, smem); }
__global__ void __launch_bounds__(256) k_ret_a(Params p) { KWAVE(p); DYN_SMEM(smem); phase_ret_a(p, smem); }
__global__ void __launch_bounds__(256) k_ret_b(Params p) { KWAVE(p); phase_ret_b(p); }
__global__ void __launch_bounds__(256) k_ret_c(Params p) { KWAVE(p); DYN_SMEM(smem); phase_ret_c(p, smem); }
__global__ void __launch_bounds__(256) k_mls_a(Params p) { KWAVE(p); DYN_SMEM(smem); phase_mls_a(p, smem); }
__global__ void __launch_bounds__(256) k_mls_b(Params p) { KWAVE(p); phase_mls_b(p); }
__global__ void __launch_bounds__(256) k_mls_c(Params p) { KWAVE(p); DYN_SMEM(smem); phase_mls_c(p, smem); }
__global__ void __launch_bounds__(256) k_gla_a(Params p) { KWAVE(p); DYN_SMEM(smem); phase_gla<false>(p, smem); }
__global__ void __launch_bounds__(256) k_gla_b(Params p) { KWAVE(p); phase_gla_b(p); }
__global__ void __launch_bounds__(256) k_gla_c(Params p) { KWAVE(p); DYN_SMEM(smem); phase_gla<true>(p, smem); }
__global__ void __launch_bounds__(256) k_merge(Params p) { KWAVE(p); DYN_SMEM(smem); phase_merge(p, smem); }
__global__ void __launch_bounds__(256) k_outproj(Params p) { KWAVE(p); DYN_SMEM(smem); phase_outproj(p, smem); }
__global__ void __launch_bounds__(256) k_moe_up(Params p) { KWAVE(p); DYN_SMEM(smem); phase_moe_up(p, smem); }
__global__ void __launch_bounds__(256) k_moe_down(Params p) { KWAVE(p); DYN_SMEM(smem); phase_moe_down(p, smem); }
__global__ void __launch_bounds__(256) k_final(Params p) { KWAVE(p); phase_final(p); }
__global__ void __launch_bounds__(256) k_lru_a(Params p) { KWAVE(p); DYN_SMEM(smem); phase_lru<false>(p, smem); }
__global__ void __launch_bounds__(256) k_lru_b(Params p) { KWAVE(p); phase_lru_carry(p); }
__global__ void __launch_bounds__(256) k_lru_c(Params p) { KWAVE(p); DYN_SMEM(smem); phase_lru<true>(p, smem); }


constexpr int cmax(int a, int b) { return a > b ? a : b; }
constexpr int MEGA_SMEM = cmax(cmax(cmax(GEMM_SMEM + 512, MLSC_SMEM), cmax(RETC_SMEM, GLA_SMEM)), cmax(cmax(LRU_SMEM, MRG_SMEM), cmax((NB + 1) * D * 4, 64 * 65 * 4)));
#ifndef EMU
#define GRID_SYNC() cooperative_groups::this_grid().sync()
#else
#define GRID_SYNC() emu::grid_barrier()
#endif
__global__ void __launch_bounds__(256, 2) k_mega(Params p0) {
  DYN_SMEM(smem);
#ifndef EMU
  const int wv_ = __builtin_amdgcn_readfirstlane((int)(threadIdx.x >> 6));
#else
  const int wv_ = 0;
#endif
#define PP(l) load_params(l, wv_)
  phase_init(PP(0));
  phase_modv(PP(0), smem);
  phase_convw(PP(0), 0, smem);
  GRID_SYNC();
#pragma unroll 1
  for (int l = 0; l < DEPTH; ++l) {
    phase_norm(PP(l), 0, smem);
    GRID_SYNC();
    phase_inproj(PP(l), smem);
    GRID_SYNC();
    phase_lru<false>(PP(l), smem);
    phase_ret_a(PP(l), smem);
    phase_mls_a(PP(l), smem);
    phase_gla<false>(PP(l), smem);
    GRID_SYNC();
    phase_lru_carry(PP(l));
    phase_ret_b(PP(l));
    phase_mls_b(PP(l));
    phase_gla_b(PP(l));
    GRID_SYNC();
    phase_lru<true>(PP(l), smem);
    phase_ret_c(PP(l), smem);
    phase_mls_c(PP(l), smem);
    phase_gla<true>(PP(l), smem);
    GRID_SYNC();
    phase_convw(PP(l), 1, smem);
    phase_merge(PP(l), smem);
    GRID_SYNC();
    phase_outproj(PP(l), smem);
    GRID_SYNC();
    phase_norm(PP(l), 1, smem);
    if (l + 1 < DEPTH) phase_convw(PP(l + 1), 0, smem);
    GRID_SYNC();
    phase_moe_up(PP(l), smem);
    GRID_SYNC();
    phase_moe_down(PP(l), smem);
    GRID_SYNC();
  }
  phase_final(PP(0));
#undef PP
}

static size_t align_up(size_t v, size_t a) { return (v + a - 1) / a * a; }

extern "C" void kernel_launch(void* const* d_in, const int* in_sizes, int n_in, void* d_out, int out_size, void* d_ws,
                              size_t ws_size, hipStream_t stream) {
  Params p{};
  const float* const* in = (const float* const*)d_in;
  p.x = in[0]; p.c = in[1]; p.ctx = in[2]; p.c_ctx = in[3]; p.w_mod = in[4]; p.b_mod = in[5]; p.w_in = in[6];
  p.a_conv_w = in[7]; p.a_conv_b = in[8]; p.a_gate_w = in[9]; p.a_gate_b = in[10]; p.a_lambda = in[11]; p.b_theta = in[12];
  p.c_conv_w = in[13]; p.c_conv_b = in[14]; p.c_gate_b = in[15]; p.d_lb = in[16]; p.w_branch = in[17]; p.w_out = in[18];
  p.moe_w_group = in[19]; p.moe_b_group = in[20]; p.moe_w_router = in[21]; p.moe_b_router = in[22];
  p.moe_w1 = in[23]; p.moe_w3 = in[24]; p.moe_w2 = in[25]; p.final_norm_w = in[26];
  p.out = (float*)d_out;
  p.ws = (char*)d_ws;
  if (ws_size < WS_TOTAL) fprintf(stderr, "workspace too small: %zu < %zu\n", ws_size, (size_t)WS_TOTAL);
#ifdef EMU
  extern Params g_params; g_params = p;
  const int G = 8;
#else
  const int G = 1024;
  hipFuncSetAttribute((const void*)k_inproj, hipFuncAttributeMaxDynamicSharedMemorySize, GEMM_SMEM + 512);
  hipFuncSetAttribute((const void*)k_ret_a, hipFuncAttributeMaxDynamicSharedMemorySize, RETA_SMEM);
  hipFuncSetAttribute((const void*)k_ret_c, hipFuncAttributeMaxDynamicSharedMemorySize, RETC_SMEM);
  hipFuncSetAttribute((const void*)k_mls_a, hipFuncAttributeMaxDynamicSharedMemorySize, MLSA_SMEM);
  hipFuncSetAttribute((const void*)k_mls_c, hipFuncAttributeMaxDynamicSharedMemorySize, MLSC_SMEM);
  hipFuncSetAttribute((const void*)k_gla_a, hipFuncAttributeMaxDynamicSharedMemorySize, GLA_SMEM);
  hipFuncSetAttribute((const void*)k_gla_c, hipFuncAttributeMaxDynamicSharedMemorySize, GLA_SMEM);
  hipFuncSetAttribute((const void*)k_merge, hipFuncAttributeMaxDynamicSharedMemorySize, MRG_SMEM);
  hipFuncSetAttribute((const void*)k_outproj, hipFuncAttributeMaxDynamicSharedMemorySize, GEMM_SMEM + 512);
  hipFuncSetAttribute((const void*)k_moe_up, hipFuncAttributeMaxDynamicSharedMemorySize, GEMM_SMEM + 512);
  hipFuncSetAttribute((const void*)k_moe_down, hipFuncAttributeMaxDynamicSharedMemorySize, GEMM_SMEM + 512);
  hipFuncSetAttribute((const void*)k_lru_a, hipFuncAttributeMaxDynamicSharedMemorySize, LRU_SMEM);
  hipFuncSetAttribute((const void*)k_lru_c, hipFuncAttributeMaxDynamicSharedMemorySize, LRU_SMEM);
#endif
#ifndef MULTI_LAUNCH
#ifdef EMU
  g_kp = p;
  emu::launch(dim3(8), dim3(256), true, [=]() { k_mega(p); });
#else
  {
    static int grid_blocks = 0;
    if (!grid_blocks) {
      hipFuncSetAttribute((const void*)k_mega, hipFuncAttributeMaxDynamicSharedMemorySize, MEGA_SMEM);
      int dev = 0, cus = 0, per_cu = 0;
      hipGetDevice(&dev);
      hipDeviceGetAttribute(&cus, hipDeviceAttributeMultiprocessorCount, dev);
      hipOccupancyMaxActiveBlocksPerMultiprocessor(&per_cu, k_mega, 256, MEGA_SMEM);
      if (per_cu < 1) per_cu = 1;
      grid_blocks = cus * per_cu;
    }
    void* args[] = {(void*)&p};
    hipError_t e = hipLaunchCooperativeKernel((void*)k_mega, dim3(grid_blocks), dim3(256), args, MEGA_SMEM, stream);
    if (e != hipSuccess) fprintf(stderr, "cooperative launch failed: %s (grid %d)\n", hipGetErrorString(e), grid_blocks);
  }
#endif
#else
  LAUNCH(k_init, G, 256, 0, stream, p);
  LAUNCH(k_modv, (DEPTH * NMOD * D + 255) / 256, 256, (NB + 1) * D * 4, stream, p);
#ifdef EMU
  const int nlayers = getenv("EMU_LAYERS") ? atoi(getenv("EMU_LAYERS")) : DEPTH;
  const int stop_after = getenv("EMU_STOP") ? atoi(getenv("EMU_STOP")) : 99;
#else
  const int nlayers = DEPTH, stop_after = 99;
#endif
  for (int l = 0; l < nlayers; ++l) {
    p.layer = l;
    const bool lastl = (l == nlayers - 1);
    LAUNCH(k_convw, G, 256, 64 * 65 * 4, stream, p, 0);
    LAUNCH(k_norm, G, 256, 4 * 16 * 33 * 4, stream, p, 0);
    LAUNCH(k_inproj, G, 256, GEMM_SMEM + 512, stream, p);
    if (lastl && stop_after < 1) break;
    LAUNCH(k_lru_a, G, 256, LRU_SMEM, stream, p);
    LAUNCH(k_ret_a, G, 256, RETA_SMEM, stream, p);
    LAUNCH(k_mls_a, G, 256, MLSA_SMEM, stream, p);
    LAUNCH(k_gla_a, G, 256, GLA_SMEM, stream, p);
    LAUNCH(k_lru_b, G, 256, 0, stream, p);
    LAUNCH(k_ret_b, G, 256, 0, stream, p);
    LAUNCH(k_mls_b, G, 256, 0, stream, p);
    LAUNCH(k_gla_b, G, 256, 0, stream, p);
    LAUNCH(k_lru_c, G, 256, LRU_SMEM, stream, p);
    LAUNCH(k_ret_c, G, 256, RETC_SMEM, stream, p);
    LAUNCH(k_mls_c, G, 256, MLSC_SMEM, stream, p);
    LAUNCH(k_gla_c, G, 256, GLA_SMEM, stream, p);
    if (lastl && stop_after < 2) break;
    LAUNCH(k_convw, G, 256, 64 * 65 * 4, stream, p, 1);
    LAUNCH(k_merge, G, 256, MRG_SMEM, stream, p);
    if (lastl && stop_after < 3) break;
    LAUNCH(k_outproj, G, 256, GEMM_SMEM + 512, stream, p);
    if (lastl && stop_after < 4) break;
    LAUNCH(k_norm, G, 256, 4 * 16 * 33 * 4, stream, p, 1);
    LAUNCH(k_moe_up, G, 256, GEMM_SMEM + 512, stream, p);
    LAUNCH(k_moe_down, G, 256, GEMM_SMEM + 512, stream, p);
  }
  if (nlayers == DEPTH && stop_after >= 99) LAUNCH(k_final, G, 256, 0, stream, p);
#endif

}
```

```cpp
#ifndef EMU
#include <hip/hip_runtime.h>
#include <hip/hip_cooperative_groups.h>
#include <cstdio>
typedef short bf16x8 __attribute__((ext_vector_type(8)));
typedef float f32x4 __attribute__((ext_vector_type(4)));
#define MFMA16(a, b, c) __builtin_amdgcn_mfma_f32_16x16x32_bf16(a, b, c, 0, 0, 0)
#define LAUNCH(kern, grid, block, smem, stream, ...) hipLaunchKernelGGL(kern, dim3(grid), dim3(block), smem, stream, __VA_ARGS__)
#define DYN_SMEM(name) extern __shared__ __attribute__((aligned(16))) char name[]
#define WAVE_SYNC() __builtin_amdgcn_wave_barrier()
#define NO_HOIST() asm volatile("" ::: "memory")
#define SCHED_FENCE() __builtin_amdgcn_sched_barrier(0)
#define SET_PRIO(n) __builtin_amdgcn_s_setprio(n)
#define NO_CSE(v) asm volatile("" : "+v"(v))
#define MEM_DRAIN() asm volatile("s_waitcnt vmcnt(0)" ::: "memory")
#define GLDS16(gp, lp) __builtin_amdgcn_global_load_lds((const unsigned*)(gp), (unsigned*)(lp), 16, 0, 0)
#define RAW_BARRIER() __builtin_amdgcn_s_barrier()
#define WAIT_VM(n) asm volatile("s_waitcnt vmcnt(" #n ")" ::: "memory")
#define STORE_WT16(ptr, val) asm volatile("global_store_dwordx4 %0, %1, off sc1" :: "v"(ptr), "v"(val) : "memory")
#define STORE_WT8(ptr, val) asm volatile("global_store_dwordx2 %0, %1, off sc1" :: "v"(ptr), "v"(val) : "memory")
#define STORE_WT4(ptr, val) asm volatile("global_store_dword %0, %1, off sc1" :: "v"(ptr), "v"(val) : "memory")
#else
#define STORE_WT4(ptr, val) (*(ptr) = (val))
#define STORE_WT16(ptr, val) memcpy((void*)(ptr), &(val), 16)
#define STORE_WT8(ptr, val) memcpy((void*)(ptr), &(val), 8)
#define MFMA16(a, b, c) emu_mfma16(a, b, c)
#define LAUNCH(kern, grid, block, smem, stream, ...) emu::launch(dim3(grid), dim3(block), false, [=]() { kern(__VA_ARGS__); })
#define DYN_SMEM(name) char* name = emu::tl_blk->dyn_smem
#define WAVE_SYNC() emu::wave_barrier()
#define NO_HOIST()
#define SCHED_FENCE()
#define SET_PRIO(n)
#define NO_CSE(v)
#define MEM_DRAIN()
#define GLDS16(gp, lp) memcpy((void*)(lp), (const void*)(gp), 16)
#define RAW_BARRIER() emu::block_barrier()
#define WAIT_VM(n)
#endif

typedef unsigned short bf16_t;
typedef unsigned u32x4 __attribute__((ext_vector_type(4)));
typedef unsigned u32x2 __attribute__((ext_vector_type(2)));
typedef float f32x2 __attribute__((ext_vector_type(2)));

#ifdef EMU_SMALL
constexpr int D = 256, NB = 2, SEQ = 256, CTX = 128, DE = 128;
#else
constexpr int D = 1024, NB = 4, SEQ = 4096, CTX = 256, DE = 512;
#endif
constexpr int DEPTH = 2, NH = 4, HD = 64, MW = 256;
constexpr int TS = CTX + SEQ;
constexpr int T = NB * TS;
constexpr int NT = TS / 128;
constexpr int CT = CTX / 128;
constexpr int MT = T / 128;
constexpr int INW = 15 * MW + 16 + 4 * D;
constexpr int PW = 15 * MW;
constexpr int NMOD = 6;
constexpr int GRIDW = 64;
constexpr int NCLS = 24;
constexpr float EPS = 1e-6f;
enum { C_AX = 0, C_AG = 1, C_BQ = 2, C_BK = 3, C_BV = 4, C_BG = 5, C_CQ = 6, C_CK = 7, C_CV = 8, C_CO = 9,
       C_DQ = 10, C_DFF = 11, C_DFB = 12, C_DI = 13, C_DG = 14 };

constexpr size_t A256(size_t v) { return (v + 255) / 256 * 256; }
constexpr size_t O_modv = 0;
constexpr size_t O_xc = O_modv + A256((size_t)DEPTH * (NB + 1) * NMOD * D * 4);
constexpr size_t O_h = O_xc + A256((size_t)NB * CTX * D * 4);
constexpr size_t O_cg = O_h + A256((size_t)T * D * 2);
constexpr size_t O_y = O_cg + A256((size_t)T * 16 * 4);
constexpr size_t O_WinT = O_y + A256((size_t)T * 4 * MW * 2);
constexpr size_t O_WmT = O_WinT + A256((size_t)PW * D * 2);
constexpr size_t O_WbT = O_WmT + A256((size_t)4 * D * D * 2);
constexpr size_t O_WoT = O_WbT + A256((size_t)4 * D * MW * 2);
constexpr size_t O_WcgT = O_WoT + A256((size_t)D * D * 2);
constexpr size_t O_WrtT = O_WcgT + A256((size_t)16 * D * 2);
constexpr size_t O_retKV = O_WrtT + A256((size_t)32 * D * 2);
constexpr size_t O_retSp = O_retKV + A256((size_t)NB * NH * 2 * NT * 64 * 64 * 4);
constexpr size_t O_mlC = O_retSp + A256((size_t)NB * NH * 2 * NT * 64 * 64 * 2);
constexpr size_t O_mlCe = O_mlC + A256((size_t)NB * NH * 2 * NT * 80 * 64 * 4);
constexpr size_t O_mlSp = O_mlCe + A256((size_t)NB * NH * 2 * NT * 4);
constexpr size_t O_glKV = O_mlSp + A256((size_t)NB * NH * 2 * NT * 80 * 64 * 2);
constexpr size_t O_glE = O_glKV + A256((size_t)NB * NH * 2 * NT * 64 * 64 * 4);
constexpr size_t O_glSp = O_glE + A256((size_t)NB * NH * 2 * NT * 64 * 4);
constexpr size_t O_lruS = O_glSp + A256((size_t)NB * NH * 2 * NT * 64 * 64 * 4);
constexpr size_t O_lruC = O_lruS + A256((size_t)NB * 2 * (TS / 64) * 2 * 256 * 4);
constexpr size_t O_moe_cnt = O_lruC + A256((size_t)NB * 2 * (TS / 64) * 256 * 4);
constexpr size_t O_moe_list = O_moe_cnt + A256((size_t)DEPTH * 2 * NCLS * 4);
constexpr size_t O_moe_tw = O_moe_list + A256((size_t)NCLS * T * 4);
constexpr size_t O_rope = O_moe_tw + A256((size_t)T * 2 * 4);
constexpr size_t O_PROBE = O_rope + A256((size_t)SEQ * 32 * 2 * 4);
constexpr size_t O_BAR = O_PROBE + 4096;
constexpr size_t O_P_ = O_BAR + 16384;
constexpr size_t O_P = O_P_;
constexpr size_t O_z = O_P;
constexpr size_t O_mid = O_z + A256((size_t)T * D * 2);
constexpr size_t O_W1T = O_P + A256((size_t)T * PW * 2);
constexpr size_t O_W3T = O_W1T + A256((size_t)16 * DE * D * 2);
constexpr size_t O_W2T = O_W3T + A256((size_t)16 * DE * D * 2);
constexpr size_t WS_TOTAL = O_W2T + A256((size_t)16 * DE * D * 2);
static_assert(O_W2T + A256((size_t)16 * D * DE * 2) <= WS_TOTAL, "P-region aliases overflow");
struct Params {
  const float *x, *c, *ctx, *c_ctx, *w_mod, *b_mod, *w_in, *a_conv_w, *a_conv_b, *a_gate_w, *a_gate_b, *a_lambda,
      *b_theta, *c_conv_w, *c_conv_b, *c_gate_b, *d_lb, *w_branch, *w_out, *moe_w_group, *moe_b_group,
      *moe_w_router, *moe_b_router, *moe_w1, *moe_w3, *moe_w2, *final_norm_w;
  float* out;
  char* ws;
  __device__ __host__ __forceinline__ float* modv() const { return (float*)(ws + O_modv); }
  __device__ __host__ __forceinline__ float* xc() const { return (float*)(ws + O_xc); }
  __device__ __host__ __forceinline__ bf16_t* h() const { return (bf16_t*)(ws + O_h); }
  __device__ __host__ __forceinline__ float* cg() const { return (float*)(ws + O_cg); }
  __device__ __host__ __forceinline__ bf16_t* y() const { return (bf16_t*)(ws + O_y); }
  __device__ __host__ __forceinline__ bf16_t* WinT() const { return (bf16_t*)(ws + O_WinT); }
  __device__ __host__ __forceinline__ bf16_t* WmT() const { return (bf16_t*)(ws + O_WmT); }
  __device__ __host__ __forceinline__ bf16_t* WbT() const { return (bf16_t*)(ws + O_WbT); }
  __device__ __host__ __forceinline__ bf16_t* WoT() const { return (bf16_t*)(ws + O_WoT); }
  __device__ __host__ __forceinline__ bf16_t* WcgT() const { return (bf16_t*)(ws + O_WcgT); }
  __device__ __host__ __forceinline__ bf16_t* WrtT() const { return (bf16_t*)(ws + O_WrtT); }
  __device__ __host__ __forceinline__ float* retKV() const { return (float*)(ws + O_retKV); }
  __device__ __host__ __forceinline__ bf16_t* retSp() const { return (bf16_t*)(ws + O_retSp); }
  __device__ __host__ __forceinline__ float* mlC() const { return (float*)(ws + O_mlC); }
  __device__ __host__ __forceinline__ float* mlCe() const { return (float*)(ws + O_mlCe); }
  __device__ __host__ __forceinline__ bf16_t* mlSp() const { return (bf16_t*)(ws + O_mlSp); }
  __device__ __host__ __forceinline__ float* glKV() const { return (float*)(ws + O_glKV); }
  __device__ __host__ __forceinline__ float* glE() const { return (float*)(ws + O_glE); }
  __device__ __host__ __forceinline__ float* glSp() const { return (float*)(ws + O_glSp); }
  __device__ __host__ __forceinline__ float* lruS() const { return (float*)(ws + O_lruS); }
  __device__ __host__ __forceinline__ float* lruC() const { return (float*)(ws + O_lruC); }
  __device__ __host__ __forceinline__ int* moe_cnt() const { return (int*)(ws + O_moe_cnt); }
  __device__ __host__ __forceinline__ int* moe_list() const { return (int*)(ws + O_moe_list); }
  __device__ __host__ __forceinline__ float* moe_tw() const { return (float*)(ws + O_moe_tw); }
  __device__ __host__ __forceinline__ float* rope() const { return (float*)(ws + O_rope); }
  __device__ __host__ __forceinline__ bf16_t* P() const { return (bf16_t*)(ws + O_P); }
  __device__ __host__ __forceinline__ bf16_t* z() const { return (bf16_t*)(ws + O_z); }
  __device__ __host__ __forceinline__ bf16_t* mid() const { return (bf16_t*)(ws + O_mid); }
  __device__ __host__ __forceinline__ bf16_t* W1T() const { return (bf16_t*)(ws + O_W1T); }
  __device__ __host__ __forceinline__ bf16_t* W3T() const { return (bf16_t*)(ws + O_W3T); }
  __device__ __host__ __forceinline__ bf16_t* W2T() const { return (bf16_t*)(ws + O_W2T); }
  int layer;
  int wave;
  int bid, gdim;
};


#ifndef EMU
typedef __attribute__((address_space(4))) const Params* KParamsPtr;
__device__ __forceinline__ Params load_params(int layer, int wave) {
  auto kp0 = __builtin_amdgcn_kernarg_segment_ptr();
  asm volatile("" : "+s"(kp0));
  KParamsPtr kp = (KParamsPtr)kp0;
  Params p;
  p.x = kp->x; p.c = kp->c; p.ctx = kp->ctx; p.c_ctx = kp->c_ctx; p.w_mod = kp->w_mod; p.b_mod = kp->b_mod; p.w_in = kp->w_in; p.a_conv_w = kp->a_conv_w; p.a_conv_b = kp->a_conv_b; p.a_gate_w = kp->a_gate_w; p.a_gate_b = kp->a_gate_b; p.a_lambda = kp->a_lambda; p.b_theta = kp->b_theta; p.c_conv_w = kp->c_conv_w; p.c_conv_b = kp->c_conv_b; p.c_gate_b = kp->c_gate_b; p.d_lb = kp->d_lb; p.w_branch = kp->w_branch; p.w_out = kp->w_out; p.moe_w_group = kp->moe_w_group; p.moe_b_group = kp->moe_b_group; p.moe_w_router = kp->moe_w_router; p.moe_b_router = kp->moe_b_router; p.moe_w1 = kp->moe_w1; p.moe_w3 = kp->moe_w3; p.moe_w2 = kp->moe_w2; p.final_norm_w = kp->final_norm_w; p.out = kp->out; p.ws = kp->ws;
  p.layer = layer; p.wave = wave;
  { int b_ = (int)blockIdx.x, g_ = (int)gridDim.x; asm volatile("" : "+s"(b_), "+s"(g_)); p.bid = b_; p.gdim = g_; }
  return p;
}
#else
static Params g_kp;
static inline Params load_params(int layer, int wave) { Params p = g_kp; p.layer = layer; p.wave = wave; p.bid = blockIdx.x; p.gdim = gridDim.x; return p; }
#endif

__device__ __forceinline__ unsigned f2u(float f) { return __builtin_bit_cast(unsigned, f); }
__device__ __forceinline__ float u2f(unsigned u) { return __builtin_bit_cast(float, u); }
#ifndef EMU
typedef __bf16 hwbf16x2 __attribute__((ext_vector_type(2)));
__device__ __forceinline__ bf16_t f2bf(float f) { return __builtin_bit_cast(unsigned short, (__bf16)f); }
__device__ __forceinline__ unsigned pack2(float lo, float hi) { f32x2 v = {lo, hi}; return __builtin_bit_cast(unsigned, __builtin_convertvector(v, hwbf16x2)); }
#else
__device__ __forceinline__ bf16_t f2bf(float f) {
  unsigned u = f2u(f);
  u += 0x7FFFu + ((u >> 16) & 1u);
  return (bf16_t)(u >> 16);
}
__device__ __forceinline__ unsigned pack2(float lo, float hi) { return (unsigned)f2bf(lo) | ((unsigned)f2bf(hi) << 16); }
#endif
__device__ __forceinline__ float bf2f(bf16_t b) { return u2f(((unsigned)b) << 16); }
#ifndef EMU
__device__ __forceinline__ float fexp(float x) { return __expf(x); }
__device__ __forceinline__ float fexp2(float x) { return __builtin_amdgcn_exp2f(x); }
__device__ __forceinline__ float frcp(float x) { return __builtin_amdgcn_rcpf(x); }
__device__ __forceinline__ float fsqrt(float x) { return __builtin_amdgcn_sqrtf(x); }
__device__ __forceinline__ float flog(float x) { return __logf(x); }
#else
__device__ __forceinline__ float fexp(float x) { return expf(x); }
__device__ __forceinline__ float fexp2(float x) { return exp2f(x); }
__device__ __forceinline__ float frcp(float x) { return 1.0f / x; }
__device__ __forceinline__ float fsqrt(float x) { return sqrtf(x); }
__device__ __forceinline__ float flog(float x) { return logf(x); }
#endif
__device__ __forceinline__ float fsigmoid(float x) { return frcp(1.0f + fexp(-x)); }
__device__ __forceinline__ float fsilu(float x) { return x * frcp(1.0f + fexp(-x)); }
__device__ __forceinline__ float sigmoidf_(float x) { return 1.0f / (1.0f + expf(-x)); }
__device__ __forceinline__ float siluf_(float x) { return x / (1.0f + expf(-x)); }
__device__ __forceinline__ float logsigf_(float x) {
  return (x >= 0.f) ? -log1pf(expf(-x)) : (x - log1pf(expf(x)));
}
__device__ __forceinline__ float geluf_(float x) {
  return 0.5f * x * (1.0f + tanhf(0.7978845608028654f * (x + 0.044715f * x * x * x)));
}
__device__ __forceinline__ float* xrow(const Params& p, int r) {
  int b = r / TS, s = r - b * TS;
  return (s < CTX) ? (p.xc() + ((size_t)b * CTX + s) * D) : (p.out + ((size_t)b * SEQ + (s - CTX)) * D);
}
__device__ __forceinline__ const float* xrow_src(const Params& p, int r, bool first) {
  if (!first) return xrow(p, r);
  int b = r / TS, s = r - b * TS;
  return (s < CTX) ? (p.ctx + ((size_t)b * CTX + s) * D) : (p.x + ((size_t)b * SEQ + (s - CTX)) * D);
}
__device__ __forceinline__ const float* modrow(const Params& p, int r, int m) {
  int b = r / TS, s = r - b * TS;
  int mr = (s < CTX) ? NB : b;
  return p.modv() + ((size_t)p.layer * (NB + 1) + mr) * (NMOD * D) + m * D;
}
__device__ __forceinline__ int tidx(const Params& p) {
#ifdef EMU
  return threadIdx.x;
#else
  int z; asm volatile("v_mov_b32 %0, 0" : "=v"(z));
  return (p.wave << 6) + (int)__builtin_amdgcn_mbcnt_hi(~0u, __builtin_amdgcn_mbcnt_lo(~0u, (unsigned)z));
#endif
}
__device__ __forceinline__ int imin(int a, int b) { return a < b ? a : b; }
#ifndef EMU
__device__ __forceinline__ float shfl_idx(float v, int src_lane) { return __builtin_bit_cast(float, __builtin_amdgcn_ds_bpermute(src_lane << 2, __builtin_bit_cast(int, v))); }
#else
__device__ __forceinline__ float shfl_idx(float v, int src_lane) { return __shfl(v, src_lane, 64); }
#endif
#define SHFL_XOR(v, m) shfl_idx(v, lane ^ (m))
#define SHFL(v, src) shfl_idx(v, src)
__device__ __forceinline__ float wave_sum(float v, int lane) {
#pragma unroll
  for (int o = 32; o > 0; o >>= 1) v += SHFL_XOR(v, o);
  return v;
}

__device__ __forceinline__ void phase_init(const Params& p) {
  const int tid = tidx(p);
  int gt = p.bid * 256 + tid, gn = p.gdim * 256;
  for (int i = gt; i < DEPTH * 2 * NCLS; i += gn) p.moe_cnt()[i] = 0;
  for (int i = gt; i < SEQ * 32; i += gn) {
    int tt = i >> 5, pp = i & 31;
    float pos = (float)(pp < 16 ? (tt / GRIDW) : (tt % GRIDW));
    float inv = exp2f(-(float)(pp & 15) * (13.287712379549449f / 16.0f));
    float sn, cs; sincosf(pos * inv, &sn, &cs);
    p.rope()[2 * i] = cs; p.rope()[2 * i + 1] = sn;
  }
}

__device__ __forceinline__ void phase_modv(const Params& p, char* smem_) {
  const int tid = tidx(p);
  float* sc = (float*)smem_;
  float* part = sc + (NB + 1) * D;
  __syncthreads();
  for (int i = tid; i < (NB + 1) * D; i += 256) {
    int r = i / D, k = i - r * D;
    float v = (r < NB) ? p.c[r * D + k] : p.c_ctx[k];
    sc[i] = siluf_(v);
  }
  __syncthreads();
  const int ncg = DEPTH * NMOD * D / 64;
  const int cl = tid & 63, kg = tid >> 6;
  constexpr int KQ = D / 4;
  for (int cgi = p.bid; cgi < ncg; cgi += p.gdim) {
    const int col = cgi * 64 + cl;
    const int l = col / (NMOD * D), n = col - l * (NMOD * D);
    const float* w = p.w_mod + (size_t)l * D * (NMOD * D) + n + (size_t)kg * KQ * (NMOD * D);
    float acc[NB + 1];
#pragma unroll
    for (int r = 0; r <= NB; ++r) acc[r] = 0.f;
#pragma unroll 8
    for (int k = 0; k < KQ; ++k) {
      float wv = w[(size_t)k * (NMOD * D)];
#pragma unroll
      for (int r = 0; r <= NB; ++r) acc[r] += sc[r * D + kg * KQ + k] * wv;
    }
#pragma unroll
    for (int r = 0; r <= NB; ++r) part[(kg * (NB + 1) + r) * 64 + cl] = acc[r];
    __syncthreads();
    if (kg == 0) {
      float bb = p.b_mod[l * (NMOD * D) + n];
#pragma unroll
      for (int r = 0; r <= NB; ++r) {
        float v = part[(0 * (NB + 1) + r) * 64 + cl] + part[(1 * (NB + 1) + r) * 64 + cl] + part[(2 * (NB + 1) + r) * 64 + cl] + part[(3 * (NB + 1) + r) * 64 + cl];
        p.modv()[((size_t)l * (NB + 1) + r) * (NMOD * D) + n] = v + bb;
      }
    }
    __syncthreads();
  }
}

struct ConvJob { const float* src; bf16_t* dst; int ld_src, ld_dst; };
__device__ __forceinline__ ConvJob conv_job(const Params& p, int t) {
  const int l = p.layer;
  const int tA = (D / 64) * (2560 / 64), tB = (D / 64) * (1280 / 64), tM = (D / 64) * (4 * D / 64);
  const int tWb = 4 * (MW / 64) * (D / 64), tWo = (D / 64) * (D / 64);
  const int tE = 16 * (D / 64) * (DE / 64);
  const float* win = p.w_in + (size_t)l * D * INW;
  ConvJob j;
  int u = t;
  if (u < tA) { int kt = u / (2560 / 64), nt = u % (2560 / 64); j.src = win + (size_t)kt * 64 * INW + nt * 64; j.ld_src = INW; j.dst = p.WinT() + (size_t)nt * 64 * D + kt * 64; j.ld_dst = D; return j; }
  u -= tA;
  if (u < tB) { int kt = u / (1280 / 64), nt = u % (1280 / 64); j.src = win + 2576 + (size_t)kt * 64 * INW + nt * 64; j.ld_src = INW; j.dst = p.WinT() + (size_t)(2560 + nt * 64) * D + kt * 64; j.ld_dst = D; return j; }
  u -= tB;
  if (u < tM) { int kt = u / (4 * D / 64), nt = u % (4 * D / 64); j.src = win + 3856 + (size_t)kt * 64 * INW + nt * 64; j.ld_src = INW; j.dst = p.WmT() + (size_t)nt * 64 * D + kt * 64; j.ld_dst = D; return j; }
  u -= tM;
  if (u < tWb) {
    int n = u / ((MW / 64) * (D / 64)), r = u % ((MW / 64) * (D / 64)); int kt = r / (D / 64), nt = r % (D / 64);
    j.src = p.w_branch + ((size_t)l * 4 + n) * MW * D + (size_t)kt * 64 * D + nt * 64; j.ld_src = D; j.dst = p.WbT() + (size_t)n * D * MW + (size_t)nt * 64 * MW + kt * 64; j.ld_dst = MW; return j;
  }
  u -= tWb;
  if (u < tWo) { int kt = u / (D / 64), nt = u % (D / 64); j.src = p.w_out + (size_t)l * D * D + (size_t)kt * 64 * D + nt * 64; j.ld_src = D; j.dst = p.WoT() + (size_t)nt * 64 * D + kt * 64; j.ld_dst = D; return j; }
  u -= tWo;
  if (u < 2 * tE) {
    int which = u / tE; int v = u % tE; int e = v / ((D / 64) * (DE / 64)), r = v % ((D / 64) * (DE / 64)); int kt = r / (DE / 64), nt = r % (DE / 64);
    j.src = (which ? p.moe_w3 : p.moe_w1) + ((size_t)l * 16 + e) * D * DE + (size_t)kt * 64 * DE + nt * 64; j.ld_src = DE;
    j.dst = (which ? p.W3T() : p.W1T()) + (size_t)e * DE * D + (size_t)nt * 64 * D + kt * 64; j.ld_dst = D; return j;
  }
  u -= 2 * tE;
  { int e = u / ((DE / 64) * (D / 64)), r = u % ((DE / 64) * (D / 64)); int kt = r / (D / 64), nt = r % (D / 64);
    j.src = p.moe_w2 + ((size_t)l * 16 + e) * DE * D + (size_t)kt * 64 * D + nt * 64; j.ld_src = D; j.dst = p.W2T() + (size_t)e * D * DE + (size_t)nt * 64 * DE + kt * 64; j.ld_dst = DE; }
  return j;
}
__device__ __forceinline__ void phase_convw(const Params& p, int part, char* smem_, int skip = 0) {
  const int tid = tidx(p);
  float* tile = (float*)smem_;
  const int l = p.layer;
  const int tA = (D / 64) * (2560 / 64), tB = (D / 64) * (1280 / 64), tM = (D / 64) * (4 * D / 64);
  const int tWb = 4 * (MW / 64) * (D / 64), tWo = (D / 64) * (D / 64);
  const int tE = 16 * (D / 64) * (DE / 64);
  const int total = tA + tB + tM + tWb + tWo + 3 * tE;
  {
    for (int i = p.bid * 256 + tid; i < (part ? 32 : 16) * D; i += p.gdim * 256) {
      int n = i / D, k = i - n * D;
      if (part == 0) p.WcgT()[(size_t)n * D + k] = f2bf(p.w_in[((size_t)l * D + k) * INW + 2560 + n]);
      else {
        float v = 0.f;
        if (n < 16) v = p.moe_w_router[((size_t)l * D + k) * 16 + n]; else if (n < 20) v = p.moe_w_group[((size_t)l * D + k) * 4 + (n - 16)];
        p.WrtT()[(size_t)n * D + k] = f2bf(v);
      }
    }
  }
  const int nA = tA + tB + tM + tWb + tWo;
  const int lo = part ? nA : 0, hi = part ? total : nA;
  const int tx = tid & 63, ty = tid >> 6;
  float r[16];
  const int nblk = p.gdim - skip;
  int t = (p.bid >= skip) ? lo + (p.bid - skip) : hi;
  ConvJob cur = conv_job(p, t < hi ? t : lo);
  if (t < hi) {
#pragma unroll
    for (int q = 0; q < 16; ++q) r[q] = cur.src[(size_t)(ty + 4 * q) * cur.ld_src + tx];
  }
  __syncthreads();
  for (; t < hi; t += nblk) {
#pragma unroll
    for (int q = 0; q < 16; ++q) tile[(ty + 4 * q) * 65 + tx] = r[q];
    const int tn = t + nblk;
    ConvJob nxt = conv_job(p, tn < hi ? tn : lo);
    if (tn < hi) {
#pragma unroll
      for (int q = 0; q < 16; ++q) r[q] = nxt.src[(size_t)(ty + 4 * q) * nxt.ld_src + tx];
    }
    __syncthreads();
#pragma unroll
    for (int c0 = 0; c0 < 2; ++c0) {
      int c = tid + c0 * 256; int n = c >> 3, kc = (c & 7) * 8;
      u32x4 v;
      v[0] = pack2(tile[(kc + 0) * 65 + n], tile[(kc + 1) * 65 + n]);
      v[1] = pack2(tile[(kc + 2) * 65 + n], tile[(kc + 3) * 65 + n]);
      v[2] = pack2(tile[(kc + 4) * 65 + n], tile[(kc + 5) * 65 + n]);
      v[3] = pack2(tile[(kc + 6) * 65 + n], tile[(kc + 7) * 65 + n]);
      *(u32x4*)(cur.dst + (size_t)n * cur.ld_dst + kc) = v;
    }
    cur = nxt;
    __syncthreads();
  }
}

__device__ __forceinline__ void phase_norm(const Params& p, int which, char* smem_) {
  const int tid = tidx(p);
  const int lane = tid & 63, wid = tid >> 6, nw = 256 >> 6, fr = lane & 15, fq = lane >> 4;
  const bool last = (p.layer == DEPTH - 1);
  float* slog = (float*)smem_ + wid * (16 * 33);
  int* hist = (int*)(smem_ + 4 * 16 * 33 * 4);
  int* hbase = hist + 32;
  static_assert((T / 16) % 4 == 0, "the four waves of a workgroup run the same number of tasks");
  for (int rt0 = p.bid * nw; rt0 < T / 16; rt0 += p.gdim * nw) {
    const int rt = rt0 + wid;
    const int r0 = rt * 16;
    const bool active = !(which == 1 && last && (r0 % TS) < CTX);
    int my_cls = 0, my_rank = 0; float my_wlo = 0.f, my_whi = 0.f;
    if (which == 1) { if (tid < 32) hist[tid] = 0; __syncthreads(); }
    if (active) {
    const float* sh = modrow(p, r0, which ? 3 : 0);
    const float* sc = modrow(p, r0, which ? 4 : 1);
    const bf16_t* W = which ? p.WrtT() : p.WcgT();
    f32x4 shv[D / 256], scv[D / 256];
#pragma unroll
    for (int i = 0; i < D / 256; ++i) { shv[i] = *(const f32x4*)(sh + i * 256 + lane * 4); scv[i] = *(const f32x4*)(sc + i * 256 + lane * 4); }
#pragma unroll 1
    for (int rb = 0; rb < 16; rb += 8) {
      f32x4 xv[8][D / 256];
#pragma unroll
      for (int q = 0; q < 8; ++q) {
        const float* xr = xrow_src(p, r0 + rb + q, p.layer == 0 && which == 0);
#pragma unroll
        for (int i = 0; i < D / 256; ++i) xv[q][i] = *(const f32x4*)(xr + i * 256 + lane * 4);
      }
#pragma unroll
      for (int q = 0; q < 8; ++q) {
        float ss = 0.f;
#pragma unroll
        for (int i = 0; i < D / 256; ++i) ss += xv[q][i][0] * xv[q][i][0] + xv[q][i][1] * xv[q][i][1] + xv[q][i][2] * xv[q][i][2] + xv[q][i][3] * xv[q][i][3];
        ss = wave_sum(ss, lane);
        const float rs = rsqrtf(ss * (1.0f / D) + EPS);
#pragma unroll
        for (int i = 0; i < D / 256; ++i) {
          float h0 = xv[q][i][0] * rs * (1.0f + scv[i][0]) + shv[i][0], h1 = xv[q][i][1] * rs * (1.0f + scv[i][1]) + shv[i][1];
          float h2 = xv[q][i][2] * rs * (1.0f + scv[i][2]) + shv[i][2], h3 = xv[q][i][3] * rs * (1.0f + scv[i][3]) + shv[i][3];
          u32x2 o; o[0] = pack2(h0, h1); o[1] = pack2(h2, h3);
          *(u32x2*)(p.h() + (size_t)(r0 + rb + q) * D + i * 256 + lane * 4) = o;
        }
      }
    }
    MEM_DRAIN(); WAVE_SYNC();
    const int row = r0 + fr;
    f32x4 acc0 = {0.f, 0.f, 0.f, 0.f}, acc1 = {0.f, 0.f, 0.f, 0.f};
#pragma unroll 8
    for (int ks = 0; ks < D / 32; ++ks) {
      const int k = ks * 32 + fq * 8;
      bf16x8 af = *(const bf16x8*)(p.h() + (size_t)row * D + k);
      bf16x8 w0 = *(const bf16x8*)(W + (size_t)fr * D + k);
      acc0 = MFMA16(af, w0, acc0);
      if (which) { bf16x8 w1 = *(const bf16x8*)(W + (size_t)(16 + fr) * D + k); acc1 = MFMA16(af, w1, acc1); }
    }
    if (which == 0) {
      const float bias = p.c_gate_b[p.layer * 16 + fr];
#pragma unroll
      for (int r = 0; r < 4; ++r) STORE_WT4(p.cg() + (size_t)(r0 + fq * 4 + r) * 16 + fr, acc0[r] + bias);
    } else {
#pragma unroll
      for (int r = 0; r < 4; ++r) { slog[(fq * 4 + r) * 33 + fr] = acc0[r]; slog[(fq * 4 + r) * 33 + 16 + fr] = acc1[r]; }
      WAVE_SYNC();
      if (lane < 16) {
        const float* lg = slog + lane * 33;
        const int r = r0 + lane;
        float ag[4];
#pragma unroll
        for (int g = 0; g < 4; ++g) ag[g] = lg[16 + g] + p.moe_b_group[p.layer * 4 + g];
        int gi = 0; float gm = ag[0];
#pragma unroll
        for (int g = 1; g < 4; ++g) if (ag[g] > gm) { gm = ag[g]; gi = g; }
        float gs = 0.f;
#pragma unroll
        for (int g = 0; g < 4; ++g) gs += expf(ag[g] - gm);
        const float gprob = 1.0f / gs;
        float el[4];
#pragma unroll
        for (int e = 0; e < 4; ++e) el[e] = lg[gi * 4 + e] + p.moe_b_router[p.layer * 16 + gi * 4 + e];
        int i0 = 0; float m0 = el[0];
#pragma unroll
        for (int e = 1; e < 4; ++e) if (el[e] > m0) { m0 = el[e]; i0 = e; }
        int i1 = -1; float m1 = -3.0e38f;
#pragma unroll
        for (int e = 0; e < 4; ++e) if (e != i0 && el[e] > m1) { m1 = el[e]; i1 = e; }
        const float e1 = expf(m1 - m0);
        const float w0 = gprob / (1.0f + e1), w1 = gprob * e1 / (1.0f + e1);
        const int lo = (i0 < i1) ? i0 : i1, hi = (i0 < i1) ? i1 : i0;
        const float wlo = (i0 < i1) ? w0 : w1, whi = (i0 < i1) ? w1 : w0;
        const int pair = (lo == 0) ? (hi - 1) : (lo == 1) ? (hi + 1) : 5;
        const int cls = gi * 6 + pair;
        my_cls = cls; my_wlo = wlo; my_whi = whi;
        my_rank = atomicAdd(hist + cls, 1);
      }
      WAVE_SYNC();
    }
    }
    if (which == 1) {
      __syncthreads();
      if (tid < NCLS) { const int n = hist[tid]; hbase[tid] = (n > 0) ? atomicAdd(p.moe_cnt() + (p.layer * 2) * NCLS + tid, n) : 0; }
      __syncthreads();
      if (active && lane < 16) {
        const int r = r0 + lane;
        const int pos = hbase[my_cls] + my_rank;
        STORE_WT4(p.moe_list() + (size_t)my_cls * T + pos, r);
        STORE_WT4(p.moe_tw() + (size_t)r * 2 + 0, my_wlo);
        STORE_WT4(p.moe_tw() + (size_t)r * 2 + 1, my_whi);
      }
    }
  }
}

constexpr int LDT = 72;
constexpr int GEMM_STAGE = 128 * 64;
constexpr int GEMM_SMEM = 2 * 2 * GEMM_STAGE * 2;
__device__ __forceinline__ int swz_off(int row, int chunk) { return row * 64 + ((chunk ^ ((row >> 1) & 7)) << 3); }

struct GemmRegs { u32x4 a[4], b[4]; };

struct GemmOffs { unsigned a[4], b[4]; };
template <class AF, class BF>
__device__ __forceinline__ void gemm_gload(GemmRegs& g, AF abase, BF bbase, const GemmOffs& o, int k0) {
  const bf16_t* pa = abase(k0); const bf16_t* pb = bbase(k0);
#pragma unroll
  for (int i = 0; i < 4; ++i) {
    g.a[i] = *(const u32x4*)(pa + o.a[i]);
    g.b[i] = *(const u32x4*)(pb + o.b[i]);
  }
}
__device__ __forceinline__ void gemm_sstore(int tid, const GemmRegs& g, bf16_t* sA, bf16_t* sB) {
#pragma unroll
  for (int i = 0; i < 4; ++i) {
    int c = tid + i * 256; int o = swz_off(c >> 3, c & 7);
    *(u32x4*)(sA + o) = g.a[i];
    *(u32x4*)(sB + o) = g.b[i];
  }
}
__device__ __forceinline__ void gemm_mma(int tid, f32x4 (&acc)[4][4], const bf16_t* sA, const bf16_t* sB, int wr, int wc) {
  const int lane = tid & 63, fr = lane & 15, fq = lane >> 4, sw = fr >> 1;
#pragma unroll
  for (int ks = 0; ks < 2; ++ks) {
    bf16x8 af[4], bfr[4];
    const int co = ((ks * 4 + fq) ^ sw) << 3;
#pragma unroll
    for (int m = 0; m < 4; ++m) af[m] = *(const bf16x8*)(sA + (wr * 64 + m * 16 + fr) * 64 + co);
#pragma unroll
    for (int n = 0; n < 4; ++n) bfr[n] = *(const bf16x8*)(sB + (wc * 64 + n * 16 + fr) * 64 + co);
#pragma unroll
    for (int m = 0; m < 4; ++m)
#pragma unroll
      for (int n = 0; n < 4; ++n) acc[m][n] = MFMA16(bfr[n], af[m], acc[m][n]);
  }
}
template <class AF, class BF>
__device__ __forceinline__ void gemm_kloop(int tid, f32x4 (&acc)[4][4], AF aptr, BF bptr, const GemmOffs& offs, int K, bf16_t* smem) {
  const int wid = tid >> 6, wr = wid >> 1, wc = wid & 1;
  GemmRegs g;
  const int nk = K / 64;
  gemm_gload(g, aptr, bptr, offs, 0);
  __syncthreads();
  gemm_sstore(tid, g, smem, smem + GEMM_STAGE);
  __syncthreads();
#pragma unroll 2
  for (int kt = 0; kt < nk; ++kt) {
    const int co = (kt & 1) * (2 * GEMM_STAGE), no = ((kt & 1) ^ 1) * (2 * GEMM_STAGE);
    if (kt + 1 < nk) gemm_gload(g, aptr, bptr, offs, (kt + 1) * 64);
    gemm_mma(tid, acc, smem + co, smem + co + GEMM_STAGE, wr, wc);
    if (kt + 1 < nk) gemm_sstore(tid, g, smem + no, smem + no + GEMM_STAGE);
    __syncthreads();
  }
}

#ifdef PROBE_A
template <int V, class AF, class BF>
__device__ __forceinline__ void gemm_kloop_x(int tid, f32x4 (&acc)[4][4], AF aptr, BF bptr, const GemmOffs& offs, int K, bf16_t* smem) {
  const int wid = tid >> 6, wr = wid >> 1, wc = wid & 1;
  GemmRegs g;
  const int nk = K / 64;
  gemm_gload(g, aptr, bptr, offs, 0);
  __syncthreads();
  gemm_sstore(tid, g, smem, smem + GEMM_STAGE);
  __syncthreads();
#pragma unroll 2
  for (int kt = 0; kt < nk; ++kt) {
    const int co = (kt & 1) * (2 * GEMM_STAGE), no = ((kt & 1) ^ 1) * (2 * GEMM_STAGE);
    if (V != 6) { if (kt + 1 < nk) gemm_gload(g, aptr, bptr, offs, (kt + 1) * 64); }
    if (V == 8 || V == 9) __builtin_amdgcn_sched_barrier(0);
    if (V == 9) __builtin_amdgcn_s_setprio(1);
    if (V != 5) gemm_mma(tid, acc, smem + co, smem + co + GEMM_STAGE, wr, wc);
    if (V == 9) __builtin_amdgcn_s_setprio(0);
    if (V == 8 || V == 9) __builtin_amdgcn_sched_barrier(0);
    if (V != 7) { if (kt + 1 < nk) gemm_sstore(tid, g, smem + no, smem + no + GEMM_STAGE); }
    else {
#pragma unroll
      for (int i = 0; i < 4; ++i) { asm volatile("" :: "v"(g.a[i])); asm volatile("" :: "v"(g.b[i])); }
    }
    __syncthreads();
  }
}
#endif

struct GemmOffs2 { unsigned a[2], b[2]; };
__device__ __forceinline__ int dma_g(int row) { return (0x78 >> (2 * ((row >> 2) & 3))) & 3; }
__device__ __forceinline__ int dma_row(int tid, int i) { return (2 * (tid >> 6) + i) * 16 + ((tid & 63) >> 2); }
__device__ __forceinline__ int dma_chunk(int tid, int row) { return (((tid & 3) ^ dma_g(row)) << 3); }
template <class AF, class BF>
__device__ __forceinline__ void gemm_kloop_dma(int tid, f32x4 (&acc)[4][4], AF abase, BF bbase, const GemmOffs2& o, int K, bf16_t* smem) {
  const int lane = tid & 63, wid = tid >> 6, wr = wid >> 1, wc = wid & 1, fr = lane & 15, fq = lane >> 4;
  const int nk = K / 32;
  char* sb = (char*)smem;
  const int ldst = (2 * wid) * 1024 + lane * 16;
  auto issue = [&](int kt, int stage) {
    const bf16_t* pa = abase(kt * 32); const bf16_t* pb = bbase(kt * 32);
    char* st = sb + stage * 16384 + ldst;
    GLDS16(pa + o.a[0], st); GLDS16(pa + o.a[1], st + 1024);
    GLDS16(pb + o.b[0], st + 8192); GLDS16(pb + o.b[1], st + 8192 + 1024);
  };
  __syncthreads();
  issue(0, 0);
  issue(1, 1);
  const int fro = ((fq ^ dma_g(fr)) << 4);
  for (int kp = 0; kp < nk; kp += 2) {
    WAIT_VM(0);
    RAW_BARRIER();
    if (kp + 2 < nk) { issue(kp + 2, (kp + 2) & 3); issue(kp + 3, (kp + 3) & 3); }
#pragma unroll
    for (int hs = 0; hs < 2; ++hs) {
      const int kt = kp + hs;
      const char* sa = sb + (kt & 3) * 16384; const char* sbb = sa + 8192;
      bf16x8 af[4], bfr[4];
#pragma unroll
      for (int m = 0; m < 4; ++m) af[m] = *(const bf16x8*)(sa + (wr * 64 + m * 16 + fr) * 64 + fro);
#pragma unroll
      for (int n = 0; n < 4; ++n) bfr[n] = *(const bf16x8*)(sbb + (wc * 64 + n * 16 + fr) * 64 + fro);
      SET_PRIO(1);
#pragma unroll
      for (int m = 0; m < 4; ++m)
#pragma unroll
        for (int n = 0; n < 4; ++n) acc[m][n] = MFMA16(bfr[n], af[m], acc[m][n]);
      SET_PRIO(0);
    }
  }
  __syncthreads();
}
#define ACC_ZERO(acc) _Pragma("unroll") for (int m_ = 0; m_ < 4; ++m_) _Pragma("unroll") for (int n_ = 0; n_ < 4; ++n_) acc[m_][n_] = f32x4{0.f, 0.f, 0.f, 0.f}

constexpr int EPI_LD = 136;
template <class VF>
__device__ __forceinline__ void epi_store_bf16(int tid, bf16_t* smem, bf16_t* dst, int ld_dst, VF val) {
  const int lane = tid & 63, wid = tid >> 6, wr = wid >> 1, wc = wid & 1, fr = lane & 15, fq = lane >> 4;
#pragma unroll
  for (int m = 0; m < 4; ++m)
#pragma unroll
    for (int n = 0; n < 4; ++n) {
      f32x4 v = val(m, n);
      u32x2 o; o[0] = pack2(v[0], v[1]); o[1] = pack2(v[2], v[3]);
      *(u32x2*)(smem + (wr * 64 + m * 16 + fr) * EPI_LD + wc * 64 + n * 16 + fq * 4) = o;
    }
  __syncthreads();
#pragma unroll
  for (int i = 0; i < 8; ++i) {
    int c = tid + i * 256; int row = c >> 4, ch = (c & 15) * 8;
    { const u32x4 v_ = *(const u32x4*)(smem + row * EPI_LD + ch); STORE_WT16(dst + (size_t)row * ld_dst + ch, v_); }
  }
}
constexpr int EPF_LD = 132;
template <class RF, class GF, class SF>
__device__ __forceinline__ void epi_rmw_f32(int tid, float* sf, f32x4 (&acc)[4][4], int col0, RF rowptr, GF gate, SF srcptr) {
  const int lane = tid & 63, wid = tid >> 6, wr = wid >> 1, wc = wid & 1, fr = lane & 15, fq = lane >> 4;
#pragma unroll
  for (int half = 0; half < 2; ++half) {
    if (half) __syncthreads();
    if (wr == half) {
#pragma unroll
      for (int m = 0; m < 4; ++m)
#pragma unroll
        for (int n = 0; n < 4; ++n) *(f32x4*)(sf + (m * 16 + fr) * EPF_LD + wc * 64 + n * 16 + fq * 4) = acc[m][n];
    }
    __syncthreads();
#pragma unroll
    for (int i = 0; i < 8; ++i) {
      int c = tid + i * 256; int r = c >> 5, ch = (c & 31) * 4;
      float* xr = rowptr(half * 64 + r);
      if (xr) {
        const float* g = gate(half * 64 + r);
        const float* xs_ = srcptr(half * 64 + r);
        f32x4 xv = *(const f32x4*)(xs_ + col0 + ch); f32x4 gv = *(const f32x4*)(g + col0 + ch); f32x4 av = *(const f32x4*)(sf + r * EPF_LD + ch);
#pragma unroll
        for (int q = 0; q < 4; ++q) xv[q] += gv[q] * av[q];
        STORE_WT16(xr + col0 + ch, xv);
      }
    }
  }
}
struct XcdSched {
  int x, j, nloc, seg, nrow, ncol, total;
  __device__ __forceinline__ XcdSched(const Params& p, int nrow_, int ncol_) {
    nrow = nrow_; ncol = ncol_;
    const int nrg = (nrow + 7) >> 3;
    total = nrg * 8 * ncol;
    if ((p.gdim & 7) == 0) { x = p.bid & 7; j = p.bid >> 3; nloc = p.gdim >> 3; seg = (total + 7) >> 3; }
    else { x = 0; j = p.bid; nloc = p.gdim; seg = total; }
  }
  __device__ __forceinline__ bool get(int it, int& tm, int& tn) const {
    const int u = j + it * nloc;
    if (u >= seg) return false;
    const int tp = x * seg + u;
    if (tp >= total) return false;
    const int g = tp / (8 * ncol), rem = tp - g * (8 * ncol);
    tn = rem >> 3; tm = g * 8 + (rem & 7);
    return true;
  }
};
__device__ __forceinline__ void phase_inproj(const Params& p, char* smem_) {
  const int tid = tidx(p);
  bf16_t* smem = (bf16_t*)smem_;
  const int lane = tid & 63, wid = tid >> 6, wr = wid >> 1, wc = wid & 1, fr = lane & 15, fq = lane >> 4;
  const int ntn = PW / 128;
  const XcdSched sch(p, MT, ntn);
  for (int it = 0;; ++it) {
    int tm, tn;
    if (!sch.get(it, tm, tn)) break;
    if (tm >= MT) continue;
    const bf16_t* A = p.h() + (size_t)tm * 128 * D;
    const bf16_t* B = p.WinT() + (size_t)tn * 128 * D;
    f32x4 acc[4][4]; ACC_ZERO(acc);
    GemmOffs2 go;
#pragma unroll
    for (int i = 0; i < 2; ++i) { int row = dma_row(tid, i); go.a[i] = (unsigned)(row * D + dma_chunk(tid, row)); go.b[i] = go.a[i]; }
    gemm_kloop_dma(tid, acc, [&](int k0) { return A + k0; }, [&](int k0) { return B + k0; }, go, D, smem);
    epi_store_bf16(tid, smem, p.P() + (size_t)tm * 128 * PW + tn * 128, PW, [&](int m, int n) { return acc[m][n]; });
  }
}


#ifdef PROBE_A
template <int V>
__device__ __forceinline__ void phase_exp(const Params& p, char* smem_) {
  const int tid = tidx(p);
  bf16_t* smem = (bf16_t*)smem_;
  const int lane = tid & 63, wid = tid >> 6, wr = wid >> 1, wc = wid & 1, fr = lane & 15, fq = lane >> 4;
  const int ntn = PW / 128;
  const XcdSched sch(p, MT, ntn);
  if (V == 10 || V == 11) {
    if ((p.bid >> 3) >= (p.gdim >> 4)) { for (int q = 0; q < (V == 10 ? 1 : 3); ++q) __builtin_amdgcn_s_sleep(16); }
  }
  for (int it = 0;; ++it) {
    int tm, tn;
    if (V == 3) { int t = p.bid + it * p.gdim; if (t >= MT * ntn) break; tm = t / ntn; tn = t % ntn; }
    else { if (!sch.get(it, tm, tn)) break; if (tm >= MT) continue; }
    const bf16_t* A = p.h() + (size_t)((V == 1) ? 0 : tm) * 128 * D;
    const bf16_t* B = p.WinT() + (size_t)((V == 1) ? 0 : tn) * 128 * D;
    f32x4 acc[4][4]; ACC_ZERO(acc);
    GemmOffs go;
#pragma unroll
    for (int i = 0; i < 4; ++i) {
      int c = tid + i * 256;
      go.a[i] = (V == 2) ? (unsigned)(c * 8) : (unsigned)((c >> 3) * D + (c & 7) * 8);
      go.b[i] = go.a[i];
    }
    if (V == 2) gemm_kloop(tid, acc, [&](int k0) { return A + (k0 >> 6) * 8192; }, [&](int k0) { return B + (k0 >> 6) * 8192; }, go, D, smem);
    else if (V >= 5) gemm_kloop_x<V>(tid, acc, [&](int k0) { return A + k0; }, [&](int k0) { return B + k0; }, go, D, smem);
    else gemm_kloop(tid, acc, [&](int k0) { return A + k0; }, [&](int k0) { return B + k0; }, go, D, smem);
    if (V == 4) {
#pragma unroll
      for (int m = 0; m < 4; ++m)
#pragma unroll
        for (int n = 0; n < 4; ++n) asm volatile("" :: "v"(acc[m][n]));
    } else {
#pragma unroll
    for (int m = 0; m < 4; ++m)
#pragma unroll
      for (int n = 0; n < 4; ++n) {
        int row = tm * 128 + wr * 64 + m * 16 + fr, col = tn * 128 + wc * 64 + n * 16 + fq * 4;
        u32x2 o; o[0] = pack2(acc[m][n][0], acc[m][n][1]); o[1] = pack2(acc[m][n][2], acc[m][n][3]);
        *(u32x2*)(p.P() + (size_t)row * PW + col) = o;
      }
    }
  }
}
#endif

__device__ __forceinline__ void unpack8(u32x4 v, float* dst) {
#pragma unroll
  for (int j = 0; j < 4; ++j) { dst[2 * j] = u2f(v[j] << 16); dst[2 * j + 1] = u2f(v[j] & 0xFFFF0000u); }
}
__device__ __forceinline__ int first_item(const Params& p, int rot) { int g = p.gdim; int v = (p.bid - rot) % g; return v < 0 ? v + g : v; }
__device__ __forceinline__ int proc_tile(int dir, int idx) { return dir == 0 ? idx : (idx < CT ? CT - 1 - idx : NT - 1 - (idx - CT)); }

constexpr int LT = 64;
constexpr int NLT = TS / LT, CLT = CTX / LT;
__device__ __forceinline__ int proc_ltile(int dir, int idx) { return dir == 0 ? idx : (idx < CLT ? CLT - 1 - idx : NLT - 1 - (idx - CLT)); }
constexpr int LRU_LD = 72;
constexpr int LRU_SMEM = 2 * LT * LRU_LD * 2;
template <bool FINAL, int dir>
__device__ __forceinline__ void lru_dir(int tid, const Params& p, const bf16_t* su, int b, int tile, int hh, int nt, f32x4 (&hsum)[4]) {
  const int lane = tid & 63, fr = lane & 15, fq = lane >> 4;
  const int l = p.layer;
  const int c = hh * 64 + nt * 16 + fr;
  f32x4 ar[4], ai[4];
#pragma unroll
  for (int m = 0; m < 4; ++m) { ar[m] = f32x4{0.f, 0.f, 0.f, 0.f}; ai[m] = f32x4{0.f, 0.f, 0.f, 0.f}; }
  const float* wr_ = p.a_gate_w + ((((size_t)(l * 2 + dir) * 2 + 0) * NH + hh) * 64) * 64;
  const float* wi_ = p.a_gate_w + ((((size_t)(l * 2 + dir) * 2 + 1) * NH + hh) * 64) * 64;
#pragma unroll
  for (int ks = 0; ks < 2; ++ks) {
    bf16x8 br, bi;
#pragma unroll
    for (int e = 0; e < 8; ++e) {
      int k = ks * 32 + fq * 8 + e;
      br[e] = (short)f2bf(wr_[k * 64 + nt * 16 + fr]);
      bi[e] = (short)f2bf(wi_[k * 64 + nt * 16 + fr]);
    }
#pragma unroll
    for (int m = 0; m < 4; ++m) {
      bf16x8 af = *(const bf16x8*)(su + (m * 16 + fr) * LRU_LD + ks * 32 + fq * 8);
      ar[m] = MFMA16(af, br, ar[m]);
      ai[m] = MFMA16(af, bi, ai[m]);
    }
  }
  const float b_r = p.a_gate_b[((l * 2 + dir) * 2 + 0) * MW + c], b_i = p.a_gate_b[((l * 2 + dir) * 2 + 1) * MW + c];
  const float lsl = 8.0f * logsigf_(p.a_lambda[(l * 2 + dir) * MW + c]);
#pragma unroll
  for (int m = 0; m < 4; ++m)
#pragma unroll
    for (int r = 0; r < 4; ++r) {
      int i = m * 16 + fq * 4 + r;
      float rg = fsigmoid(ar[m][r] + b_r), ig = fsigmoid(ai[m][r] + b_i);
      float la = lsl * rg;
      float uv = bf2f(su[i * LRU_LD + nt * 16 + fr]);
      float t2 = 2.0f * la;
      float om_s = -t2 * (1.0f + t2 * (0.5f + t2 * (0.16666667f + t2 * (0.041666668f + t2 * 0.0083333338f)))), om_e = 1.0f - fexp(t2);
      float om = (t2 > -0.25f) ? om_s : om_e;
      ar[m][r] = fexp(la);
      ai[m][r] = fsqrt(om) * ig * uv;
    }
  float carry = 0.f, atot = 1.f;
  if (FINAL) carry = p.lruC()[(((size_t)b * 2 + dir) * NLT + tile) * 256 + c];
#pragma unroll
  for (int mm = 0; mm < 4; ++mm) {
    const int m = dir ? 3 - mm : mm;
    float pa[4], hl[4];
    if (dir == 0) {
      pa[0] = ar[m][0]; hl[0] = ai[m][0];
#pragma unroll
      for (int r = 1; r < 4; ++r) { pa[r] = pa[r - 1] * ar[m][r]; hl[r] = ar[m][r] * hl[r - 1] + ai[m][r]; }
    } else {
      pa[3] = ar[m][3]; hl[3] = ai[m][3];
#pragma unroll
      for (int r = 2; r >= 0; --r) { pa[r] = pa[r + 1] * ar[m][r]; hl[r] = ar[m][r] * hl[r + 1] + ai[m][r]; }
    }
    const float gp = dir ? pa[0] : pa[3], gh = dir ? hl[0] : hl[3];
    float Pg[4], Hg[4];
#pragma unroll
    for (int g = 0; g < 4; ++g) { Pg[g] = SHFL(gp, fr + 16 * g); Hg[g] = SHFL(gh, fr + 16 * g); }
    float cin = carry;
#pragma unroll
    for (int gg = 0; gg < 4; ++gg) {
      const int g = dir ? 3 - gg : gg;
      bool before = dir ? (g > fq) : (g < fq);
      if (before) cin = Pg[g] * cin + Hg[g];
      carry = Pg[g] * carry + Hg[g];
      atot *= Pg[g];
    }
    if (FINAL) {
#pragma unroll
      for (int r = 0; r < 4; ++r) hsum[m][r] += hl[r] + pa[r] * cin;
    }
  }
  if (!FINAL && fq == 0) {
    float* S = p.lruS() + ((((size_t)b * 2 + dir) * NLT + tile) * 2) * 256;
    S[c] = atot; S[256 + c] = carry;
  }
}
template <bool FINAL>
__device__ __forceinline__ void phase_lru(const Params& p, char* smem_) {
  const int tid = tidx(p);
  bf16_t* su = (bf16_t*)smem_;
  bf16_t* gy = su + LT * LRU_LD;
  const int lane = tid & 63, nt = tid >> 6, fr = lane & 15, fq = lane >> 4;
  const int l = p.layer;
  for (int t = first_item(p, 0); t < NB * NLT * NH; t += p.gdim) {
    const int hh = t % NH, tile = (t / NH) % NLT, b = t / (NH * NLT);
    const int s0 = tile * LT;
    const int seg_lo = (tile < CLT) ? 0 : CTX, seg_hi = (tile < CLT) ? CTX : TS;
    __syncthreads();
    {
      const int cc = tid & 7, tg = tid >> 3;
      const int c0 = hh * 64 + cc * 8;
      float w[4][8], bias[8];
#pragma unroll
      for (int k = 0; k < 4; ++k) {
        f32x4 w0 = *(const f32x4*)(p.a_conv_w + (l * 4 + k) * MW + c0), w1 = *(const f32x4*)(p.a_conv_w + (l * 4 + k) * MW + c0 + 4);
#pragma unroll
        for (int j = 0; j < 4; ++j) { w[k][j] = w0[j]; w[k][4 + j] = w1[j]; }
      }
      {
        f32x4 b0 = *(const f32x4*)(p.a_conv_b + l * MW + c0), b1 = *(const f32x4*)(p.a_conv_b + l * MW + c0 + 4);
#pragma unroll
        for (int j = 0; j < 4; ++j) { bias[j] = b0[j]; bias[4 + j] = b1[j]; }
      }
      float win[5][8];
      const int i0 = tg * 2;
#pragma unroll
      for (int q = 0; q < 5; ++q) {
        const int sq = s0 + i0 - 2 + q;
        const bool ok = (sq >= seg_lo && sq < seg_hi);
        const int sc_ = sq < seg_lo ? seg_lo : (sq >= seg_hi ? seg_hi - 1 : sq);
        u32x4 v = *(const u32x4*)(p.P() + ((size_t)b * TS + sc_) * PW + C_AX * 256 + c0);
#pragma unroll
        for (int j = 0; j < 4; ++j) { if (!ok) v[j] = 0u; win[q][2 * j] = u2f(v[j] << 16); win[q][2 * j + 1] = u2f(v[j] & 0xFFFF0000u); }
      }
      u32x4 ga[2];
      if (FINAL) {
#pragma unroll
        for (int i = 0; i < 2; ++i) ga[i] = *(const u32x4*)(p.P() + ((size_t)b * TS + s0 + i0 + i) * PW + C_AG * 256 + c0);
      }
#pragma unroll
      for (int i = 0; i < 2; ++i) {
        float o[8];
#pragma unroll
        for (int j = 0; j < 8; ++j) o[j] = bias[j] + w[0][j] * win[i][j] + w[1][j] * win[i + 1][j] + w[2][j] * win[i + 2][j] + w[3][j] * win[i + 3][j];
        u32x4 ov; ov[0] = pack2(o[0], o[1]); ov[1] = pack2(o[2], o[3]); ov[2] = pack2(o[4], o[5]); ov[3] = pack2(o[6], o[7]);
        *(u32x4*)(su + (i0 + i) * LRU_LD + cc * 8) = ov;
        if (FINAL) {
          float g[8]; unpack8(ga[i], g);
          u32x4 gv; gv[0] = pack2(geluf_(g[0]), geluf_(g[1])); gv[1] = pack2(geluf_(g[2]), geluf_(g[3])); gv[2] = pack2(geluf_(g[4]), geluf_(g[5])); gv[3] = pack2(geluf_(g[6]), geluf_(g[7]));
          *(u32x4*)(gy + (i0 + i) * LRU_LD + cc * 8) = gv;
        }
      }
    }
    __syncthreads();
    {
      f32x4 hsum[4];
#pragma unroll
      for (int m = 0; m < 4; ++m) hsum[m] = f32x4{0.f, 0.f, 0.f, 0.f};
      lru_dir<FINAL, 0>(tid, p, su, b, tile, hh, nt, hsum);
      lru_dir<FINAL, 1>(tid, p, su, b, tile, hh, nt, hsum);
      if (FINAL) {
#pragma unroll
        for (int m = 0; m < 4; ++m)
#pragma unroll
          for (int r = 0; r < 4; ++r) {
            int i = m * 16 + fq * 4 + r;
            gy[i * LRU_LD + nt * 16 + fr] = f2bf(bf2f(gy[i * LRU_LD + nt * 16 + fr]) * hsum[m][r]);
          }
      }
    }
    if (FINAL) {
      __syncthreads();
#pragma unroll
      for (int q = 0; q < 2; ++q) {
        int ch = tid + q * 256; int i = ch >> 3, c8 = (ch & 7) * 8;
        { const u32x4 v_ = *(const u32x4*)(gy + i * LRU_LD + c8); STORE_WT16(p.y() + ((size_t)b * TS + s0 + i) * (4 * MW) + hh * 64 + c8, v_); }
      }
    }
  }
}
__device__ __forceinline__ void phase_lru_carry(const Params& p) {
  const int tid = tidx(p);
  for (int i = p.bid * 256 + tid; i < NB * 2 * 256; i += p.gdim * 256) {
    int c = i & 255, dir = (i >> 8) & 1, b = i >> 9;
    float hcar = 0.f;
    constexpr int HC = NLT / 2;
#pragma unroll 1
    for (int half = 0; half < 2; ++half) {
      float aa[HC], hh_[HC];
#pragma unroll
      for (int k = 0; k < HC; ++k) {
        size_t base = ((size_t)b * 2 + dir) * NLT + proc_ltile(dir, half * HC + k);
        aa[k] = p.lruS()[base * 512 + c]; hh_[k] = p.lruS()[base * 512 + 256 + c];
      }
#pragma unroll
      for (int k = 0; k < HC; ++k) {
        size_t base = ((size_t)b * 2 + dir) * NLT + proc_ltile(dir, half * HC + k);
        p.lruC()[base * 256 + c] = hcar;
        hcar = aa[k] * hcar + hh_[k];
      }
    }
  }
}

constexpr int LDV = 136;
__device__ __forceinline__ void load_rope_row(const Params& p, const bf16_t* src, int s, int half, float scale, float* o) {
  unpack8(*(const u32x4*)(src + half * 16), o);
  unpack8(*(const u32x4*)(src + half * 16 + 8), o + 8);
  unpack8(*(const u32x4*)(src + 32 + half * 16), o + 16);
  unpack8(*(const u32x4*)(src + 32 + half * 16 + 8), o + 24);
  if (s >= CTX) {
    const f32x4* tb = (const f32x4*)(p.rope() + ((size_t)(s - CTX) * 32 + half * 16) * 2);
#pragma unroll
    for (int i = 0; i < 8; ++i) {
      f32x4 cs = tb[i];
      float t1 = o[2 * i], t2 = o[16 + 2 * i];
      o[2 * i] = (t1 * cs[0] - t2 * cs[1]) * scale; o[16 + 2 * i] = (t1 * cs[1] + t2 * cs[0]) * scale;
      t1 = o[2 * i + 1]; t2 = o[16 + 2 * i + 1];
      o[2 * i + 1] = (t1 * cs[2] - t2 * cs[3]) * scale; o[16 + 2 * i + 1] = (t1 * cs[3] + t2 * cs[2]) * scale;
    }
  } else {
#pragma unroll
    for (int i = 0; i < 32; ++i) o[i] *= scale;
  }
}
constexpr int RETA_SMEM = 3 * 64 * LDV * 2;
__device__ __forceinline__ void phase_ret_a(const Params& p, char* smem_) {
  const int tid = tidx(p);
  bf16_t* Vt = (bf16_t*)smem_; bf16_t* Ktf = Vt + 64 * LDV; bf16_t* Ktb = Ktf + 64 * LDV;
  const int lane = tid & 63, wid = tid >> 6, fr = lane & 15, fq = lane >> 4;
  const int l = p.layer;
  for (int t = first_item(p, 64); t < NB * NH * NT; t += p.gdim) {
    const int tile = t % NT, hh = (t / NT) % NH, b = t / (NT * NH);
    const float lgf = logsigf_(p.b_theta[(l * 2 + 0) * NH + hh]) * 1.4426950408889634f;
    const float lgb = logsigf_(p.b_theta[(l * 2 + 1) * NH + hh]) * 1.4426950408889634f;
    __syncthreads();
    {
      const int j = tid >> 1, half = tid & 1;
      const int s = tile * 128 + j;
      const bf16_t* prow = p.P() + ((size_t)b * TS + s) * PW;
      float k[32];
      load_rope_row(p, prow + C_BK * 256 + hh * 64, s, half, 0.125f, k);
      const float wf = exp2f(lgf * (float)(127 - j)), wb = exp2f(lgb * (float)j);
#pragma unroll
      for (int i = 0; i < 32; ++i) {
        int d = (i < 16) ? (half * 16 + i) : (32 + half * 16 + i - 16);
        Ktf[d * LDV + j] = f2bf(k[i] * wf); Ktb[d * LDV + j] = f2bf(k[i] * wb);
      }
      float v[32];
      unpack8(*(const u32x4*)(prow + C_BV * 256 + hh * 64 + half * 32), v);
      unpack8(*(const u32x4*)(prow + C_BV * 256 + hh * 64 + half * 32 + 8), v + 8);
      unpack8(*(const u32x4*)(prow + C_BV * 256 + hh * 64 + half * 32 + 16), v + 16);
      unpack8(*(const u32x4*)(prow + C_BV * 256 + hh * 64 + half * 32 + 24), v + 24);
#pragma unroll
      for (int i = 0; i < 32; ++i) Vt[(half * 32 + i) * LDV + j] = f2bf(v[i]);
    }
    __syncthreads();
    f32x4 acc[2][4];
#pragma unroll
    for (int d = 0; d < 2; ++d)
#pragma unroll
      for (int n = 0; n < 4; ++n) acc[d][n] = f32x4{0.f, 0.f, 0.f, 0.f};
#pragma unroll
    for (int ks = 0; ks < 4; ++ks) {
      bf16x8 af = *(const bf16x8*)(Vt + (wid * 16 + fr) * LDV + ks * 32 + fq * 8);
#pragma unroll
      for (int n = 0; n < 4; ++n) {
        bf16x8 b0 = *(const bf16x8*)(Ktf + (n * 16 + fr) * LDV + ks * 32 + fq * 8);
        bf16x8 b1 = *(const bf16x8*)(Ktb + (n * 16 + fr) * LDV + ks * 32 + fq * 8);
        acc[0][n] = MFMA16(af, b0, acc[0][n]);
        acc[1][n] = MFMA16(af, b1, acc[1][n]);
      }
    }
#pragma unroll
    for (int d = 0; d < 2; ++d) {
      float* dst = p.retKV() + ((((size_t)b * NH + hh) * 2 + d) * NT + tile) * 4096;
#pragma unroll
      for (int n = 0; n < 4; ++n)
#pragma unroll
        for (int r = 0; r < 4; ++r) dst[(wid * 16 + fq * 4 + r) * 64 + n * 16 + fr] = acc[d][n][r];
    }
  }
}
__device__ __forceinline__ void phase_ret_b(const Params& p) {
  const int tid = tidx(p);
  const int l = p.layer;
  for (int i = p.bid * 256 + tid; i < NB * NH * 2 * 4096; i += p.gdim * 256) {
    int el = i & 4095, dir = (i >> 12) & 1, hh = (i >> 13) % NH, b = i / (8192 * NH);
    float g = expf(128.0f * logsigf_(p.b_theta[(l * 2 + dir) * NH + hh]));
    size_t base = (((size_t)b * NH + hh) * 2 + dir) * NT;
    float kv[NT];
#pragma unroll
    for (int k = 0; k < NT; ++k) kv[k] = p.retKV()[(base + proc_tile(dir, k)) * 4096 + el];
    float S = 0.f;
#pragma unroll
    for (int k = 0; k < NT; ++k) {
      p.retSp()[(base + proc_tile(dir, k)) * 4096 + el] = f2bf(S);
      S = g * S + kv[k];
    }
  }
}
__device__ __forceinline__ bf16x8 frag_perm8(const bf16_t* base, int fq) {
  u32x2 lo = *(const u32x2*)(base + 4 * fq), hi = *(const u32x2*)(base + 16 + 4 * fq);
  u32x4 v; v[0] = lo[0]; v[1] = lo[1]; v[2] = hi[0]; v[3] = hi[1];
  return __builtin_bit_cast(bf16x8, v);
}
__device__ __forceinline__ bf16x8 pack_frag(f32x4 a, f32x4 b) {
  u32x4 v; v[0] = pack2(a[0], a[1]); v[1] = pack2(a[2], a[3]); v[2] = pack2(b[0], b[1]); v[3] = pack2(b[2], b[3]);
  return __builtin_bit_cast(bf16x8, v);
}
constexpr int RETC_SMEM = (2 * 128 * LDT + 64 * LDV + 2 * 64 * LDT) * 2;
__device__ __forceinline__ void phase_ret_c(const Params& p, char* smem_) {
  const int tid = tidx(p);
  bf16_t* Qs = (bf16_t*)smem_; bf16_t* Ks = Qs + 128 * LDT; bf16_t* Vt = Ks + 128 * LDT;
  bf16_t* Spf = Vt + 64 * LDV; bf16_t* Spb = Spf + 64 * LDT;
  const int lane = tid & 63, wid = tid >> 6, fr = lane & 15, fq = lane >> 4;
  const int l = p.layer;
  for (int t = first_item(p, 64); t < NB * NH * NT; t += p.gdim) {
    const int tile = t % NT, hh = (t / NT) % NH, b = t / (NT * NH);
    const float lgf = logsigf_(p.b_theta[(l * 2 + 0) * NH + hh]) * 1.4426950408889634f;
    const float lgb = logsigf_(p.b_theta[(l * 2 + 1) * NH + hh]) * 1.4426950408889634f;
    __syncthreads();
    {
      const int j = tid >> 1, half = tid & 1;
      const int s = tile * 128 + j;
      const bf16_t* prow = p.P() + ((size_t)b * TS + s) * PW;
      float k[32];
      load_rope_row(p, prow + C_BQ * 256 + hh * 64, s, half, 1.0f, k);
#pragma unroll
      for (int c = 0; c < 4; ++c) {
        u32x4 v; v[0] = pack2(k[c * 8 + 0], k[c * 8 + 1]); v[1] = pack2(k[c * 8 + 2], k[c * 8 + 3]); v[2] = pack2(k[c * 8 + 4], k[c * 8 + 5]); v[3] = pack2(k[c * 8 + 6], k[c * 8 + 7]);
        int d0 = (c < 2) ? (half * 16 + c * 8) : (32 + half * 16 + (c - 2) * 8);
        *(u32x4*)(Qs + j * LDT + d0) = v;
      }
      load_rope_row(p, prow + C_BK * 256 + hh * 64, s, half, 0.125f, k);
#pragma unroll
      for (int c = 0; c < 4; ++c) {
        u32x4 v; v[0] = pack2(k[c * 8 + 0], k[c * 8 + 1]); v[1] = pack2(k[c * 8 + 2], k[c * 8 + 3]); v[2] = pack2(k[c * 8 + 4], k[c * 8 + 5]); v[3] = pack2(k[c * 8 + 6], k[c * 8 + 7]);
        int d0 = (c < 2) ? (half * 16 + c * 8) : (32 + half * 16 + (c - 2) * 8);
        *(u32x4*)(Ks + j * LDT + d0) = v;
      }
#pragma unroll
      for (int c = 0; c < 4; ++c) {
        u32x4 v = *(const u32x4*)(prow + C_BV * 256 + hh * 64 + half * 32 + c * 8);
#pragma unroll
        for (int q = 0; q < 4; ++q) {
          Vt[(half * 32 + c * 8 + 2 * q) * LDV + j] = (bf16_t)(v[q] & 0xFFFFu);
          Vt[(half * 32 + c * 8 + 2 * q + 1) * LDV + j] = (bf16_t)(v[q] >> 16);
        }
      }
      const bf16_t* spf = p.retSp() + ((((size_t)b * NH + hh) * 2 + 0) * NT + tile) * 4096;
      const bf16_t* spb = p.retSp() + ((((size_t)b * NH + hh) * 2 + 1) * NT + tile) * 4096;
#pragma unroll
      for (int i = 0; i < 2; ++i) {
        int c = tid + i * 256; int e = c >> 3, d0 = (c & 7) * 8;
        *(u32x4*)(Spf + e * LDT + d0) = *(const u32x4*)(spf + e * 64 + d0);
        *(u32x4*)(Spb + e * LDT + d0) = *(const u32x4*)(spb + e * 64 + d0);
      }
    }
    __syncthreads();
#pragma unroll 1
    for (int mi = 0; mi < 2; ++mi) {
      NO_HOIST();
      const int i = wid * 32 + mi * 16 + fr;
      f32x4 sc[8];
#pragma unroll
      for (int nj = 0; nj < 8; ++nj) sc[nj] = f32x4{0.f, 0.f, 0.f, 0.f};
      f32x4 ao[4], af_[4], ab_[4];
#pragma unroll
      for (int n = 0; n < 4; ++n) { ao[n] = f32x4{0.f, 0.f, 0.f, 0.f}; af_[n] = ao[n]; ab_[n] = ao[n]; }
#pragma unroll
      for (int ks = 0; ks < 2; ++ks) {
        bf16x8 qf = *(const bf16x8*)(Qs + i * LDT + ks * 32 + fq * 8);
#pragma unroll
        for (int nj = 0; nj < 8; ++nj) {
          bf16x8 kf = *(const bf16x8*)(Ks + (nj * 16 + fr) * LDT + ks * 32 + fq * 8);
          sc[nj] = MFMA16(kf, qf, sc[nj]);
        }
#pragma unroll
        for (int n = 0; n < 4; ++n) {
          bf16x8 s0 = *(const bf16x8*)(Spf + (n * 16 + fr) * LDT + ks * 32 + fq * 8);
          bf16x8 s1 = *(const bf16x8*)(Spb + (n * 16 + fr) * LDT + ks * 32 + fq * 8);
          af_[n] = MFMA16(s0, qf, af_[n]); ab_[n] = MFMA16(s1, qf, ab_[n]);
        }
      }
#pragma unroll
      for (int nj = 0; nj < 8; ++nj)
#pragma unroll
        for (int r = 0; r < 4; ++r) {
          int j = nj * 16 + fq * 4 + r;
          float fd = (float)(i - j);
          sc[nj][r] *= fexp2(fminf(lgf * fd, -lgb * fd));
        }
#pragma unroll
      for (int ks = 0; ks < 4; ++ks) {
        bf16x8 sf = pack_frag(sc[2 * ks], sc[2 * ks + 1]);
#pragma unroll
        for (int n = 0; n < 4; ++n) {
          bf16x8 vf = frag_perm8(Vt + (n * 16 + fr) * LDV + ks * 32, fq);
          ao[n] = MFMA16(vf, sf, ao[n]);
        }
      }
      const float sfw = fexp2(lgf * (float)(i + 1)), sbw = fexp2(lgb * (float)(128 - i));
      float o[4][4]; float sum = 0.f;
#pragma unroll
      for (int n = 0; n < 4; ++n)
#pragma unroll
        for (int r = 0; r < 4; ++r) { o[n][r] = ao[n][r] + sfw * af_[n][r] + sbw * ab_[n][r]; sum += o[n][r]; }
      sum += SHFL_XOR(sum, 16); sum += SHFL_XOR(sum, 32);
      const float mean = sum * (1.0f / 64.0f);
      float var = 0.f;
#pragma unroll
      for (int n = 0; n < 4; ++n)
#pragma unroll
        for (int r = 0; r < 4; ++r) { o[n][r] -= mean; var += o[n][r] * o[n][r]; }
      var += SHFL_XOR(var, 16); var += SHFL_XOR(var, 32);
      const float rs = rsqrtf(var * (1.0f / 64.0f) + EPS);
      const size_t row = (size_t)b * TS + tile * 128 + i;
#pragma unroll
      for (int n = 0; n < 4; ++n) {
        int e = n * 16 + fq * 4;
        u32x2 gv = *(const u32x2*)(p.P() + row * PW + C_BG * 256 + hh * 64 + e);
        float g0 = u2f(gv[0] << 16), g1 = u2f(gv[0] & 0xFFFF0000u), g2 = u2f(gv[1] << 16), g3 = u2f(gv[1] & 0xFFFF0000u);
        u32x2 ov; ov[0] = pack2(o[n][0] * rs * fsilu(g0), o[n][1] * rs * fsilu(g1)); ov[1] = pack2(o[n][2] * rs * fsilu(g2), o[n][3] * rs * fsilu(g3));
        STORE_WT8(p.y() + row * (4 * MW) + 1 * MW + hh * 64 + e, ov);
      }
    }
  }
}

__device__ __forceinline__ void conv_silu8(const Params& p, int b, int s, int seg_lo, int seg_hi, int cb, int cw, int ch0, float scale, float* o) {
  const int l = p.layer;
  {
    f32x4 b0 = *(const f32x4*)(p.c_conv_b + l * 512 + cw + ch0), b1 = *(const f32x4*)(p.c_conv_b + l * 512 + cw + ch0 + 4);
#pragma unroll
    for (int j = 0; j < 4; ++j) { o[j] = b0[j]; o[4 + j] = b1[j]; }
  }
#pragma unroll
  for (int k = 0; k < 4; ++k) {
    int sk = s + k - 2;
    const float msk = (sk >= seg_lo && sk < seg_hi) ? 1.0f : 0.0f;
    const int skc = sk < seg_lo ? seg_lo : (sk >= seg_hi ? seg_hi - 1 : sk);
    {
      float v[8]; unpack8(*(const u32x4*)(p.P() + ((size_t)b * TS + skc) * PW + cb * 256 + ch0), v);
      const float* w = p.c_conv_w + (size_t)(l * 4 + k) * 512 + cw + ch0;
      f32x4 w0 = *(const f32x4*)w * msk, w1 = *(const f32x4*)(w + 4) * msk;
#pragma unroll
      for (int j = 0; j < 4; ++j) { o[j] += w0[j] * v[j]; o[4 + j] += w1[j] * v[4 + j]; }
    }
  }
#pragma unroll
  for (int j = 0; j < 8; ++j) o[j] = fsilu(o[j]) * scale;
}
__device__ __forceinline__ void mls_gates(int tid, const Params& p, int b, int tile, int hh, float* cumf, float* cumb, float* lif, float* lib) {
  const int tdx = tid;
  {
    int i = tdx & 127; const float* g = p.cg() + ((size_t)b * TS + tile * 128 + i) * 16;
    if (tdx < 128) { lif[i] = g[0 * 4 + hh]; cumf[i] = logsigf_(g[1 * 4 + hh]); }
    else { lib[i] = g[2 * 4 + hh]; cumb[i] = logsigf_(g[3 * 4 + hh]); }
  }
  __syncthreads();
  for (int off = 1; off < 128; off <<= 1) {
    float v = 0.f; int i = tdx & 127;
    if (tdx < 128) { if (i >= off) v = cumf[i - off]; } else { if (i + off < 128) v = cumb[i + off]; }
    __syncthreads();
    if (tdx < 128) cumf[i] += v; else cumb[i] += v;
    __syncthreads();
  }
}
constexpr int MLSA_SMEM = (80 * LDV + 2 * 64 * LDV) * 2 + 4 * 128 * 4;
__device__ __forceinline__ void phase_mls_a(const Params& p, char* smem_) {
  const int tid = tidx(p);
  bf16_t* Vt = (bf16_t*)smem_; bf16_t* Ktf = Vt + 80 * LDV; bf16_t* Ktb = Ktf + 64 * LDV;
  float* cumf = (float*)(Ktb + 64 * LDV); float* cumb = cumf + 128; float* lif = cumb + 128; float* lib = lif + 128;
  const int lane = tid & 63, wid = tid >> 6, fr = lane & 15, fq = lane >> 4;
  for (int t = first_item(p, 96); t < NB * NH * NT; t += p.gdim) {
    const int tile = t % NT, hh = (t / NT) % NH, b = t / (NT * NH);
    const int seg_lo = (tile < CT) ? 0 : CTX, seg_hi = (tile < CT) ? CTX : TS;
    __syncthreads();
    mls_gates(tid, p, b, tile, hh, cumf, cumb, lif, lib);
    {
      const int j = tid >> 1, half = tid & 1;
      const int s = tile * 128 + j;
      const float wf = expf(cumf[127] - cumf[j] + lif[j]), wb = expf(cumb[0] - cumb[j] + lib[j]);
#pragma unroll 1
      for (int c = 0; c < 4; ++c) {
        NO_HOIST();
        float k[8];
        conv_silu8(p, b, s, seg_lo, seg_hi, C_CK, 256, hh * 64 + half * 32 + c * 8, 0.125f, k);
#pragma unroll
        for (int i = 0; i < 8; ++i) { Ktf[(half * 32 + c * 8 + i) * LDV + j] = f2bf(k[i] * wf); Ktb[(half * 32 + c * 8 + i) * LDV + j] = f2bf(k[i] * wb); }
      }
      const bf16_t* prow = p.P() + ((size_t)b * TS + s) * PW + C_CV * 256 + hh * 64 + half * 32;
#pragma unroll
      for (int c = 0; c < 4; ++c) {
        u32x4 v = *(const u32x4*)(prow + c * 8);
#pragma unroll
        for (int q = 0; q < 4; ++q) {
          Vt[(half * 32 + c * 8 + 2 * q) * LDV + j] = (bf16_t)(v[q] & 0xFFFFu);
          Vt[(half * 32 + c * 8 + 2 * q + 1) * LDV + j] = (bf16_t)(v[q] >> 16);
        }
      }
#pragma unroll
      for (int e = 0; e < 8; ++e) Vt[(64 + half * 8 + e) * LDV + j] = (half == 0 && e == 0) ? (bf16_t)0x3F80 : (bf16_t)0;
    }
    __syncthreads();
    for (int mt = wid; mt < 5; mt += 4) {
      f32x4 acc[2][4];
#pragma unroll
      for (int d = 0; d < 2; ++d)
#pragma unroll
        for (int n = 0; n < 4; ++n) acc[d][n] = f32x4{0.f, 0.f, 0.f, 0.f};
#pragma unroll
      for (int ks = 0; ks < 4; ++ks) {
        bf16x8 af = *(const bf16x8*)(Vt + (mt * 16 + fr) * LDV + ks * 32 + fq * 8);
#pragma unroll
        for (int n = 0; n < 4; ++n) {
          bf16x8 b0 = *(const bf16x8*)(Ktf + (n * 16 + fr) * LDV + ks * 32 + fq * 8);
          bf16x8 b1 = *(const bf16x8*)(Ktb + (n * 16 + fr) * LDV + ks * 32 + fq * 8);
          acc[0][n] = MFMA16(af, b0, acc[0][n]);
          acc[1][n] = MFMA16(af, b1, acc[1][n]);
        }
      }
#pragma unroll
      for (int d = 0; d < 2; ++d) {
        float* dst = p.mlC() + ((((size_t)b * NH + hh) * 2 + d) * NT + tile) * (80 * 64);
#pragma unroll
        for (int n = 0; n < 4; ++n)
#pragma unroll
          for (int r = 0; r < 4; ++r) dst[(mt * 16 + fq * 4 + r) * 64 + n * 16 + fr] = acc[d][n][r];
      }
    }
    if (tid < 2) p.mlCe()[(((size_t)b * NH + hh) * 2 + tid) * NT + tile] = tid ? cumb[0] : cumf[127];
  }
}
__device__ __forceinline__ void phase_mls_b(const Params& p) {
  const int tid = tidx(p);
  const int NE = 80 * 64, NU = 65 * 64;
  for (int i = p.bid * 256 + tid; i < NB * NH * 2 * NE; i += p.gdim * 256) {
    int el = i % NE, chain = i / NE;
    int dir = chain & 1;
    size_t base = (size_t)chain * NT;
    if (el >= NU) {
#pragma unroll
      for (int k = 0; k < NT; ++k) p.mlSp()[(base + k) * NE + el] = 0;
      continue;
    }
    float kv[NT], ce[NT];
#pragma unroll
    for (int k = 0; k < NT; ++k) { int tile = proc_tile(dir, k); kv[k] = p.mlC()[(base + tile) * NE + el]; ce[k] = p.mlCe()[base + tile]; }
    float S = 0.f;
#pragma unroll
    for (int k = 0; k < NT; ++k) {
      p.mlSp()[(base + proc_tile(dir, k)) * NE + el] = f2bf(S);
      S = expf(ce[k]) * S + kv[k];
    }
  }
}
constexpr int MLSC_SMEM = (2 * 128 * LDT + 64 * LDV + 2 * 80 * LDT) * 2 + 4 * 128 * 4;
__device__ __forceinline__ void phase_mls_c(const Params& p, char* smem_) {
  const int tid = tidx(p);
  bf16_t* Qs = (bf16_t*)smem_; bf16_t* Ks = Qs + 128 * LDT; bf16_t* Vt = Ks + 128 * LDT;
  bf16_t* Cpf = Vt + 64 * LDV; bf16_t* Cpb = Cpf + 80 * LDT;
  float* cumf = (float*)(Cpb + 80 * LDT); float* cumb = cumf + 128; float* lif = cumb + 128; float* lib = lif + 128;
  const int lane = tid & 63, wid = tid >> 6, fr = lane & 15, fq = lane >> 4;
  for (int t = first_item(p, 96); t < NB * NH * NT; t += p.gdim) {
    const int tile = t % NT, hh = (t / NT) % NH, b = t / (NT * NH);
    const int seg_lo = (tile < CT) ? 0 : CTX, seg_hi = (tile < CT) ? CTX : TS;
    __syncthreads();
    mls_gates(tid, p, b, tile, hh, cumf, cumb, lif, lib);
    if (tid < 128) lif[tid] -= cumf[tid]; else lib[tid - 128] -= cumb[tid - 128];
    {
      const int j = tid >> 1, half = tid & 1;
      const int s = tile * 128 + j;
#pragma unroll 1
      for (int c = 0; c < 8; ++c) {
        NO_HOIST();
        const int isk = c >> 2, cc = c & 3;
        float k[8];
        conv_silu8(p, b, s, seg_lo, seg_hi, isk ? C_CK : C_CQ, isk ? 256 : 0, hh * 64 + half * 32 + cc * 8, isk ? 0.125f : 1.0f, k);
        u32x4 v; v[0] = pack2(k[0], k[1]); v[1] = pack2(k[2], k[3]); v[2] = pack2(k[4], k[5]); v[3] = pack2(k[6], k[7]);
        *(u32x4*)((isk ? Ks : Qs) + j * LDT + half * 32 + cc * 8) = v;
      }
      const bf16_t* prow = p.P() + ((size_t)b * TS + s) * PW + C_CV * 256 + hh * 64 + half * 32;
#pragma unroll
      for (int c = 0; c < 4; ++c) {
        u32x4 v = *(const u32x4*)(prow + c * 8);
#pragma unroll
        for (int q = 0; q < 4; ++q) {
          Vt[(half * 32 + c * 8 + 2 * q) * LDV + j] = (bf16_t)(v[q] & 0xFFFFu);
          Vt[(half * 32 + c * 8 + 2 * q + 1) * LDV + j] = (bf16_t)(v[q] >> 16);
        }
      }
      const bf16_t* spf = p.mlSp() + ((((size_t)b * NH + hh) * 2 + 0) * NT + tile) * (80 * 64);
      const bf16_t* spb = p.mlSp() + ((((size_t)b * NH + hh) * 2 + 1) * NT + tile) * (80 * 64);
      for (int c = tid; c < 80 * 8; c += 256) {
        int e = c >> 3, d0 = (c & 7) * 8;
        *(u32x4*)(Cpf + e * LDT + d0) = *(const u32x4*)(spf + e * 64 + d0);
        *(u32x4*)(Cpb + e * LDT + d0) = *(const u32x4*)(spb + e * 64 + d0);
      }
    }
    __syncthreads();
#pragma unroll 1
    for (int mi = 0; mi < 2; ++mi) {
      NO_HOIST();
      const int i = wid * 32 + mi * 16 + fr;
      f32x4 sc[8];
#pragma unroll
      for (int nj = 0; nj < 8; ++nj) sc[nj] = f32x4{0.f, 0.f, 0.f, 0.f};
#pragma unroll
      for (int ks = 0; ks < 2; ++ks) {
        bf16x8 qf = *(const bf16x8*)(Qs + i * LDT + ks * 32 + fq * 8);
#pragma unroll
        for (int nj = 0; nj < 8; ++nj) {
          bf16x8 kf = *(const bf16x8*)(Ks + (nj * 16 + fr) * LDT + ks * 32 + fq * 8);
          sc[nj] = MFMA16(kf, qf, sc[nj]);
        }
      }
      float hsum[4][4];
#pragma unroll
      for (int n = 0; n < 4; ++n)
#pragma unroll
        for (int r = 0; r < 4; ++r) hsum[n][r] = 0.f;
#pragma unroll 1
      for (int dir = 0; dir < 2; ++dir) {
        NO_HOIST();
        const float* cum = dir ? cumb : cumf; const float* li = dir ? lib : lif; const bf16_t* Cp = dir ? Cpb : Cpf;
        const float ci = cum[i];
        f32x4 sd[8]; float dsum = 0.f;
#pragma unroll
        for (int nj = 0; nj < 8; ++nj)
#pragma unroll
          for (int r = 0; r < 4; ++r) {
            int j = nj * 16 + fq * 4 + r;
            int dd = dir ? (j - i) : (i - j);
            float v = sc[nj][r] * fexp(ci + li[j] + u2f((unsigned)(dd >> 31) & 0xF149F2CAu));
            sd[nj][r] = v; dsum += v;
          }
        dsum += SHFL_XOR(dsum, 16); dsum += SHFL_XOR(dsum, 32);
        f32x4 an[4];
#pragma unroll
        for (int n = 0; n < 4; ++n) an[n] = f32x4{0.f, 0.f, 0.f, 0.f};
#pragma unroll
        for (int ks = 0; ks < 4; ++ks) {
          bf16x8 sf = pack_frag(sd[2 * ks], sd[2 * ks + 1]);
#pragma unroll
          for (int n = 0; n < 4; ++n) {
            bf16x8 vf = frag_perm8(Vt + (n * 16 + fr) * LDV + ks * 32, fq);
            an[n] = MFMA16(vf, sf, an[n]);
          }
        }
        f32x4 ai[5];
#pragma unroll
        for (int n = 0; n < 5; ++n) ai[n] = f32x4{0.f, 0.f, 0.f, 0.f};
#pragma unroll
        for (int ks = 0; ks < 2; ++ks) {
          bf16x8 qf = *(const bf16x8*)(Qs + i * LDT + ks * 32 + fq * 8);
#pragma unroll
          for (int n = 0; n < 5; ++n) {
            bf16x8 cf = *(const bf16x8*)(Cp + (n * 16 + fr) * LDT + ks * 32 + fq * 8);
            ai[n] = MFMA16(cf, qf, ai[n]);
          }
        }
        const float ec = fexp(ci);
        float dinter = ai[4][0];
        dinter = SHFL(dinter, fr);
        const float den = dsum + ec * dinter;
        const float inv = 1.0f / fmaxf(fabsf(den), 1.0f);
#pragma unroll
        for (int n = 0; n < 4; ++n)
#pragma unroll
          for (int r = 0; r < 4; ++r) {
            float hv = (an[n][r] + ec * ai[n][r]) * inv;
            hsum[n][r] += hv;
          }
      }
      float sum = 0.f;
#pragma unroll
      for (int n = 0; n < 4; ++n)
#pragma unroll
        for (int r = 0; r < 4; ++r) sum += hsum[n][r];
      sum += SHFL_XOR(sum, 16); sum += SHFL_XOR(sum, 32);
      const float mean = sum * (1.0f / 64.0f);
      float var = 0.f;
#pragma unroll
      for (int n = 0; n < 4; ++n)
#pragma unroll
        for (int r = 0; r < 4; ++r) { hsum[n][r] -= mean; var += hsum[n][r] * hsum[n][r]; }
      var += SHFL_XOR(var, 16); var += SHFL_XOR(var, 32);
      const float rs = rsqrtf(var * (1.0f / 64.0f) + EPS);
      const size_t row = (size_t)b * TS + tile * 128 + i;
#pragma unroll
      for (int n = 0; n < 4; ++n) {
        int e = n * 16 + fq * 4;
        u32x2 gv = *(const u32x2*)(p.P() + row * PW + C_CO * 256 + hh * 64 + e);
        float g0 = u2f(gv[0] << 16), g1 = u2f(gv[0] & 0xFFFF0000u), g2 = u2f(gv[1] << 16), g3 = u2f(gv[1] & 0xFFFF0000u);
        u32x2 ov; ov[0] = pack2(hsum[n][0] * rs * fsigmoid(g0), hsum[n][1] * rs * fsigmoid(g1));
        ov[1] = pack2(hsum[n][2] * rs * fsigmoid(g2), hsum[n][3] * rs * fsigmoid(g3));
        STORE_WT8(p.y() + row * (4 * MW) + 2 * MW + hh * 64 + e, ov);
      }
    }
  }
}

constexpr int GL_OLD = 68;
constexpr int GL_TLD = 24;
constexpr int GL_DIRB = 16 * GL_OLD * 4 + 2 * 64 * GL_TLD * 2 + 2 * 16 * LDT * 2 + 64 * GL_TLD * 2 + 3 * 64 * 4;
constexpr int GLA_SMEM = 128 * GL_OLD * 4 + 2 * GL_DIRB;
template <bool FINAL>
__device__ __forceinline__ void phase_gla(const Params& p, char* smem_) {
  const int tid = tidx(p);
  float* oacc = (float*)smem_;
  char* dbase = smem_ + 128 * GL_OLD * 4;
  const int lane = tid & 63, wid = tid >> 6, fr = lane & 15, fq = lane >> 4;
  const int l = p.layer;
  const int pi = tid >> 4, pc4 = (tid & 15) * 4;
  for (int t = first_item(p, 128); t < NB * NH * NT; t += p.gdim) {
    const int tile = t % NT, hh = (t / NT) % NH, b = t / (NT * NH);
    float lb4[4];
#pragma unroll
    for (int j = 0; j < 4; ++j) {
      int c = hh * 64 + pc4 + j;
      float mx = -3.0e38f;
      for (int q = 0; q < DEPTH; ++q) mx = fmaxf(mx, p.d_lb[q * MW + c]);
      float den = 0.f, num = 0.f;
      for (int q = 0; q < DEPTH; ++q) { float e = expf(p.d_lb[q * MW + c] - mx); den += e; if (q >= 1 && q <= l) num += e; }
      lb4[j] = num / den;
    }
    __syncthreads();
    f32x4 S[2][4];
    u32x2 rq[2], rf[2], rv[2];
#pragma unroll
    for (int dir = 0; dir < 2; ++dir) {
      const size_t chain = (((size_t)b * NH + hh) * 2 + dir) * NT + tile;
#pragma unroll
      for (int mt = 0; mt < 4; ++mt)
#pragma unroll
        for (int r = 0; r < 4; ++r) S[dir][mt][r] = FINAL ? p.glSp()[chain * 4096 + (mt * 16 + fq * 4 + r) * 64 + wid * 16 + fr] : 0.f;
      float* Et = (float*)(dbase + dir * GL_DIRB + GL_DIRB - 64 * 4);
      if (tid < 64) Et[tid] = 1.0f;
    }
    auto gload = [&](int dir, int k) {
      int sc_ = dir ? 7 - k : k; int i = dir ? 15 - pi : pi;
      const bf16_t* prow = p.P() + ((size_t)b * TS + tile * 128 + sc_ * 16 + i) * PW + hh * 64 + pc4;
      rq[dir] = *(const u32x2*)(prow + C_DQ * 256); rf[dir] = *(const u32x2*)(prow + (dir ? C_DFB : C_DFF) * 256); rv[dir] = *(const u32x2*)(prow + C_DI * 256);
    };
    gload(0, 0); gload(1, 0);
#pragma unroll 1
    for (int k = 0; k < 8; ++k) {
      float kk4[2][4], qq4[2][4];
#pragma unroll
      for (int dir = 0; dir < 2; ++dir) {
        float* lgf = (float*)(dbase + dir * GL_DIRB);
        bf16_t* vT = (bf16_t*)(lgf + 16 * GL_OLD) + (k & 1) * 64 * GL_TLD;
        float zq[4] = {u2f(rq[dir][0] << 16), u2f(rq[dir][0] & 0xFFFF0000u), u2f(rq[dir][1] << 16), u2f(rq[dir][1] & 0xFFFF0000u)};
        float zf[4] = {u2f(rf[dir][0] << 16), u2f(rf[dir][0] & 0xFFFF0000u), u2f(rf[dir][1] << 16), u2f(rf[dir][1] & 0xFFFF0000u)};
        f32x4 lg;
#pragma unroll
        for (int j = 0; j < 4; ++j) {
          float f = lb4[j] + (1.0f - lb4[j]) * fsigmoid(zf[j]);
          lg[j] = flog(f); kk4[dir][j] = 1.0f - f; qq4[dir][j] = fsilu(zq[j]);
        }
        *(f32x4*)(lgf + pi * GL_OLD + pc4) = lg;
        vT[(pc4 + 0) * GL_TLD + pi] = (bf16_t)(rv[dir][0] & 0xFFFFu); vT[(pc4 + 1) * GL_TLD + pi] = (bf16_t)(rv[dir][0] >> 16);
        vT[(pc4 + 2) * GL_TLD + pi] = (bf16_t)(rv[dir][1] & 0xFFFFu); vT[(pc4 + 3) * GL_TLD + pi] = (bf16_t)(rv[dir][1] >> 16);
      }
      if (k + 1 < 8) { gload(0, k + 1); gload(1, k + 1); }
      __syncthreads();
#pragma unroll
      for (int dir = 0; dir < 2; ++dir) {
        float* lgf = (float*)(dbase + dir * GL_DIRB);
        bf16_t* qe = (bf16_t*)(lgf + 16 * GL_OLD) + 2 * 64 * GL_TLD; bf16_t* ki = qe + 16 * LDT; bf16_t* kdT = ki + 16 * LDT;
        float* Ec = (float*)(kdT + 64 * GL_TLD); float* Em = Ec + 64; float* Et = Em + 64;
        f32x4 cs = {0.f, 0.f, 0.f, 0.f}, ce = cs, cm = cs;
#pragma unroll
        for (int q = 0; q < 16; ++q) {
          f32x4 v = *(const f32x4*)(lgf + q * GL_OLD + pc4);
          ce += v; if (q <= pi) cs += v; if (q < 8) cm += v;
        }
        float a[4], bb[4];
#pragma unroll
        for (int j = 0; j < 4; ++j) {
          a[j] = qq4[dir][j] * fexp(cs[j] - cm[j]); bb[j] = kk4[dir][j] * fexp(cm[j] - cs[j]);
          kdT[(pc4 + j) * GL_TLD + pi] = f2bf(kk4[dir][j] * fexp(ce[j] - cs[j]));
        }
        u32x2 av; av[0] = pack2(a[0], a[1]); av[1] = pack2(a[2], a[3]);
        u32x2 bv; bv[0] = pack2(bb[0], bb[1]); bv[1] = pack2(bb[2], bb[3]);
        *(u32x2*)(qe + pi * LDT + pc4) = av; *(u32x2*)(ki + pi * LDT + pc4) = bv;
        if (pi == 0) {
#pragma unroll
          for (int j = 0; j < 4; ++j) { float e = fexp(ce[j]); Ec[pc4 + j] = e; Em[pc4 + j] = fexp(cm[j]); Et[pc4 + j] *= e; }
        }
      }
      __syncthreads();
      const u32x4 zero4 = {0u, 0u, 0u, 0u};
#pragma unroll
      for (int dir = 0; dir < 2; ++dir) {
        const int sc_ = dir ? 7 - k : k;
        float* lgf = (float*)(dbase + dir * GL_DIRB);
        bf16_t* vT = (bf16_t*)(lgf + 16 * GL_OLD) + (k & 1) * 64 * GL_TLD;
        bf16_t* qe = (bf16_t*)(lgf + 16 * GL_OLD) + 2 * 64 * GL_TLD; bf16_t* ki = qe + 16 * LDT; bf16_t* kdT = ki + 16 * LDT;
        float* Ec = (float*)(kdT + 64 * GL_TLD); float* Em = Ec + 64;
        if (FINAL) {
          f32x4 sct = {0.f, 0.f, 0.f, 0.f}, oT = {0.f, 0.f, 0.f, 0.f};
#pragma unroll
          for (int ks = 0; ks < 2; ++ks) {
            bf16x8 kf = *(const bf16x8*)(ki + fr * LDT + ks * 32 + fq * 8);
            bf16x8 qf = *(const bf16x8*)(qe + fr * LDT + ks * 32 + fq * 8);
            sct = MFMA16(kf, qf, sct);
            f32x4 e0 = *(const f32x4*)(Em + (2 * ks) * 16 + fq * 4), e1 = *(const f32x4*)(Em + (2 * ks + 1) * 16 + fq * 4);
            f32x4 s0 = S[dir][2 * ks] * e0, s1 = S[dir][2 * ks + 1] * e1;
            bf16x8 sf = pack_frag(s0, s1);
            bf16x8 qp = frag_perm8(qe + fr * LDT + ks * 32, fq);
            oT = MFMA16(sf, qp, oT);
          }
#pragma unroll
          for (int r = 0; r < 4; ++r) if (fq * 4 + r > fr) sct[r] = 0.f;
          {
            u32x4 bs = zero4; bs[0] = pack2(sct[0], sct[1]); bs[1] = pack2(sct[2], sct[3]);
            u32x2 va = *(const u32x2*)(vT + (wid * 16 + fr) * GL_TLD + fq * 4);
            u32x4 as = zero4; as[0] = va[0]; as[1] = va[1];
            oT = MFMA16(__builtin_bit_cast(bf16x8, as), __builtin_bit_cast(bf16x8, bs), oT);
          }
          const int tok = sc_ * 16 + (dir ? 15 - fr : fr);
          float* od = oacc + tok * GL_OLD + wid * 16 + fq * 4;
          const bool first = dir ? (sc_ >= 4) : (sc_ < 4);
          if (first) *(f32x4*)od = oT; else { f32x4 prev = *(const f32x4*)od; *(f32x4*)od = prev + oT; }
        }
        {
          u32x4 bsrc = (fq < 2) ? *(const u32x4*)(vT + (wid * 16 + fr) * GL_TLD + fq * 8) : zero4;
          bf16x8 bf_ = __builtin_bit_cast(bf16x8, bsrc);
#pragma unroll
          for (int mt = 0; mt < 4; ++mt) {
            f32x4 e4 = *(const f32x4*)(Ec + mt * 16 + fq * 4);
            u32x4 asrc = (fq < 2) ? *(const u32x4*)(kdT + (mt * 16 + fr) * GL_TLD + fq * 8) : zero4;
            S[dir][mt] = MFMA16(__builtin_bit_cast(bf16x8, asrc), bf_, S[dir][mt] * e4);
          }
        }
      }
    }
    __syncthreads();
    if (!FINAL) {
#pragma unroll
      for (int dir = 0; dir < 2; ++dir) {
        const size_t chain = (((size_t)b * NH + hh) * 2 + dir) * NT + tile;
        const float* Et = (const float*)(dbase + dir * GL_DIRB + GL_DIRB - 64 * 4);
#pragma unroll
        for (int mt = 0; mt < 4; ++mt)
#pragma unroll
          for (int r = 0; r < 4; ++r) p.glKV()[chain * 4096 + (mt * 16 + fq * 4 + r) * 64 + wid * 16 + fr] = S[dir][mt][r];
        if (tid < 64) p.glE()[chain * 64 + tid] = Et[tid];
      }
    }
    if (FINAL) {
      const int row = tid >> 1, half = tid & 1;
      float ss = 0.f;
#pragma unroll
      for (int e = 0; e < 32; e += 4) { f32x4 v = *(const f32x4*)(oacc + row * GL_OLD + half * 32 + e); ss += v[0] * v[0] + v[1] * v[1] + v[2] * v[2] + v[3] * v[3]; }
      ss += SHFL_XOR(ss, 1);
      const float rs = rsqrtf(ss * (1.0f / 64.0f) + EPS);
      const size_t grow = (size_t)b * TS + tile * 128 + row;
#pragma unroll
      for (int c = 0; c < 4; ++c) {
        float g[8]; unpack8(*(const u32x4*)(p.P() + grow * PW + C_DG * 256 + hh * 64 + half * 32 + c * 8), g);
        f32x4 o0 = *(const f32x4*)(oacc + row * GL_OLD + half * 32 + c * 8), o1 = *(const f32x4*)(oacc + row * GL_OLD + half * 32 + c * 8 + 4);
        u32x4 ov;
        ov[0] = pack2(o0[0] * rs * fsilu(g[0]), o0[1] * rs * fsilu(g[1])); ov[1] = pack2(o0[2] * rs * fsilu(g[2]), o0[3] * rs * fsilu(g[3]));
        ov[2] = pack2(o1[0] * rs * fsilu(g[4]), o1[1] * rs * fsilu(g[5])); ov[3] = pack2(o1[2] * rs * fsilu(g[6]), o1[3] * rs * fsilu(g[7]));
        STORE_WT16(p.y() + grow * (4 * MW) + 3 * MW + hh * 64 + half * 32 + c * 8, ov);
      }
    }
  }
}
__device__ __forceinline__ void phase_gla_b(const Params& p) {
  const int tid = tidx(p);
  for (int i = p.bid * 256 + tid; i < NB * NH * 2 * 4096; i += p.gdim * 256) {
    int el = i & 4095, chain = i >> 12; int dir = chain & 1; int c = el >> 6;
    size_t base = (size_t)chain * NT;
    float kv[NT], ee[NT];
#pragma unroll
    for (int k = 0; k < NT; ++k) { int tile = proc_tile(dir, k); kv[k] = p.glKV()[(base + tile) * 4096 + el]; ee[k] = p.glE()[(base + tile) * 64 + c]; }
    float S = 0.f;
#pragma unroll
    for (int k = 0; k < NT; ++k) {
      p.glSp()[(base + proc_tile(dir, k)) * 4096 + el] = S;
      S = ee[k] * S + kv[k];
    }
  }
}


constexpr int MRG_SMEM = GEMM_SMEM;
__device__ __forceinline__ void phase_merge(const Params& p, char* smem_) {
  const int tid = tidx(p);
  bf16_t* smem = (bf16_t*)smem_;
  char* sb = (char*)smem_;
  const int lane = tid & 63, wid = tid >> 6, wr = wid >> 1, wc = wid & 1, fr = lane & 15, fq = lane >> 4;
  const bool last = (p.layer == DEPTH - 1);
  constexpr int SG = D / 32, SY = MW / 32, SB = SG + SY, NSTEP = 4 * SB;
  const int ntn = D / 128;
  const int nrow = last ? NB * (NT - CT) : MT;
  const XcdSched sch(p, nrow, ntn);
  const int fro = ((fq ^ dma_g(fr)) << 4);
  for (int it = 0;; ++it) {
    int tm, tn;
    if (!sch.get(it, tm, tn)) break;
    if (tm >= nrow) continue;
    if (last) tm = (tm / (NT - CT)) * NT + CT + tm % (NT - CT);
    const size_t row0 = (size_t)tm * 128; const int col0 = tn * 128;
    auto issue = [&](int s, int stage) {
      const int n = s / SB, r = s - n * SB;
      const bool isG = r < SG;
      const int kk = (isG ? r : r - SG) * 32;
      const bf16_t* pa = isG ? (p.h() + row0 * D + kk) : (p.y() + row0 * (4 * MW) + n * MW + kk);
      const bf16_t* pb = isG ? (p.WmT() + ((size_t)n * D + col0) * D + kk) : (p.WbT() + ((size_t)n * D + col0) * MW + kk);
      int t2 = tid; NO_CSE(t2);
      const int rw0 = dma_row(t2, 0), ch0 = dma_chunk(t2, rw0);
      const unsigned oa0 = isG ? (unsigned)(rw0 * D + ch0) : (unsigned)(rw0 * (4 * MW) + ch0);
      const unsigned oa1 = oa0 + (isG ? 16u * D : 16u * 4 * MW);
      const unsigned ob0 = isG ? (unsigned)(rw0 * D + ch0) : (unsigned)(rw0 * MW + ch0);
      const unsigned ob1 = ob0 + (isG ? 16u * D : 16u * MW);
      char* st = sb + stage * 16384 + (2 * (t2 >> 6)) * 1024 + (t2 & 63) * 16;
      GLDS16(pa + oa0, st); GLDS16(pa + oa1, st + 1024);
      GLDS16(pb + ob0, st + 8192); GLDS16(pb + ob1, st + 8192 + 1024);
    };
    f32x4 acc[4][4]; u32x2 sg[4][4], zp[4][4];
    ACC_ZERO(acc);
#pragma unroll
    for (int m = 0; m < 4; ++m)
#pragma unroll
      for (int n = 0; n < 4; ++n) { zp[m][n][0] = 0u; zp[m][n][1] = 0u; }
    __syncthreads();
    issue(0, 0);
    issue(1, 1);
    static_assert(SG % 2 == 0 && SY % 2 == 0, "k-slice pairs");
    auto step2 = [&](int s0) {
      WAIT_VM(0);
      RAW_BARRIER();
      if (s0 + 2 < NSTEP) { issue(s0 + 2, (s0 + 2) & 3); issue(s0 + 3, (s0 + 3) & 3); }
#pragma unroll
      for (int hs = 0; hs < 2; ++hs) {
        const int s = s0 + hs;
        const char* sa = sb + (s & 3) * 16384; const char* sbb = sa + 8192;
        bf16x8 af[4], bfr[4];
#pragma unroll
        for (int m = 0; m < 4; ++m) af[m] = *(const bf16x8*)(sa + (wr * 64 + m * 16 + fr) * 64 + fro);
#pragma unroll
        for (int n = 0; n < 4; ++n) bfr[n] = *(const bf16x8*)(sbb + (wc * 64 + n * 16 + fr) * 64 + fro);
        SET_PRIO(1);
#pragma unroll
        for (int m = 0; m < 4; ++m)
#pragma unroll
          for (int n = 0; n < 4; ++n) acc[m][n] = MFMA16(bfr[n], af[m], acc[m][n]);
        SET_PRIO(0);
      }
    };
#pragma unroll 1
    for (int br = 0; br < 4; ++br) {
#pragma unroll 1
      for (int r = 0; r < SG; r += 2) step2(br * SB + r);
#pragma unroll
      for (int m = 0; m < 4; ++m) {
#pragma unroll
        for (int n = 0; n < 4; ++n) {
          sg[m][n][0] = pack2(fsigmoid(acc[m][n][0]), fsigmoid(acc[m][n][1])); sg[m][n][1] = pack2(fsigmoid(acc[m][n][2]), fsigmoid(acc[m][n][3]));
          acc[m][n] = f32x4{0.f, 0.f, 0.f, 0.f};
        }
        SCHED_FENCE();
      }
#pragma unroll 1
      for (int r = SG; r < SB; r += 2) step2(br * SB + r);
#pragma unroll
      for (int m = 0; m < 4; ++m) {
#pragma unroll
        for (int n = 0; n < 4; ++n) {
          float z0 = u2f(zp[m][n][0] << 16) + u2f(sg[m][n][0] << 16) * acc[m][n][0], z1 = u2f(zp[m][n][0] & 0xFFFF0000u) + u2f(sg[m][n][0] & 0xFFFF0000u) * acc[m][n][1];
          float z2 = u2f(zp[m][n][1] << 16) + u2f(sg[m][n][1] << 16) * acc[m][n][2], z3 = u2f(zp[m][n][1] & 0xFFFF0000u) + u2f(sg[m][n][1] & 0xFFFF0000u) * acc[m][n][3];
          zp[m][n][0] = pack2(z0, z1); zp[m][n][1] = pack2(z2, z3);
          acc[m][n] = f32x4{0.f, 0.f, 0.f, 0.f};
        }
        SCHED_FENCE();
      }
    }
    __syncthreads();
#pragma unroll
    for (int m = 0; m < 4; ++m)
#pragma unroll
      for (int n = 0; n < 4; ++n) *(u32x2*)(smem + (wr * 64 + m * 16 + fr) * EPI_LD + wc * 64 + n * 16 + fq * 4) = zp[m][n];
    __syncthreads();
#pragma unroll
    for (int i = 0; i < 8; ++i) {
      int c = tid + i * 256; int row = c >> 4, ch = (c & 15) * 8;
      { const u32x4 v_ = *(const u32x4*)(smem + row * EPI_LD + ch); STORE_WT16(p.z() + (row0 + row) * D + col0 + ch, v_); }
    }
  }
}
__device__ __forceinline__ void phase_outproj(const Params& p, char* smem_) {
  const int tid = tidx(p);
  bf16_t* smem = (bf16_t*)smem_;
  const int lane = tid & 63, wid = tid >> 6, wr = wid >> 1, wc = wid & 1, fr = lane & 15, fq = lane >> 4;
  const bool last = (p.layer == DEPTH - 1);
  const int ntn = D / 128;
  const int nrow = last ? NB * (NT - CT) : MT;
  const XcdSched sch(p, nrow, ntn);
  for (int it = 0;; ++it) {
    int tm, tn;
    if (!sch.get(it, tm, tn)) break;
    if (tm >= nrow) continue;
    if (last) tm = (tm / (NT - CT)) * NT + CT + tm % (NT - CT);
    const bf16_t* A = p.z() + (size_t)tm * 128 * D;
    const bf16_t* B = p.WoT() + (size_t)tn * 128 * D;
    f32x4 acc[4][4]; ACC_ZERO(acc);
    GemmOffs2 go;
#pragma unroll
    for (int i = 0; i < 2; ++i) { int row = dma_row(tid, i); go.a[i] = (unsigned)(row * D + dma_chunk(tid, row)); go.b[i] = go.a[i]; }
    gemm_kloop_dma(tid, acc, [&](int k0) { return A + k0; }, [&](int k0) { return B + k0; }, go, D, smem);
    epi_rmw_f32(tid, (float*)smem_, acc, tn * 128, [&](int r) { return xrow(p, tm * 128 + r); }, [&](int r) { return modrow(p, tm * 128 + r, 2); },
                [&](int r) { return xrow_src(p, tm * 128 + r, p.layer == 0); });
  }
}
__device__ __forceinline__ void cls_experts(int cls, int& e_lo, int& e_hi) {
  int gi = cls / 6, pr = cls % 6;
  int lo = (pr < 3) ? 0 : (pr < 5) ? 1 : 2;
  int hi = (pr < 3) ? pr + 1 : (pr < 5) ? pr - 1 : 3;
  e_lo = gi * 4 + lo; e_hi = gi * 4 + hi;
}
__device__ __forceinline__ bool moe_find(const int* cnt, int mt, int& cls, int& mloc, int& total) {
  int acc = 0; bool found = false;
  for (int c = 0; c < NCLS; ++c) {
    int n = (cnt[c] + 127) >> 7;
    if (!found && mt < acc + n) { cls = c; mloc = mt - acc; found = true; }
    acc += n;
  }
  total = acc; return found;
}
__device__ __forceinline__ void phase_moe_up(const Params& p, char* smem_) {
  const int tid = tidx(p);
  bf16_t* smem = (bf16_t*)smem_;
  int* stok = (int*)(smem_ + GEMM_SMEM);
  const int lane = tid & 63, wid = tid >> 6, wr = wid >> 1, wc = wid & 1, fr = lane & 15, fq = lane >> 4;
  int* cnt = stok + 128;
  __syncthreads();
  if (tid < NCLS) cnt[tid] = p.moe_cnt()[(p.layer * 2) * NCLS + tid];
  __syncthreads();
  constexpr int NCB = 2 * DE / 64;
  int total_mt = 0;
  { int c_, m_; moe_find(cnt, 0, c_, m_, total_mt); }
  const XcdSched sch(p, total_mt, NCB);
  for (int it = 0;; ++it) {
    int mt, cb;
    if (!sch.get(it, mt, cb)) break;
    if (mt >= total_mt) continue;
    int cls = 0, mloc = 0, tot_;
    moe_find(cnt, mt, cls, mloc, tot_);
    int e_lo, e_hi; cls_experts(cls, e_lo, e_hi);
    const int slot = (cb * 64) / DE, cbase = (cb * 64) % DE;
    const int ex = slot ? e_hi : e_lo;
    const int nvalid = imin(128, cnt[cls] - mloc * 128);
    __syncthreads();
    if (tid < 128) stok[tid] = p.moe_list()[(size_t)cls * T + mloc * 128 + imin((int)tid, nvalid - 1)];
    __syncthreads();
    const bf16_t* W1 = p.W1T() + (size_t)ex * DE * D; const bf16_t* W3 = p.W3T() + (size_t)ex * DE * D;
    f32x4 acc[4][4]; ACC_ZERO(acc);
    GemmOffs2 go;
    const unsigned w3off = (unsigned)(W3 - W1);
#pragma unroll
    for (int i = 0; i < 2; ++i) {
      int row = dma_row(tid, i), kc = dma_chunk(tid, row);
      go.a[i] = (unsigned)(stok[row] * D + kc);
      int wcc = row >> 6, within = row & 63; int col = cbase + wcc * 32 + (within & 31);
      go.b[i] = (unsigned)(col * D + kc) + ((within >= 32) ? w3off : 0u);
    }
    const bf16_t* hbase = p.h();
    gemm_kloop_dma(tid, acc, [&](int k0) { return hbase + k0; }, [&](int k0) { return W1 + k0; }, go, D, smem);
#pragma unroll
    for (int m = 0; m < 4; ++m) {
      int rl = wr * 64 + m * 16 + fr;
      float tw = p.moe_tw()[(size_t)stok[rl] * 2 + slot];
#pragma unroll
      for (int n = 0; n < 2; ++n) {
        float v[4];
#pragma unroll
        for (int q = 0; q < 4; ++q) v[q] = fsilu(acc[m][n][q]) * acc[m][n + 2][q] * tw;
        u32x2 o; o[0] = pack2(v[0], v[1]); o[1] = pack2(v[2], v[3]);
        *(u32x2*)(smem + rl * LDT + wc * 32 + n * 16 + fq * 4) = o;
      }
    }
    __syncthreads();
#pragma unroll
    for (int i = 0; i < 4; ++i) {
      int c = tid + i * 256; int row = c >> 3, ch = (c & 7) * 8;
      if (row < nvalid) { const u32x4 v_ = *(const u32x4*)(smem + row * LDT + ch); STORE_WT16(p.mid() + (size_t)stok[row] * (2 * DE) + slot * DE + cbase + ch, v_); }
    }
  }
}
__device__ __forceinline__ void phase_moe_down(const Params& p, char* smem_) {
  const int tid = tidx(p);
  bf16_t* smem = (bf16_t*)smem_;
  int* stok = (int*)(smem_ + GEMM_SMEM);
  const int lane = tid & 63, wid = tid >> 6, wr = wid >> 1, wc = wid & 1, fr = lane & 15, fq = lane >> 4;
  int* cnt = stok + 128;
  __syncthreads();
  if (tid < NCLS) cnt[tid] = p.moe_cnt()[(p.layer * 2) * NCLS + tid];
  __syncthreads();
  constexpr int NCB = D / 128;
  int total_mt = 0;
  { int c_, m_; moe_find(cnt, 0, c_, m_, total_mt); }
  const XcdSched sch(p, total_mt, NCB);
  for (int it = 0;; ++it) {
    int mt, cb;
    if (!sch.get(it, mt, cb)) break;
    if (mt >= total_mt) continue;
    int cls = 0, mloc = 0, tot_;
    moe_find(cnt, mt, cls, mloc, tot_);
    int e_lo, e_hi; cls_experts(cls, e_lo, e_hi);
    const int nvalid = imin(128, cnt[cls] - mloc * 128);
    __syncthreads();
    if (tid < 128) stok[tid] = p.moe_list()[(size_t)cls * T + mloc * 128 + imin((int)tid, nvalid - 1)];
    __syncthreads();
    f32x4 acc[4][4]; ACC_ZERO(acc);
    GemmOffs2 go;
#pragma unroll
    for (int i = 0; i < 2; ++i) {
      int row = dma_row(tid, i), kc = dma_chunk(tid, row);
      go.a[i] = (unsigned)(stok[row] * (2 * DE) + kc);
      go.b[i] = (unsigned)(row * DE + kc);
    }
    const bf16_t* mbase = p.mid();
    const bf16_t* w2lo = p.W2T() + ((size_t)e_lo * D + cb * 128) * DE;
    const bf16_t* w2hi = p.W2T() + ((size_t)e_hi * D + cb * 128) * DE - DE;
    gemm_kloop_dma(tid, acc, [&](int k0) { return mbase + k0; }, [&](int k0) { return ((k0 < DE) ? w2lo : w2hi) + k0; }, go, 2 * DE, smem);
    epi_rmw_f32(tid, (float*)smem_, acc, cb * 128, [&](int r) { return (r < nvalid) ? xrow(p, stok[r]) : (float*)nullptr; }, [&](int r) { return modrow(p, stok[r], 5); },
                [&](int r) { return (const float*)xrow(p, stok[r]); });
  }
}
__device__ __forceinline__ void phase_final(const Params& p) {
  const int tid = tidx(p);
  const int lane = tid & 63, wid = tid >> 6, nw = 256 >> 6;
  for (int r = (p.bid * nw + wid) * 2; r < NB * SEQ; r += p.gdim * nw * 2) {
    float* xr = p.out + (size_t)r * D;
    f32x4 v[2][D / 256]; float ss[2] = {0.f, 0.f};
#pragma unroll
    for (int q = 0; q < 2; ++q)
#pragma unroll
      for (int i = 0; i < D / 256; ++i) v[q][i] = *(const f32x4*)(xr + q * D + i * 256 + lane * 4);
#pragma unroll
    for (int q = 0; q < 2; ++q) {
#pragma unroll
      for (int i = 0; i < D / 256; ++i) ss[q] += v[q][i][0] * v[q][i][0] + v[q][i][1] * v[q][i][1] + v[q][i][2] * v[q][i][2] + v[q][i][3] * v[q][i][3];
      ss[q] = wave_sum(ss[q], lane);
    }
#pragma unroll
    for (int q = 0; q < 2; ++q) {
      float rs = rsqrtf(ss[q] * (1.0f / D) + EPS);
#pragma unroll
      for (int i = 0; i < D / 256; ++i) {
        f32x4 w4 = *(const f32x4*)(p.final_norm_w + i * 256 + lane * 4);
#pragma unroll
        for (int c = 0; c < 4; ++c) v[q][i][c] = v[q][i][c] * rs * w4[c];
        *(f32x4*)(xr + q * D + i * 256 + lane * 4) = v[q][i];
      }
    }
  }
}

#ifndef EMU
#define KWAVE(p) p.wave = __builtin_amdgcn_readfirstlane((int)(threadIdx.x >> 6)); p.bid = blockIdx.x; p.gdim = gridDim.x
#else
#define KWAVE(p) p.bid = blockIdx.x; p.gdim = gridDim.x
#endif
__global__ void __launch_bounds__(256) k_init(Params p) { KWAVE(p); phase_init(p); }
__global__ void __launch_bounds__(256) k_modv(Params p) { KWAVE(p); DYN_SMEM(smem); phase_modv(p, smem); }
__global__ void __launch_bounds__(256) k_convw(Params p, int part) { KWAVE(p); DYN_SMEM(smem); phase_convw(p, part, smem); }
__global__ void __launch_bounds__(256) k_norm(Params p, int which) { KWAVE(p); DYN_SMEM(smem); phase_norm(p, which, smem); }
__global__ void __launch_bounds__(256) k_inproj(Params p) { KWAVE(p); DYN_SMEM(smem); phase_inproj(p, smem); }
__global__ void __launch_bounds__(256) k_ret_a(Params p) { KWAVE(p); DYN_SMEM(smem); phase_ret_a(p, smem); }
__global__ void __launch_bounds__(256) k_ret_b(Params p) { KWAVE(p); phase_ret_b(p); }
__global__ void __launch_bounds__(256) k_ret_c(Params p) { KWAVE(p); DYN_SMEM(smem); phase_ret_c(p, smem); }
__global__ void __launch_bounds__(256) k_mls_a(Params p) { KWAVE(p); DYN_SMEM(smem); phase_mls_a(p, smem); }
__global__ void __launch_bounds__(256) k_mls_b(Params p) { KWAVE(p); phase_mls_b(p); }
__global__ void __launch_bounds__(256) k_mls_c(Params p) { KWAVE(p); DYN_SMEM(smem); phase_mls_c(p, smem); }
__global__ void __launch_bounds__(256) k_gla_a(Params p) { KWAVE(p); DYN_SMEM(smem); phase_gla<false>(p, smem); }
__global__ void __launch_bounds__(256) k_gla_b(Params p) { KWAVE(p); phase_gla_b(p); }
__global__ void __launch_bounds__(256) k_gla_c(Params p) { KWAVE(p); DYN_SMEM(smem); phase_gla<true>(p, smem); }
__global__ void __launch_bounds__(256) k_merge(Params p) { KWAVE(p); DYN_SMEM(smem); phase_merge(p, smem); }
__global__ void __launch_bounds__(256) k_outproj(Params p) { KWAVE(p); DYN_SMEM(smem); phase_outproj(p, smem); }
__global__ void __launch_bounds__(256) k_moe_up(Params p) { KWAVE(p); DYN_SMEM(smem); phase_moe_up(p, smem); }
__global__ void __launch_bounds__(256) k_moe_down(Params p) { KWAVE(p); DYN_SMEM(smem); phase_moe_down(p, smem); }
__global__ void __launch_bounds__(256) k_final(Params p) { KWAVE(p); phase_final(p); }
__global__ void __launch_bounds__(256) k_lru_a(Params p) { KWAVE(p); DYN_SMEM(smem); phase_lru<false>(p, smem); }
__global__ void __launch_bounds__(256) k_lru_b(Params p) { KWAVE(p); phase_lru_carry(p); }
__global__ void __launch_bounds__(256) k_lru_c(Params p) { KWAVE(p); DYN_SMEM(smem); phase_lru<true>(p, smem); }


constexpr int cmax(int a, int b) { return a > b ? a : b; }
#define XBAR_LDS_OFF MEGA_SMEM_BASE
constexpr int MEGA_SMEM_BASE = cmax(cmax(cmax(GEMM_SMEM + 512, MLSC_SMEM), cmax(RETC_SMEM, GLA_SMEM)), cmax(cmax(LRU_SMEM, MRG_SMEM), cmax((NB + 1) * D * 4 + 4 * (NB + 1) * 64 * 4, 64 * 65 * 4)));
constexpr int MEGA_SMEM = MEGA_SMEM_BASE + 16;

#ifndef EMU
#define XB_TMO      128
#define XB_XCNT(j)  (256  + 64 * (j))
#define XB_XSUB(j)  (1280 + 64 * (j))
#define XB_XGEN(j)  (2304 + 64 * (j))
#define XB_TOP      3328
#define XB_TOPGEN   3392
#define XB_SPIN_CAP (1u << 20)
__device__ __forceinline__ unsigned xb_ld(unsigned* p)              { return __hip_atomic_load(p, __ATOMIC_RELAXED, __HIP_MEMORY_SCOPE_AGENT); }
__device__ __forceinline__ unsigned xb_add(unsigned* p, unsigned v) { return __hip_atomic_fetch_add(p, v, __ATOMIC_RELAXED, __HIP_MEMORY_SCOPE_AGENT); }
__device__ __forceinline__ unsigned xb_xcc_id() { return (unsigned)__builtin_amdgcn_s_getreg((3 << 11) | 20) & 0xFu; }
#define XB_SPIN(cond, bar) do { unsigned _sp = 0; while (cond) { __builtin_amdgcn_s_sleep(1); \
    if ((++_sp & 255u) == 0u) { if (xb_ld(&(bar)[XB_TMO])) break; if (_sp > XB_SPIN_CAP) { atomicAdd(&(bar)[XB_TMO], 1u); break; } } } } while (0)
__device__ __forceinline__ void xbar_post(const Params& p, char* smem_) {
  const int tid = tidx(p);
  volatile unsigned* st = (volatile unsigned*)(smem_ + XBAR_LDS_OFF);
  if (tid == 0) { st[0] = 0u; st[1] = 0u; (void)xb_add((unsigned*)(p.ws + O_BAR) + XB_XCNT(xb_xcc_id()), 1u); }
  __syncthreads();
}
__device__ __forceinline__ void xbar_sync(const Params& p, char* smem_) {
  const int tid = tidx(p);
  asm volatile("s_waitcnt vmcnt(0)" ::: "memory");
  __syncthreads();
  if (tid == 0) {
    unsigned* bar = (unsigned*)(p.ws + O_BAR);
    volatile unsigned* st = (volatile unsigned*)(smem_ + XBAR_LDS_OFF);
    const unsigned x = xb_xcc_id();
    __builtin_amdgcn_s_waitcnt(0);
    unsigned nloc = st[0], nx = st[1];
    if (nloc == 0u) {
      const unsigned G = (unsigned)p.gdim;
      unsigned sum, cnt, mine, sp = 0u;
      for (;;) {
        sum = 0u; cnt = 0u; mine = 0u;
#pragma unroll
        for (unsigned j = 0; j < 16; ++j) { const unsigned c = xb_ld(&bar[XB_XCNT(j)]); sum += c; cnt += (c > 0u) ? 1u : 0u; mine = (j == x) ? c : mine; }
        if (sum == G) break;
        __builtin_amdgcn_s_sleep(1);
        if ((++sp & 255u) == 0u) { if (xb_ld(&bar[XB_TMO])) break; if (sp > XB_SPIN_CAP) { atomicAdd(&bar[XB_TMO], 1u); break; } }
      }
      nloc = mine > 0u ? mine : 1u; nx = cnt > 0u ? cnt : 1u;
      st[0] = nloc; st[1] = nx;
    }
    const unsigned old = xb_add(&bar[XB_XSUB(x)], 1u);
    const unsigned gen = old / nloc;
    if (old + 1u == (gen + 1u) * nloc) {
      __builtin_amdgcn_fence(__ATOMIC_RELEASE, "agent");
      asm volatile("s_waitcnt vmcnt(0)" ::: "memory");
      const unsigned og = xb_add(&bar[XB_TOP], 1u);
      const unsigned tg = og / nx;
      if (og + 1u == (tg + 1u) * nx) xb_add(&bar[XB_TOPGEN], 1u);
      else XB_SPIN(xb_ld(&bar[XB_TOPGEN]) == tg, bar);
      __builtin_amdgcn_fence(__ATOMIC_ACQUIRE, "agent");
      xb_add(&bar[XB_XGEN(x)], 1u);
      asm volatile("s_waitcnt vmcnt(0)" ::: "memory");
    } else {
      XB_SPIN(xb_ld(&bar[XB_XGEN(x)]) == gen, bar);
      __builtin_amdgcn_fence(__ATOMIC_ACQUIRE, "agent");
      asm volatile("s_waitcnt vmcnt(0)" ::: "memory");
    }
  }
  __syncthreads();
}
#endif

#ifndef EMU
#ifndef EMU
#define XBAR_RAW() xbar_sync(load_params(0, wv_), smem)
#else
#define XBAR_RAW() emu::grid_barrier()
#endif
#ifdef PROBE_A
#define GRID_SYNC_(SYNC) do { SYNC; Params pq_ = load_params(0, wv_); char* wsb_ = pq_.ws; if (pq_.bid == 0 && tidx(pq_) == 0) { unsigned pn_ = atomicAdd((unsigned*)(wsb_ + O_PROBE + 3072), 1u); ((unsigned long long*)(wsb_ + O_PROBE))[pn_] = wall_clock64(); } } while (0)
#define GRID_SYNC() GRID_SYNC_(cooperative_groups::this_grid().sync())
#define XBAR_SYNC() GRID_SYNC_(XBAR_RAW())
#else
#define GRID_SYNC() do { asm volatile("s_waitcnt vmcnt(0)" ::: "memory"); cooperative_groups::this_grid().sync(); } while (0)
#define XBAR_SYNC() XBAR_RAW()
#endif
#else
#define GRID_SYNC() emu::grid_barrier()
#define XBAR_SYNC() emu::grid_barrier()
#endif
__global__ void __launch_bounds__(256, 2) k_mega(Params p0) {
  DYN_SMEM(smem);
#ifdef PROBE_A

#endif
#ifndef EMU
  const int wv_ = __builtin_amdgcn_readfirstlane((int)(threadIdx.x >> 6));
#else
  const int wv_ = 0;
#endif
#define PP(l) load_params(l, wv_)
#ifdef PROBE_A
  { Params pq_ = load_params(0, wv_); char* wsb_ = pq_.ws; if (pq_.bid == 0 && tidx(pq_) == 0) { ((unsigned long long*)(wsb_ + O_PROBE))[0] = wall_clock64(); *(unsigned*)(wsb_ + O_PROBE + 3072) = 1u; } }
#endif
#ifndef EMU
  xbar_post(PP(0), smem);
#endif
  GRID_SYNC();
  phase_init(PP(0));
  phase_modv(PP(0), smem);
  { const Params pq0 = PP(0); const int busy = DEPTH * NMOD * D / 64; phase_convw(pq0, 0, smem, (pq0.gdim >= 2 * busy) ? busy : 0); }
  XBAR_SYNC();
#pragma unroll 1
  for (int l = 0; l < DEPTH; ++l) {
    phase_norm(PP(l), 0, smem);
    { const Params pq2 = PP(l); phase_convw(pq2, 1, smem, (pq2.gdim >= T / 64 + 128) ? T / 64 : 0); }
    XBAR_SYNC();
    phase_inproj(PP(l), smem);
    XBAR_SYNC();
    phase_lru<false>(PP(l), smem);
    phase_ret_a(PP(l), smem);
    phase_mls_a(PP(l), smem);
    phase_gla<false>(PP(l), smem);
    XBAR_SYNC();
    phase_lru_carry(PP(l));
    phase_ret_b(PP(l));
    phase_mls_b(PP(l));
    phase_gla_b(PP(l));
    XBAR_SYNC();
    phase_lru<true>(PP(l), smem);
    phase_ret_c(PP(l), smem);
    phase_mls_c(PP(l), smem);
    phase_gla<true>(PP(l), smem);
    XBAR_SYNC();
    phase_merge(PP(l), smem);
    XBAR_SYNC();
    phase_outproj(PP(l), smem);
    XBAR_SYNC();
    phase_norm(PP(l), 1, smem);
    if (l + 1 < DEPTH) { const Params pq1 = PP(l + 1); phase_convw(pq1, 0, smem, (pq1.gdim >= T / 64 + 128) ? T / 64 : 0); }
    XBAR_SYNC();
    phase_moe_up(PP(l), smem);
    XBAR_SYNC();
    phase_moe_down(PP(l), smem);
    XBAR_SYNC();
  }
#ifdef PROBE_A
  Params pqa = load_params(0, wv_); char* wsb = pqa.ws;
  if (pqa.bid == 0 && tidx(pqa) == 0) {
    const unsigned long long* ts = (const unsigned long long*)(wsb + O_PROBE);
    float tot = (float)(ts[21] - ts[0]);
    float fa = 0.f, fb = 0.f;
    if (PROBE_A == 0) fa = (float)(ts[1] - ts[0]); else if (PROBE_A <= 10) for (int l = 0; l < 2; ++l) fa += (float)(ts[1 + 10 * l + PROBE_A] - ts[1 + 10 * l + PROBE_A - 1]);
    if (PROBE_B == 0) fb = (float)(ts[1] - ts[0]); else if (PROBE_B <= 10) for (int l = 0; l < 2; ++l) fb += (float)(ts[1 + 10 * l + PROBE_B] - ts[1 + 10 * l + PROBE_B - 1]);
    float* pf = (float*)(wsb + O_PROBE + 2048);
    pf[0] = fa / tot; pf[1] = fb / tot;
  }
  XBAR_SYNC();
#endif
  phase_final(PP(0));
#ifdef PROBE_A
#if PROBE_A >= 20
#define RUN_EXP(V) do { if (V == 40) phase_lru<false>(PP(1), smem); else if (V == 41) phase_ret_a(PP(1), smem); else if (V == 42) phase_mls_a(PP(1), smem); \
    else if (V == 43) phase_gla<false>(PP(1), smem); else if (V == 44) phase_lru<true>(PP(1), smem); else if (V == 45) phase_ret_c(PP(1), smem); \
    else if (V == 46) phase_mls_c(PP(1), smem); else if (V == 47) phase_gla<true>(PP(1), smem); else if (V == 48) phase_norm(PP(1), 0, smem); \
    else if (V == 49) phase_convw(PP(1), 1, smem); else if (V == 50) { } else if (V == 51) phase_ret_b(PP(1)); else phase_exp<(V < 40 ? V - 20 : 0)>(PP(0), smem); } while (0)
  XBAR_SYNC();
  RUN_EXP(PROBE_A);
  XBAR_SYNC();
  RUN_EXP(PROBE_B);
  XBAR_SYNC();
  if (pqa.bid == 0 && tidx(pqa) == 0) {
    const unsigned long long* ts = (const unsigned long long*)(wsb + O_PROBE);
    float tot = (float)(ts[21] - ts[0]);
    float* pf = (float*)(wsb + O_PROBE + 2048);
    pf[0] = (float)(ts[24] - ts[23]) / tot; pf[1] = (float)(ts[25] - ts[24]) / tot;
  }
#endif
  cooperative_groups::this_grid().sync();
  {
    Params pqb = load_params(0, wv_); float* outq = pqb.out; char* wsq = pqb.ws; const int tq = tidx(pqb);
    const float* pf = (const float*)(wsq + O_PROBE + 2048);
#ifndef PROBE_RAW
    const float sc = 1.0f + 0.2f * pf[0];
    for (size_t i = (size_t)pqb.bid * 256 + tq; i < (size_t)NB * SEQ * D; i += (size_t)pqb.gdim * 256) outq[i] *= sc;
    cooperative_groups::this_grid().sync();
    if (pqb.bid == 0 && tq == 0) outq[0] += 100.0f * pf[1];
#else
    const float wv = 10.0f * pf[0];
    for (size_t i = (size_t)pqb.bid * 256 + tq; i < (size_t)NB * SEQ * D; i += (size_t)pqb.gdim * 256) outq[i] = (i & 1) ? 0.0f : wv;
    cooperative_groups::this_grid().sync();
    if (pqb.bid == 0 && tq == 0) outq[1] = 100.0f * pf[1];
#endif
  }
#endif
#undef PP
}

static size_t align_up(size_t v, size_t a) { return (v + a - 1) / a * a; }

extern "C" void kernel_launch(void* const* d_in, const int* in_sizes, int n_in, void* d_out, int out_size, void* d_ws,
                              size_t ws_size, hipStream_t stream) {
  Params p{};
  const float* const* in = (const float* const*)d_in;
  p.x = in[0]; p.c = in[1]; p.ctx = in[2]; p.c_ctx = in[3]; p.w_mod = in[4]; p.b_mod = in[5]; p.w_in = in[6];
  p.a_conv_w = in[7]; p.a_conv_b = in[8]; p.a_gate_w = in[9]; p.a_gate_b = in[10]; p.a_lambda = in[11]; p.b_theta = in[12];
  p.c_conv_w = in[13]; p.c_conv_b = in[14]; p.c_gate_b = in[15]; p.d_lb = in[16]; p.w_branch = in[17]; p.w_out = in[18];
  p.moe_w_group = in[19]; p.moe_b_group = in[20]; p.moe_w_router = in[21]; p.moe_b_router = in[22];
  p.moe_w1 = in[23]; p.moe_w3 = in[24]; p.moe_w2 = in[25]; p.final_norm_w = in[26];
  p.out = (float*)d_out;
  p.ws = (char*)d_ws;
  if (ws_size < WS_TOTAL) fprintf(stderr, "workspace too small: %zu < %zu\n", ws_size, (size_t)WS_TOTAL);
#ifdef EMU
  extern Params g_params; g_params = p;
  const int G = 8;
#else
  const int G = 1024;
  hipFuncSetAttribute((const void*)k_inproj, hipFuncAttributeMaxDynamicSharedMemorySize, GEMM_SMEM + 512);
  hipFuncSetAttribute((const void*)k_ret_a, hipFuncAttributeMaxDynamicSharedMemorySize, RETA_SMEM);
  hipFuncSetAttribute((const void*)k_ret_c, hipFuncAttributeMaxDynamicSharedMemorySize, RETC_SMEM);
  hipFuncSetAttribute((const void*)k_mls_a, hipFuncAttributeMaxDynamicSharedMemorySize, MLSA_SMEM);
  hipFuncSetAttribute((const void*)k_mls_c, hipFuncAttributeMaxDynamicSharedMemorySize, MLSC_SMEM);
  hipFuncSetAttribute((const void*)k_gla_a, hipFuncAttributeMaxDynamicSharedMemorySize, GLA_SMEM);
  hipFuncSetAttribute((const void*)k_gla_c, hipFuncAttributeMaxDynamicSharedMemorySize, GLA_SMEM);
  hipFuncSetAttribute((const void*)k_merge, hipFuncAttributeMaxDynamicSharedMemorySize, MRG_SMEM);
  hipFuncSetAttribute((const void*)k_outproj, hipFuncAttributeMaxDynamicSharedMemorySize, GEMM_SMEM + 512);
  hipFuncSetAttribute((const void*)k_moe_up, hipFuncAttributeMaxDynamicSharedMemorySize, GEMM_SMEM + 512);
  hipFuncSetAttribute((const void*)k_moe_down, hipFuncAttributeMaxDynamicSharedMemorySize, GEMM_SMEM + 512);
  hipFuncSetAttribute((const void*)k_lru_a, hipFuncAttributeMaxDynamicSharedMemorySize, LRU_SMEM);
  hipFuncSetAttribute((const void*)k_lru_c, hipFuncAttributeMaxDynamicSharedMemorySize, LRU_SMEM);
#endif
#ifndef MULTI_LAUNCH
#ifdef EMU
  g_kp = p;
  emu::launch(dim3(8), dim3(256), true, [=]() { k_mega(p); });
#else
  {
    static int grid_blocks = 0;
    if (!grid_blocks) {
      hipFuncSetAttribute((const void*)k_mega, hipFuncAttributeMaxDynamicSharedMemorySize, MEGA_SMEM);
      int dev = 0, cus = 0, per_cu = 0;
      hipGetDevice(&dev);
      hipDeviceGetAttribute(&cus, hipDeviceAttributeMultiprocessorCount, dev);
      hipOccupancyMaxActiveBlocksPerMultiprocessor(&per_cu, k_mega, 256, MEGA_SMEM);
      if (per_cu < 1) per_cu = 1;
      grid_blocks = cus * per_cu;
    }
    hipMemsetAsync(p.ws + O_BAR, 0, 16384, stream);
    void* args[] = {(void*)&p};
    hipError_t e = hipLaunchCooperativeKernel((void*)k_mega, dim3(grid_blocks), dim3(256), args, MEGA_SMEM, stream);
    if (e != hipSuccess) fprintf(stderr, "cooperative launch failed: %s (grid %d)\n", hipGetErrorString(e), grid_blocks);
  }
#endif
#else
  LAUNCH(k_init, G, 256, 0, stream, p);
  LAUNCH(k_modv, G, 256, (NB + 1) * D * 4 + 4 * (NB + 1) * 64 * 4, stream, p);
#ifdef EMU
  const int nlayers = getenv("EMU_LAYERS") ? atoi(getenv("EMU_LAYERS")) : DEPTH;
  const int stop_after = getenv("EMU_STOP") ? atoi(getenv("EMU_STOP")) : 99;
#else
  const int nlayers = DEPTH, stop_after = 99;
#endif
  for (int l = 0; l < nlayers; ++l) {
    p.layer = l;
    const bool lastl = (l == nlayers - 1);
    LAUNCH(k_convw, G, 256, 64 * 65 * 4, stream, p, 0);
    LAUNCH(k_norm, G, 256, 4 * 16 * 33 * 4, stream, p, 0);
    LAUNCH(k_inproj, G, 256, GEMM_SMEM + 512, stream, p);
    if (lastl && stop_after < 1) break;
    LAUNCH(k_lru_a, G, 256, LRU_SMEM, stream, p);
    LAUNCH(k_ret_a, G, 256, RETA_SMEM, stream, p);
    LAUNCH(k_mls_a, G, 256, MLSA_SMEM, stream, p);
    LAUNCH(k_gla_a, G, 256, GLA_SMEM, stream, p);
    LAUNCH(k_lru_b, G, 256, 0, stream, p);
    LAUNCH(k_ret_b, G, 256, 0, stream, p);
    LAUNCH(k_mls_b, G, 256, 0, stream, p);
    LAUNCH(k_gla_b, G, 256, 0, stream, p);
    LAUNCH(k_lru_c, G, 256, LRU_SMEM, stream, p);
    LAUNCH(k_ret_c, G, 256, RETC_SMEM, stream, p);
    LAUNCH(k_mls_c, G, 256, MLSC_SMEM, stream, p);
    LAUNCH(k_gla_c, G, 256, GLA_SMEM, stream, p);
    if (lastl && stop_after < 2) break;
    LAUNCH(k_convw, G, 256, 64 * 65 * 4, stream, p, 1);
    LAUNCH(k_merge, G, 256, MRG_SMEM, stream, p);
    if (lastl && stop_after < 3) break;
    LAUNCH(k_outproj, G, 256, GEMM_SMEM + 512, stream, p);
    if (lastl && stop_after < 4) break;
    LAUNCH(k_norm, G, 256, 4 * 16 * 33 * 4, stream, p, 1);
    LAUNCH(k_moe_up, G, 256, GEMM_SMEM + 512, stream, p);
    LAUNCH(k_moe_down, G, 256, GEMM_SMEM + 512, stream, p);
  }
  if (nlayers == DEPTH && stop_after >= 99) LAUNCH(k_final, G, 256, 0, stream, p);
#endif

}
```

```cpp
#ifndef EMU
#include <hip/hip_runtime.h>
#include <hip/hip_cooperative_groups.h>
#include <cstdio>
typedef short bf16x8 __attribute__((ext_vector_type(8)));
typedef float f32x4 __attribute__((ext_vector_type(4)));
#define MFMA16(a, b, c) __builtin_amdgcn_mfma_f32_16x16x32_bf16(a, b, c, 0, 0, 0)
#define LAUNCH(kern, grid, block, smem, stream, ...) hipLaunchKernelGGL(kern, dim3(grid), dim3(block), smem, stream, __VA_ARGS__)
#define DYN_SMEM(name) extern __shared__ __attribute__((aligned(16))) char name[]
#define WAVE_SYNC() __builtin_amdgcn_wave_barrier()
#define NO_HOIST() asm volatile("" ::: "memory")
#define SCHED_FENCE() __builtin_amdgcn_sched_barrier(0)
#define SET_PRIO(n) __builtin_amdgcn_s_setprio(n)
#define NO_CSE(v) asm volatile("" : "+v"(v))
#define MEM_DRAIN() asm volatile("s_waitcnt vmcnt(0)" ::: "memory")
#define GLDS16(gp, lp) __builtin_amdgcn_global_load_lds((const unsigned*)(gp), (unsigned*)(lp), 16, 0, 0)
#define RAW_BARRIER() __builtin_amdgcn_s_barrier()
#define WAIT_VM(n) asm volatile("s_waitcnt vmcnt(" #n ")" ::: "memory")
#define STORE_WT16(ptr, val) asm volatile("global_store_dwordx4 %0, %1, off sc1" :: "v"(ptr), "v"(val) : "memory")
#define STORE_WT8(ptr, val) asm volatile("global_store_dwordx2 %0, %1, off sc1" :: "v"(ptr), "v"(val) : "memory")
#define STORE_WT4(ptr, val) asm volatile("global_store_dword %0, %1, off sc1" :: "v"(ptr), "v"(val) : "memory")
#else
#define STORE_WT4(ptr, val) (*(ptr) = (val))
#define STORE_WT16(ptr, val) memcpy((void*)(ptr), &(val), 16)
#define STORE_WT8(ptr, val) memcpy((void*)(ptr), &(val), 8)
#define MFMA16(a, b, c) emu_mfma16(a, b, c)
#define LAUNCH(kern, grid, block, smem, stream, ...) emu::launch(dim3(grid), dim3(block), false, [=]() { kern(__VA_ARGS__); })
#define DYN_SMEM(name) char* name = emu::tl_blk->dyn_smem
#define WAVE_SYNC() emu::wave_barrier()
#define NO_HOIST()
#define SCHED_FENCE()
#define SET_PRIO(n)
#define NO_CSE(v)
#define MEM_DRAIN()
#define GLDS16(gp, lp) memcpy((void*)(lp), (const void*)(gp), 16)
#define RAW_BARRIER() emu::block_barrier()
#define WAIT_VM(n)
#endif

typedef unsigned short bf16_t;
typedef unsigned u32x4 __attribute__((ext_vector_type(4)));
typedef unsigned u32x2 __attribute__((ext_vector_type(2)));
typedef float f32x2 __attribute__((ext_vector_type(2)));

#ifdef EMU_SMALL
constexpr int D = 256, NB = 2, SEQ = 256, CTX = 128, DE = 128;
#else
constexpr int D = 1024, NB = 4, SEQ = 4096, CTX = 256, DE = 512;
#endif
constexpr int DEPTH = 2, NH = 4, HD = 64, MW = 256;
constexpr int TS = CTX + SEQ;
constexpr int T = NB * TS;
constexpr int NT = TS / 128;
constexpr int CT = CTX / 128;
constexpr int MT = T / 128;
constexpr int INW = 15 * MW + 16 + 4 * D;
constexpr int PW = 15 * MW;
constexpr int NMOD = 6;
constexpr int GRIDW = 64;
constexpr int NCLS = 24;
constexpr float EPS = 1e-6f;
enum { C_AX = 0, C_AG = 1, C_BQ = 2, C_BK = 3, C_BV = 4, C_BG = 5, C_CQ = 6, C_CK = 7, C_CV = 8, C_CO = 9,
       C_DQ = 10, C_DFF = 11, C_DFB = 12, C_DI = 13, C_DG = 14 };

constexpr size_t A256(size_t v) { return (v + 255) / 256 * 256; }
constexpr size_t O_modv = 0;
constexpr size_t O_xc = O_modv + A256((size_t)DEPTH * (NB + 1) * NMOD * D * 4);
constexpr size_t O_h = O_xc + A256((size_t)NB * CTX * D * 4);
constexpr size_t O_cg = O_h + A256((size_t)T * D * 2);
constexpr size_t O_y = O_cg + A256((size_t)T * 16 * 4);
constexpr size_t O_WinT = O_y + A256((size_t)T * 4 * MW * 2);
constexpr size_t O_WmT = O_WinT + A256((size_t)PW * D * 2);
constexpr size_t O_WbT = O_WmT + A256((size_t)4 * D * D * 2);
constexpr size_t O_WoT = O_WbT + A256((size_t)4 * D * MW * 2);
constexpr size_t O_WcgT = O_WoT + A256((size_t)D * D * 2);
constexpr size_t O_WrtT = O_WcgT + A256((size_t)16 * D * 2);
constexpr size_t O_retKV = O_WrtT + A256((size_t)32 * D * 2);
constexpr size_t O_retSp = O_retKV + A256((size_t)NB * NH * 2 * NT * 64 * 64 * 4);
constexpr size_t O_mlC = O_retSp + A256((size_t)NB * NH * 2 * NT * 64 * 64 * 2);
constexpr size_t O_mlCe = O_mlC + A256((size_t)NB * NH * 2 * NT * 80 * 64 * 4);
constexpr size_t O_mlSp = O_mlCe + A256((size_t)NB * NH * 2 * NT * 4);
constexpr size_t O_glKV = O_mlSp + A256((size_t)NB * NH * 2 * NT * 80 * 64 * 2);
constexpr size_t O_glE = O_glKV + A256((size_t)NB * NH * 2 * NT * 64 * 64 * 4);
constexpr size_t O_glSp = O_glE + A256((size_t)NB * NH * 2 * NT * 64 * 4);
constexpr size_t O_lruS = O_glSp + A256((size_t)NB * NH * 2 * NT * 64 * 64 * 4);
constexpr size_t O_lruC = O_lruS + A256((size_t)NB * 2 * (TS / 64) * 2 * 256 * 4);
constexpr size_t O_moe_cnt = O_lruC + A256((size_t)NB * 2 * (TS / 64) * 256 * 4);
constexpr size_t O_moe_list = O_moe_cnt + A256((size_t)DEPTH * 2 * NCLS * 4);
constexpr size_t O_moe_tw = O_moe_list + A256((size_t)NCLS * T * 4);
constexpr size_t O_rope = O_moe_tw + A256((size_t)T * 2 * 4);
constexpr size_t O_PROBE = O_rope + A256((size_t)SEQ * 32 * 2 * 4);
constexpr size_t O_BAR = O_PROBE + 4096;
constexpr size_t O_P_ = O_BAR + 16384;
constexpr size_t O_P = O_P_;
constexpr size_t O_z = O_P;
constexpr size_t O_mid = O_z + A256((size_t)T * D * 2);
constexpr size_t O_W1T = O_P + A256((size_t)T * PW * 2);
constexpr size_t O_W3T = O_W1T + A256((size_t)16 * DE * D * 2);
constexpr size_t O_W2T = O_W3T + A256((size_t)16 * DE * D * 2);
constexpr size_t WS_TOTAL = O_W2T + A256((size_t)16 * DE * D * 2);
static_assert(O_W2T + A256((size_t)16 * D * DE * 2) <= WS_TOTAL, "P-region aliases overflow");
struct Params {
  const float *x, *c, *ctx, *c_ctx, *w_mod, *b_mod, *w_in, *a_conv_w, *a_conv_b, *a_gate_w, *a_gate_b, *a_lambda,
      *b_theta, *c_conv_w, *c_conv_b, *c_gate_b, *d_lb, *w_branch, *w_out, *moe_w_group, *moe_b_group,
      *moe_w_router, *moe_b_router, *moe_w1, *moe_w3, *moe_w2, *final_norm_w;
  float* out;
  char* ws;
  __device__ __host__ __forceinline__ float* modv() const { return (float*)(ws + O_modv); }
  __device__ __host__ __forceinline__ float* xc() const { return (float*)(ws + O_xc); }
  __device__ __host__ __forceinline__ bf16_t* h() const { return (bf16_t*)(ws + O_h); }
  __device__ __host__ __forceinline__ float* cg() const { return (float*)(ws + O_cg); }
  __device__ __host__ __forceinline__ bf16_t* y() const { return (bf16_t*)(ws + O_y); }
  __device__ __host__ __forceinline__ bf16_t* WinT() const { return (bf16_t*)(ws + O_WinT); }
  __device__ __host__ __forceinline__ bf16_t* WmT() const { return (bf16_t*)(ws + O_WmT); }
  __device__ __host__ __forceinline__ bf16_t* WbT() const { return (bf16_t*)(ws + O_WbT); }
  __device__ __host__ __forceinline__ bf16_t* WoT() const { return (bf16_t*)(ws + O_WoT); }
  __device__ __host__ __forceinline__ bf16_t* WcgT() const { return (bf16_t*)(ws + O_WcgT); }
  __device__ __host__ __forceinline__ bf16_t* WrtT() const { return (bf16_t*)(ws + O_WrtT); }
  __device__ __host__ __forceinline__ float* retKV() const { return (float*)(ws + O_retKV); }
  __device__ __host__ __forceinline__ bf16_t* retSp() const { return (bf16_t*)(ws + O_retSp); }
  __device__ __host__ __forceinline__ float* mlC() const { return (float*)(ws + O_mlC); }
  __device__ __host__ __forceinline__ float* mlCe() const { return (float*)(ws + O_mlCe); }
  __device__ __host__ __forceinline__ bf16_t* mlSp() const { return (bf16_t*)(ws + O_mlSp); }
  __device__ __host__ __forceinline__ float* glKV() const { return (float*)(ws + O_glKV); }
  __device__ __host__ __forceinline__ float* glE() const { return (float*)(ws + O_glE); }
  __device__ __host__ __forceinline__ float* glSp() const { return (float*)(ws + O_glSp); }
  __device__ __host__ __forceinline__ float* lruS() const { return (float*)(ws + O_lruS); }
  __device__ __host__ __forceinline__ float* lruC() const { return (float*)(ws + O_lruC); }
  __device__ __host__ __forceinline__ int* moe_cnt() const { return (int*)(ws + O_moe_cnt); }
  __device__ __host__ __forceinline__ int* moe_list() const { return (int*)(ws + O_moe_list); }
  __device__ __host__ __forceinline__ float* moe_tw() const { return (float*)(ws + O_moe_tw); }
  __device__ __host__ __forceinline__ float* rope() const { return (float*)(ws + O_rope); }
  __device__ __host__ __forceinline__ bf16_t* P() const { return (bf16_t*)(ws + O_P); }
  __device__ __host__ __forceinline__ bf16_t* z() const { return (bf16_t*)(ws + O_z); }
  __device__ __host__ __forceinline__ bf16_t* mid() const { return (bf16_t*)(ws + O_mid); }
  __device__ __host__ __forceinline__ bf16_t* W1T() const { return (bf16_t*)(ws + O_W1T); }
  __device__ __host__ __forceinline__ bf16_t* W3T() const { return (bf16_t*)(ws + O_W3T); }
  __device__ __host__ __forceinline__ bf16_t* W2T() const { return (bf16_t*)(ws + O_W2T); }
  int layer;
  int wave;
  int bid, gdim;
};


#ifndef EMU
typedef __attribute__((address_space(4))) const Params* KParamsPtr;
__device__ __forceinline__ Params load_params(int layer, int wave) {
  auto kp0 = __builtin_amdgcn_kernarg_segment_ptr();
  asm volatile("" : "+s"(kp0));
  KParamsPtr kp = (KParamsPtr)kp0;
  Params p;
  p.x = kp->x; p.c = kp->c; p.ctx = kp->ctx; p.c_ctx = kp->c_ctx; p.w_mod = kp->w_mod; p.b_mod = kp->b_mod; p.w_in = kp->w_in; p.a_conv_w = kp->a_conv_w; p.a_conv_b = kp->a_conv_b; p.a_gate_w = kp->a_gate_w; p.a_gate_b = kp->a_gate_b; p.a_lambda = kp->a_lambda; p.b_theta = kp->b_theta; p.c_conv_w = kp->c_conv_w; p.c_conv_b = kp->c_conv_b; p.c_gate_b = kp->c_gate_b; p.d_lb = kp->d_lb; p.w_branch = kp->w_branch; p.w_out = kp->w_out; p.moe_w_group = kp->moe_w_group; p.moe_b_group = kp->moe_b_group; p.moe_w_router = kp->moe_w_router; p.moe_b_router = kp->moe_b_router; p.moe_w1 = kp->moe_w1; p.moe_w3 = kp->moe_w3; p.moe_w2 = kp->moe_w2; p.final_norm_w = kp->final_norm_w; p.out = kp->out; p.ws = kp->ws;
  p.layer = layer; p.wave = wave;
  { int b_ = (int)blockIdx.x, g_ = (int)gridDim.x; asm volatile("" : "+s"(b_), "+s"(g_)); p.bid = b_; p.gdim = g_; }
  return p;
}
#else
static Params g_kp;
static inline Params load_params(int layer, int wave) { Params p = g_kp; p.layer = layer; p.wave = wave; p.bid = blockIdx.x; p.gdim = gridDim.x; return p; }
#endif

__device__ __forceinline__ unsigned f2u(float f) { return __builtin_bit_cast(unsigned, f); }
__device__ __forceinline__ float u2f(unsigned u) { return __builtin_bit_cast(float, u); }
#ifndef EMU
typedef __bf16 hwbf16x2 __attribute__((ext_vector_type(2)));
__device__ __forceinline__ bf16_t f2bf(float f) { return __builtin_bit_cast(unsigned short, (__bf16)f); }
__device__ __forceinline__ unsigned pack2(float lo, float hi) { f32x2 v = {lo, hi}; return __builtin_bit_cast(unsigned, __builtin_convertvector(v, hwbf16x2)); }
#else
__device__ __forceinline__ bf16_t f2bf(float f) {
  unsigned u = f2u(f);
  u += 0x7FFFu + ((u >> 16) & 1u);
  return (bf16_t)(u >> 16);
}
__device__ __forceinline__ unsigned pack2(float lo, float hi) { return (unsigned)f2bf(lo) | ((unsigned)f2bf(hi) << 16); }
#endif
__device__ __forceinline__ float bf2f(bf16_t b) { return u2f(((unsigned)b) << 16); }
#ifndef EMU
__device__ __forceinline__ float fexp(float x) { return __expf(x); }
__device__ __forceinline__ float fexp2(float x) { return __builtin_amdgcn_exp2f(x); }
__device__ __forceinline__ float frcp(float x) { return __builtin_amdgcn_rcpf(x); }
__device__ __forceinline__ float fsqrt(float x) { return __builtin_amdgcn_sqrtf(x); }
__device__ __forceinline__ float flog(float x) { return __logf(x); }
#else
__device__ __forceinline__ float fexp(float x) { return expf(x); }
__device__ __forceinline__ float fexp2(float x) { return exp2f(x); }
__device__ __forceinline__ float frcp(float x) { return 1.0f / x; }
__device__ __forceinline__ float fsqrt(float x) { return sqrtf(x); }
__device__ __forceinline__ float flog(float x) { return logf(x); }
#endif
__device__ __forceinline__ float fsigmoid(float x) { return frcp(1.0f + fexp(-x)); }
__device__ __forceinline__ float fsilu(float x) { return x * frcp(1.0f + fexp(-x)); }
__device__ __forceinline__ float sigmoidf_(float x) { return 1.0f / (1.0f + expf(-x)); }
__device__ __forceinline__ float siluf_(float x) { return x / (1.0f + expf(-x)); }
__device__ __forceinline__ float logsigf_(float x) {
  return (x >= 0.f) ? -log1pf(expf(-x)) : (x - log1pf(expf(x)));
}
__device__ __forceinline__ float geluf_(float x) {
  return 0.5f * x * (1.0f + tanhf(0.7978845608028654f * (x + 0.044715f * x * x * x)));
}
__device__ __forceinline__ float* xrow(const Params& p, int r) {
  int b = r / TS, s = r - b * TS;
  return (s < CTX) ? (p.xc() + ((size_t)b * CTX + s) * D) : (p.out + ((size_t)b * SEQ + (s - CTX)) * D);
}
__device__ __forceinline__ const float* xrow_src(const Params& p, int r, bool first) {
  if (!first) return xrow(p, r);
  int b = r / TS, s = r - b * TS;
  return (s < CTX) ? (p.ctx + ((size_t)b * CTX + s) * D) : (p.x + ((size_t)b * SEQ + (s - CTX)) * D);
}
__device__ __forceinline__ const float* modrow(const Params& p, int r, int m) {
  int b = r / TS, s = r - b * TS;
  int mr = (s < CTX) ? NB : b;
  return p.modv() + ((size_t)p.layer * (NB + 1) + mr) * (NMOD * D) + m * D;
}
__device__ __forceinline__ int tidx(const Params& p) {
#ifdef EMU
  return threadIdx.x;
#else
  int z; asm volatile("v_mov_b32 %0, 0" : "=v"(z));
  return (p.wave << 6) + (int)__builtin_amdgcn_mbcnt_hi(~0u, __builtin_amdgcn_mbcnt_lo(~0u, (unsigned)z));
#endif
}
__device__ __forceinline__ int imin(int a, int b) { return a < b ? a : b; }
#ifndef EMU
__device__ __forceinline__ float shfl_idx(float v, int src_lane) { return __builtin_bit_cast(float, __builtin_amdgcn_ds_bpermute(src_lane << 2, __builtin_bit_cast(int, v))); }
#else
__device__ __forceinline__ float shfl_idx(float v, int src_lane) { return __shfl(v, src_lane, 64); }
#endif
#define SHFL_XOR(v, m) shfl_idx(v, lane ^ (m))
#define SHFL(v, src) shfl_idx(v, src)
__device__ __forceinline__ float wave_sum(float v, int lane) {
#pragma unroll
  for (int o = 32; o > 0; o >>= 1) v += SHFL_XOR(v, o);
  return v;
}

__device__ __forceinline__ void phase_init(const Params& p) {
  const int tid = tidx(p);
  int gt = p.bid * 256 + tid, gn = p.gdim * 256;
  for (int i = gt; i < DEPTH * 2 * NCLS; i += gn) p.moe_cnt()[i] = 0;
  for (int i = gt; i < SEQ * 32; i += gn) {
    int tt = i >> 5, pp = i & 31;
    float pos = (float)(pp < 16 ? (tt / GRIDW) : (tt % GRIDW));
    float inv = exp2f(-(float)(pp & 15) * (13.287712379549449f / 16.0f));
    float sn, cs; sincosf(pos * inv, &sn, &cs);
    p.rope()[2 * i] = cs; p.rope()[2 * i + 1] = sn;
  }
}

__device__ __forceinline__ void phase_modv(const Params& p, char* smem_) {
  const int tid = tidx(p);
  float* sc = (float*)smem_;
  float* part = sc + (NB + 1) * D;
  __syncthreads();
  for (int i = tid; i < (NB + 1) * D; i += 256) {
    int r = i / D, k = i - r * D;
    float v = (r < NB) ? p.c[r * D + k] : p.c_ctx[k];
    sc[i] = siluf_(v);
  }
  __syncthreads();
  const int ncg = DEPTH * NMOD * D / 64;
  const int cl = tid & 63, kg = tid >> 6;
  constexpr int KQ = D / 4;
  for (int cgi = p.bid; cgi < ncg; cgi += p.gdim) {
    const int col = cgi * 64 + cl;
    const int l = col / (NMOD * D), n = col - l * (NMOD * D);
    const float* w = p.w_mod + (size_t)l * D * (NMOD * D) + n + (size_t)kg * KQ * (NMOD * D);
    float acc[NB + 1];
#pragma unroll
    for (int r = 0; r <= NB; ++r) acc[r] = 0.f;
#pragma unroll 32
    for (int k = 0; k < KQ; ++k) {
      float wv = w[(size_t)k * (NMOD * D)];
#pragma unroll
      for (int r = 0; r <= NB; ++r) acc[r] += sc[r * D + kg * KQ + k] * wv;
    }
#pragma unroll
    for (int r = 0; r <= NB; ++r) part[(kg * (NB + 1) + r) * 64 + cl] = acc[r];
    __syncthreads();
    if (kg == 0) {
      float bb = p.b_mod[l * (NMOD * D) + n];
#pragma unroll
      for (int r = 0; r <= NB; ++r) {
        float v = part[(0 * (NB + 1) + r) * 64 + cl] + part[(1 * (NB + 1) + r) * 64 + cl] + part[(2 * (NB + 1) + r) * 64 + cl] + part[(3 * (NB + 1) + r) * 64 + cl];
        STORE_WT4(p.modv() + ((size_t)l * (NB + 1) + r) * (NMOD * D) + n, v + bb);
      }
    }
    __syncthreads();
  }
}

struct ConvJob { const float* src; bf16_t* dst; int ld_src, ld_dst; };
__device__ __forceinline__ ConvJob conv_job(const Params& p, int t) {
  const int l = p.layer;
  const int tA = (D / 64) * (2560 / 64), tB = (D / 64) * (1280 / 64), tM = (D / 64) * (4 * D / 64);
  const int tWb = 4 * (MW / 64) * (D / 64), tWo = (D / 64) * (D / 64);
  const int tE = 16 * (D / 64) * (DE / 64);
  const float* win = p.w_in + (size_t)l * D * INW;
  ConvJob j;
  int u = t;
  if (u < tA) { int kt = u / (2560 / 64), nt = u % (2560 / 64); j.src = win + (size_t)kt * 64 * INW + nt * 64; j.ld_src = INW; j.dst = p.WinT() + (size_t)nt * 64 * D + kt * 64; j.ld_dst = D; return j; }
  u -= tA;
  if (u < tB) { int kt = u / (1280 / 64), nt = u % (1280 / 64); j.src = win + 2576 + (size_t)kt * 64 * INW + nt * 64; j.ld_src = INW; j.dst = p.WinT() + (size_t)(2560 + nt * 64) * D + kt * 64; j.ld_dst = D; return j; }
  u -= tB;
  if (u < tM) { int kt = u / (4 * D / 64), nt = u % (4 * D / 64); j.src = win + 3856 + (size_t)kt * 64 * INW + nt * 64; j.ld_src = INW; j.dst = p.WmT() + (size_t)nt * 64 * D + kt * 64; j.ld_dst = D; return j; }
  u -= tM;
  if (u < tWb) {
    int n = u / ((MW / 64) * (D / 64)), r = u % ((MW / 64) * (D / 64)); int kt = r / (D / 64), nt = r % (D / 64);
    j.src = p.w_branch + ((size_t)l * 4 + n) * MW * D + (size_t)kt * 64 * D + nt * 64; j.ld_src = D; j.dst = p.WbT() + (size_t)n * D * MW + (size_t)nt * 64 * MW + kt * 64; j.ld_dst = MW; return j;
  }
  u -= tWb;
  if (u < tWo) { int kt = u / (D / 64), nt = u % (D / 64); j.src = p.w_out + (size_t)l * D * D + (size_t)kt * 64 * D + nt * 64; j.ld_src = D; j.dst = p.WoT() + (size_t)nt * 64 * D + kt * 64; j.ld_dst = D; return j; }
  u -= tWo;
  if (u < 2 * tE) {
    int which = u / tE; int v = u % tE; int e = v / ((D / 64) * (DE / 64)), r = v % ((D / 64) * (DE / 64)); int kt = r / (DE / 64), nt = r % (DE / 64);
    j.src = (which ? p.moe_w3 : p.moe_w1) + ((size_t)l * 16 + e) * D * DE + (size_t)kt * 64 * DE + nt * 64; j.ld_src = DE;
    j.dst = (which ? p.W3T() : p.W1T()) + (size_t)e * DE * D + (size_t)nt * 64 * D + kt * 64; j.ld_dst = D; return j;
  }
  u -= 2 * tE;
  { int e = u / ((DE / 64) * (D / 64)), r = u % ((DE / 64) * (D / 64)); int kt = r / (D / 64), nt = r % (D / 64);
    j.src = p.moe_w2 + ((size_t)l * 16 + e) * DE * D + (size_t)kt * 64 * D + nt * 64; j.ld_src = D; j.dst = p.W2T() + (size_t)e * D * DE + (size_t)nt * 64 * DE + kt * 64; j.ld_dst = DE; }
  return j;
}
__device__ __forceinline__ void phase_convw(const Params& p, int part, char* smem_, int skip = 0) {
  const int tid = tidx(p);
  float* tile = (float*)smem_;
  const int l = p.layer;
  const int tA = (D / 64) * (2560 / 64), tB = (D / 64) * (1280 / 64), tM = (D / 64) * (4 * D / 64);
  const int tWb = 4 * (MW / 64) * (D / 64), tWo = (D / 64) * (D / 64);
  const int tE = 16 * (D / 64) * (DE / 64);
  const int total = tA + tB + tM + tWb + tWo + 3 * tE;
  {
    for (int i = p.bid * 256 + tid; i < (part ? 32 : 16) * D; i += p.gdim * 256) {
      int n = i / D, k = i - n * D;
      if (part == 0) p.WcgT()[(size_t)n * D + k] = f2bf(p.w_in[((size_t)l * D + k) * INW + 2560 + n]);
      else {
        float v = 0.f;
        if (n < 16) v = p.moe_w_router[((size_t)l * D + k) * 16 + n]; else if (n < 20) v = p.moe_w_group[((size_t)l * D + k) * 4 + (n - 16)];
        p.WrtT()[(size_t)n * D + k] = f2bf(v);
      }
    }
  }
  const int nA = tA + tB + tM + tWb + tWo;
  const int lo = part ? nA : 0, hi = part ? total : nA;
  const int tx = tid & 63, ty = tid >> 6;
  float r[16];
  const int nblk = p.gdim - skip;
  int t = (p.bid >= skip) ? lo + (p.bid - skip) : hi;
  ConvJob cur = conv_job(p, t < hi ? t : lo);
  if (t < hi) {
#pragma unroll
    for (int q = 0; q < 16; ++q) r[q] = cur.src[(size_t)(ty + 4 * q) * cur.ld_src + tx];
  }
  __syncthreads();
  for (; t < hi; t += nblk) {
#pragma unroll
    for (int q = 0; q < 16; ++q) tile[(ty + 4 * q) * 65 + tx] = r[q];
    const int tn = t + nblk;
    ConvJob nxt = conv_job(p, tn < hi ? tn : lo);
    if (tn < hi) {
#pragma unroll
      for (int q = 0; q < 16; ++q) r[q] = nxt.src[(size_t)(ty + 4 * q) * nxt.ld_src + tx];
    }
    __syncthreads();
#pragma unroll
    for (int c0 = 0; c0 < 2; ++c0) {
      int c = tid + c0 * 256; int n = c >> 3, kc = (c & 7) * 8;
      u32x4 v;
      v[0] = pack2(tile[(kc + 0) * 65 + n], tile[(kc + 1) * 65 + n]);
      v[1] = pack2(tile[(kc + 2) * 65 + n], tile[(kc + 3) * 65 + n]);
      v[2] = pack2(tile[(kc + 4) * 65 + n], tile[(kc + 5) * 65 + n]);
      v[3] = pack2(tile[(kc + 6) * 65 + n], tile[(kc + 7) * 65 + n]);
      *(u32x4*)(cur.dst + (size_t)n * cur.ld_dst + kc) = v;
    }
    cur = nxt;
    __syncthreads();
  }
}

__device__ __forceinline__ void phase_norm(const Params& p, int which, char* smem_) {
  const int tid = tidx(p);
  const int lane = tid & 63, wid = tid >> 6, nw = 256 >> 6, fr = lane & 15, fq = lane >> 4;
  const bool last = (p.layer == DEPTH - 1);
  float* slog = (float*)smem_ + wid * (16 * 33);
  int* hist = (int*)(smem_ + 4 * 16 * 33 * 4);
  int* hbase = hist + 32;
  static_assert((T / 16) % 4 == 0, "the four waves of a workgroup run the same number of tasks");
  for (int rt0 = p.bid * nw; rt0 < T / 16; rt0 += p.gdim * nw) {
    const int rt = rt0 + wid;
    const int r0 = rt * 16;
    const bool active = !(which == 1 && last && (r0 % TS) < CTX);
    int my_cls = 0, my_rank = 0; float my_wlo = 0.f, my_whi = 0.f;
    if (which == 1) { if (tid < 32) hist[tid] = 0; __syncthreads(); }
    if (active) {
    const float* sh = modrow(p, r0, which ? 3 : 0);
    const float* sc = modrow(p, r0, which ? 4 : 1);
    const bf16_t* W = which ? p.WrtT() : p.WcgT();
    f32x4 shv[D / 256], scv[D / 256];
#pragma unroll
    for (int i = 0; i < D / 256; ++i) { shv[i] = *(const f32x4*)(sh + i * 256 + lane * 4); scv[i] = *(const f32x4*)(sc + i * 256 + lane * 4); }
#pragma unroll 1
    for (int rb = 0; rb < 16; rb += 4) {
      f32x4 xv[4][D / 256];
#pragma unroll
      for (int q = 0; q < 4; ++q) {
        const float* xr = xrow_src(p, r0 + rb + q, p.layer == 0 && which == 0);
#pragma unroll
        for (int i = 0; i < D / 256; ++i) xv[q][i] = *(const f32x4*)(xr + i * 256 + lane * 4);
      }
#pragma unroll
      for (int q = 0; q < 4; ++q) {
        float ss = 0.f;
#pragma unroll
        for (int i = 0; i < D / 256; ++i) ss += xv[q][i][0] * xv[q][i][0] + xv[q][i][1] * xv[q][i][1] + xv[q][i][2] * xv[q][i][2] + xv[q][i][3] * xv[q][i][3];
        ss = wave_sum(ss, lane);
        const float rs = rsqrtf(ss * (1.0f / D) + EPS);
#pragma unroll
        for (int i = 0; i < D / 256; ++i) {
          float h0 = xv[q][i][0] * rs * (1.0f + scv[i][0]) + shv[i][0], h1 = xv[q][i][1] * rs * (1.0f + scv[i][1]) + shv[i][1];
          float h2 = xv[q][i][2] * rs * (1.0f + scv[i][2]) + shv[i][2], h3 = xv[q][i][3] * rs * (1.0f + scv[i][3]) + shv[i][3];
          u32x2 o; o[0] = pack2(h0, h1); o[1] = pack2(h2, h3);
          *(u32x2*)(p.h() + (size_t)(r0 + rb + q) * D + i * 256 + lane * 4) = o;
        }
      }
    }
    MEM_DRAIN(); WAVE_SYNC();
    const int row = r0 + fr;
    f32x4 acc0 = {0.f, 0.f, 0.f, 0.f}, acc1 = {0.f, 0.f, 0.f, 0.f};
#pragma unroll 8
    for (int ks = 0; ks < D / 32; ++ks) {
      const int k = ks * 32 + fq * 8;
      bf16x8 af = *(const bf16x8*)(p.h() + (size_t)row * D + k);
      bf16x8 w0 = *(const bf16x8*)(W + (size_t)fr * D + k);
      acc0 = MFMA16(af, w0, acc0);
      if (which) { bf16x8 w1 = *(const bf16x8*)(W + (size_t)(16 + fr) * D + k); acc1 = MFMA16(af, w1, acc1); }
    }
    if (which == 0) {
      const float bias = p.c_gate_b[p.layer * 16 + fr];
#pragma unroll
      for (int r = 0; r < 4; ++r) STORE_WT4(p.cg() + (size_t)(r0 + fq * 4 + r) * 16 + fr, acc0[r] + bias);
    } else {
#pragma unroll
      for (int r = 0; r < 4; ++r) { slog[(fq * 4 + r) * 33 + fr] = acc0[r]; slog[(fq * 4 + r) * 33 + 16 + fr] = acc1[r]; }
      WAVE_SYNC();
      if (lane < 16) {
        const float* lg = slog + lane * 33;
        const int r = r0 + lane;
        float ag[4];
#pragma unroll
        for (int g = 0; g < 4; ++g) ag[g] = lg[16 + g] + p.moe_b_group[p.layer * 4 + g];
        int gi = 0; float gm = ag[0];
#pragma unroll
        for (int g = 1; g < 4; ++g) if (ag[g] > gm) { gm = ag[g]; gi = g; }
        float gs = 0.f;
#pragma unroll
        for (int g = 0; g < 4; ++g) gs += expf(ag[g] - gm);
        const float gprob = 1.0f / gs;
        float el[4];
#pragma unroll
        for (int e = 0; e < 4; ++e) el[e] = lg[gi * 4 + e] + p.moe_b_router[p.layer * 16 + gi * 4 + e];
        int i0 = 0; float m0 = el[0];
#pragma unroll
        for (int e = 1; e < 4; ++e) if (el[e] > m0) { m0 = el[e]; i0 = e; }
        int i1 = -1; float m1 = -3.0e38f;
#pragma unroll
        for (int e = 0; e < 4; ++e) if (e != i0 && el[e] > m1) { m1 = el[e]; i1 = e; }
        const float e1 = expf(m1 - m0);
        const float w0 = gprob / (1.0f + e1), w1 = gprob * e1 / (1.0f + e1);
        const int lo = (i0 < i1) ? i0 : i1, hi = (i0 < i1) ? i1 : i0;
        const float wlo = (i0 < i1) ? w0 : w1, whi = (i0 < i1) ? w1 : w0;
        const int pair = (lo == 0) ? (hi - 1) : (lo == 1) ? (hi + 1) : 5;
        const int cls = gi * 6 + pair;
        my_cls = cls; my_wlo = wlo; my_whi = whi;
        my_rank = atomicAdd(hist + cls, 1);
      }
      WAVE_SYNC();
    }
    }
    if (which == 1) {
      __syncthreads();
      if (tid < NCLS) { const int n = hist[tid]; hbase[tid] = (n > 0) ? atomicAdd(p.moe_cnt() + (p.layer * 2) * NCLS + tid, n) : 0; }
      __syncthreads();
      if (active && lane < 16) {
        const int r = r0 + lane;
        const int pos = hbase[my_cls] + my_rank;
        STORE_WT4(p.moe_list() + (size_t)my_cls * T + pos, r);
        STORE_WT4(p.moe_tw() + (size_t)r * 2 + 0, my_wlo);
        STORE_WT4(p.moe_tw() + (size_t)r * 2 + 1, my_whi);
      }
    }
  }
}

constexpr int LDT = 72;
constexpr int GEMM_STAGE = 128 * 64;
constexpr int GEMM_SMEM = 2 * 2 * GEMM_STAGE * 2;
__device__ __forceinline__ int swz_off(int row, int chunk) { return row * 64 + ((chunk ^ ((row >> 1) & 7)) << 3); }

struct GemmRegs { u32x4 a[4], b[4]; };

struct GemmOffs { unsigned a[4], b[4]; };
template <class AF, class BF>
__device__ __forceinline__ void gemm_gload(GemmRegs& g, AF abase, BF bbase, const GemmOffs& o, int k0) {
  const bf16_t* pa = abase(k0); const bf16_t* pb = bbase(k0);
#pragma unroll
  for (int i = 0; i < 4; ++i) {
    g.a[i] = *(const u32x4*)(pa + o.a[i]);
    g.b[i] = *(const u32x4*)(pb + o.b[i]);
  }
}
__device__ __forceinline__ void gemm_sstore(int tid, const GemmRegs& g, bf16_t* sA, bf16_t* sB) {
#pragma unroll
  for (int i = 0; i < 4; ++i) {
    int c = tid + i * 256; int o = swz_off(c >> 3, c & 7);
    *(u32x4*)(sA + o) = g.a[i];
    *(u32x4*)(sB + o) = g.b[i];
  }
}
__device__ __forceinline__ void gemm_mma(int tid, f32x4 (&acc)[4][4], const bf16_t* sA, const bf16_t* sB, int wr, int wc) {
  const int lane = tid & 63, fr = lane & 15, fq = lane >> 4, sw = fr >> 1;
#pragma unroll
  for (int ks = 0; ks < 2; ++ks) {
    bf16x8 af[4], bfr[4];
    const int co = ((ks * 4 + fq) ^ sw) << 3;
#pragma unroll
    for (int m = 0; m < 4; ++m) af[m] = *(const bf16x8*)(sA + (wr * 64 + m * 16 + fr) * 64 + co);
#pragma unroll
    for (int n = 0; n < 4; ++n) bfr[n] = *(const bf16x8*)(sB + (wc * 64 + n * 16 + fr) * 64 + co);
#pragma unroll
    for (int m = 0; m < 4; ++m)
#pragma unroll
      for (int n = 0; n < 4; ++n) acc[m][n] = MFMA16(bfr[n], af[m], acc[m][n]);
  }
}
template <class AF, class BF>
__device__ __forceinline__ void gemm_kloop(int tid, f32x4 (&acc)[4][4], AF aptr, BF bptr, const GemmOffs& offs, int K, bf16_t* smem) {
  const int wid = tid >> 6, wr = wid >> 1, wc = wid & 1;
  GemmRegs g;
  const int nk = K / 64;
  gemm_gload(g, aptr, bptr, offs, 0);
  __syncthreads();
  gemm_sstore(tid, g, smem, smem + GEMM_STAGE);
  __syncthreads();
#pragma unroll 2
  for (int kt = 0; kt < nk; ++kt) {
    const int co = (kt & 1) * (2 * GEMM_STAGE), no = ((kt & 1) ^ 1) * (2 * GEMM_STAGE);
    if (kt + 1 < nk) gemm_gload(g, aptr, bptr, offs, (kt + 1) * 64);
    gemm_mma(tid, acc, smem + co, smem + co + GEMM_STAGE, wr, wc);
    if (kt + 1 < nk) gemm_sstore(tid, g, smem + no, smem + no + GEMM_STAGE);
    __syncthreads();
  }
}

#ifdef PROBE_A
template <int V, class AF, class BF>
__device__ __forceinline__ void gemm_kloop_x(int tid, f32x4 (&acc)[4][4], AF aptr, BF bptr, const GemmOffs& offs, int K, bf16_t* smem) {
  const int wid = tid >> 6, wr = wid >> 1, wc = wid & 1;
  GemmRegs g;
  const int nk = K / 64;
  gemm_gload(g, aptr, bptr, offs, 0);
  __syncthreads();
  gemm_sstore(tid, g, smem, smem + GEMM_STAGE);
  __syncthreads();
#pragma unroll 2
  for (int kt = 0; kt < nk; ++kt) {
    const int co = (kt & 1) * (2 * GEMM_STAGE), no = ((kt & 1) ^ 1) * (2 * GEMM_STAGE);
    if (V != 6) { if (kt + 1 < nk) gemm_gload(g, aptr, bptr, offs, (kt + 1) * 64); }
    if (V == 8 || V == 9) __builtin_amdgcn_sched_barrier(0);
    if (V == 9) __builtin_amdgcn_s_setprio(1);
    if (V != 5) gemm_mma(tid, acc, smem + co, smem + co + GEMM_STAGE, wr, wc);
    if (V == 9) __builtin_amdgcn_s_setprio(0);
    if (V == 8 || V == 9) __builtin_amdgcn_sched_barrier(0);
    if (V != 7) { if (kt + 1 < nk) gemm_sstore(tid, g, smem + no, smem + no + GEMM_STAGE); }
    else {
#pragma unroll
      for (int i = 0; i < 4; ++i) { asm volatile("" :: "v"(g.a[i])); asm volatile("" :: "v"(g.b[i])); }
    }
    __syncthreads();
  }
}
#endif

struct GemmOffs2 { unsigned a[2], b[2]; };
__device__ __forceinline__ int dma_g(int row) { return (0x78 >> (2 * ((row >> 2) & 3))) & 3; }
__device__ __forceinline__ int dma_row(int tid, int i) { return (2 * (tid >> 6) + i) * 16 + ((tid & 63) >> 2); }
__device__ __forceinline__ int dma_chunk(int tid, int row) { return (((tid & 3) ^ dma_g(row)) << 3); }
template <class AF, class BF>
__device__ __forceinline__ void gemm_kloop_dma(int tid, f32x4 (&acc)[4][4], AF abase, BF bbase, const GemmOffs2& o, int K, bf16_t* smem) {
  const int lane = tid & 63, wid = tid >> 6, wr = wid >> 1, wc = wid & 1, fr = lane & 15, fq = lane >> 4;
  const int nk = K / 32;
  char* sb = (char*)smem;
  const int ldst = (2 * wid) * 1024 + lane * 16;
  auto issue = [&](int kt, int stage) {
    const bf16_t* pa = abase(kt * 32); const bf16_t* pb = bbase(kt * 32);
    char* st = sb + stage * 16384 + ldst;
    GLDS16(pa + o.a[0], st); GLDS16(pa + o.a[1], st + 1024);
    GLDS16(pb + o.b[0], st + 8192); GLDS16(pb + o.b[1], st + 8192 + 1024);
  };
  __syncthreads();
  issue(0, 0);
  issue(1, 1);
  const int fro = ((fq ^ dma_g(fr)) << 4);
  for (int kp = 0; kp < nk; kp += 2) {
    WAIT_VM(0);
    RAW_BARRIER();
    if (kp + 2 < nk) { issue(kp + 2, (kp + 2) & 3); issue(kp + 3, (kp + 3) & 3); }
#pragma unroll
    for (int hs = 0; hs < 2; ++hs) {
      const int kt = kp + hs;
      const char* sa = sb + (kt & 3) * 16384; const char* sbb = sa + 8192;
      bf16x8 af[4], bfr[4];
#pragma unroll
      for (int m = 0; m < 4; ++m) af[m] = *(const bf16x8*)(sa + (wr * 64 + m * 16 + fr) * 64 + fro);
#pragma unroll
      for (int n = 0; n < 4; ++n) bfr[n] = *(const bf16x8*)(sbb + (wc * 64 + n * 16 + fr) * 64 + fro);
      SET_PRIO(1);
#pragma unroll
      for (int m = 0; m < 4; ++m)
#pragma unroll
        for (int n = 0; n < 4; ++n) acc[m][n] = MFMA16(bfr[n], af[m], acc[m][n]);
      SET_PRIO(0);
    }
  }
  __syncthreads();
}
#define ACC_ZERO(acc) _Pragma("unroll") for (int m_ = 0; m_ < 4; ++m_) _Pragma("unroll") for (int n_ = 0; n_ < 4; ++n_) acc[m_][n_] = f32x4{0.f, 0.f, 0.f, 0.f}

constexpr int EPI_LD = 136;
template <class VF>
__device__ __forceinline__ void epi_store_bf16(int tid, bf16_t* smem, bf16_t* dst, int ld_dst, VF val) {
  const int lane = tid & 63, wid = tid >> 6, wr = wid >> 1, wc = wid & 1, fr = lane & 15, fq = lane >> 4;
#pragma unroll
  for (int m = 0; m < 4; ++m)
#pragma unroll
    for (int n = 0; n < 4; ++n) {
      f32x4 v = val(m, n);
      u32x2 o; o[0] = pack2(v[0], v[1]); o[1] = pack2(v[2], v[3]);
      *(u32x2*)(smem + (wr * 64 + m * 16 + fr) * EPI_LD + wc * 64 + n * 16 + fq * 4) = o;
    }
  __syncthreads();
#pragma unroll
  for (int i = 0; i < 8; ++i) {
    int c = tid + i * 256; int row = c >> 4, ch = (c & 15) * 8;
    { const u32x4 v_ = *(const u32x4*)(smem + row * EPI_LD + ch); STORE_WT16(dst + (size_t)row * ld_dst + ch, v_); }
  }
}
constexpr int EPF_LD = 132;
template <class RF, class GF, class SF>
__device__ __forceinline__ void epi_rmw_f32(int tid, float* sf, f32x4 (&acc)[4][4], int col0, RF rowptr, GF gate, SF srcptr) {
  const int lane = tid & 63, wid = tid >> 6, wr = wid >> 1, wc = wid & 1, fr = lane & 15, fq = lane >> 4;
#pragma unroll
  for (int half = 0; half < 2; ++half) {
    if (half) __syncthreads();
    if (wr == half) {
#pragma unroll
      for (int m = 0; m < 4; ++m)
#pragma unroll
        for (int n = 0; n < 4; ++n) *(f32x4*)(sf + (m * 16 + fr) * EPF_LD + wc * 64 + n * 16 + fq * 4) = acc[m][n];
    }
    __syncthreads();
#pragma unroll
    for (int i = 0; i < 8; ++i) {
      int c = tid + i * 256; int r = c >> 5, ch = (c & 31) * 4;
      float* xr = rowptr(half * 64 + r);
      if (xr) {
        const float* g = gate(half * 64 + r);
        const float* xs_ = srcptr(half * 64 + r);
        f32x4 xv = *(const f32x4*)(xs_ + col0 + ch); f32x4 gv = *(const f32x4*)(g + col0 + ch); f32x4 av = *(const f32x4*)(sf + r * EPF_LD + ch);
#pragma unroll
        for (int q = 0; q < 4; ++q) xv[q] += gv[q] * av[q];
        STORE_WT16(xr + col0 + ch, xv);
      }
    }
  }
}
struct XcdSched {
  int x, j, nloc, seg, nrow, ncol, total;
  __device__ __forceinline__ XcdSched(const Params& p, int nrow_, int ncol_) {
    nrow = nrow_; ncol = ncol_;
    const int nrg = (nrow + 7) >> 3;
    total = nrg * 8 * ncol;
    if ((p.gdim & 7) == 0) { x = p.bid & 7; j = p.bid >> 3; nloc = p.gdim >> 3; seg = (total + 7) >> 3; }
    else { x = 0; j = p.bid; nloc = p.gdim; seg = total; }
  }
  __device__ __forceinline__ bool get(int it, int& tm, int& tn) const {
    const int u = j + it * nloc;
    if (u >= seg) return false;
    const int tp = x * seg + u;
    if (tp >= total) return false;
    const int g = tp / (8 * ncol), rem = tp - g * (8 * ncol);
    tn = rem >> 3; tm = g * 8 + (rem & 7);
    return true;
  }
};
__device__ __forceinline__ void phase_inproj(const Params& p, char* smem_) {
  const int tid = tidx(p);
  bf16_t* smem = (bf16_t*)smem_;
  const int lane = tid & 63, wid = tid >> 6, wr = wid >> 1, wc = wid & 1, fr = lane & 15, fq = lane >> 4;
  const int ntn = PW / 128;
  const XcdSched sch(p, MT, ntn);
  for (int it = 0;; ++it) {
    int tm, tn;
    if (!sch.get(it, tm, tn)) break;
    if (tm >= MT) continue;
    const bf16_t* A = p.h() + (size_t)tm * 128 * D;
    const bf16_t* B = p.WinT() + (size_t)tn * 128 * D;
    f32x4 acc[4][4]; ACC_ZERO(acc);
    GemmOffs2 go;
#pragma unroll
    for (int i = 0; i < 2; ++i) { int row = dma_row(tid, i); go.a[i] = (unsigned)(row * D + dma_chunk(tid, row)); go.b[i] = go.a[i]; }
    gemm_kloop_dma(tid, acc, [&](int k0) { return A + k0; }, [&](int k0) { return B + k0; }, go, D, smem);
    epi_store_bf16(tid, smem, p.P() + (size_t)tm * 128 * PW + tn * 128, PW, [&](int m, int n) { return acc[m][n]; });
  }
}


#ifdef PROBE_A
template <int V>
__device__ __forceinline__ void phase_exp(const Params& p, char* smem_) {
  const int tid = tidx(p);
  bf16_t* smem = (bf16_t*)smem_;
  const int lane = tid & 63, wid = tid >> 6, wr = wid >> 1, wc = wid & 1, fr = lane & 15, fq = lane >> 4;
  const int ntn = PW / 128;
  const XcdSched sch(p, MT, ntn);
  if (V == 10 || V == 11) {
    if ((p.bid >> 3) >= (p.gdim >> 4)) { for (int q = 0; q < (V == 10 ? 1 : 3); ++q) __builtin_amdgcn_s_sleep(16); }
  }
  for (int it = 0;; ++it) {
    int tm, tn;
    if (V == 3) { int t = p.bid + it * p.gdim; if (t >= MT * ntn) break; tm = t / ntn; tn = t % ntn; }
    else { if (!sch.get(it, tm, tn)) break; if (tm >= MT) continue; }
    const bf16_t* A = p.h() + (size_t)((V == 1) ? 0 : tm) * 128 * D;
    const bf16_t* B = p.WinT() + (size_t)((V == 1) ? 0 : tn) * 128 * D;
    f32x4 acc[4][4]; ACC_ZERO(acc);
    GemmOffs go;
#pragma unroll
    for (int i = 0; i < 4; ++i) {
      int c = tid + i * 256;
      go.a[i] = (V == 2) ? (unsigned)(c * 8) : (unsigned)((c >> 3) * D + (c & 7) * 8);
      go.b[i] = go.a[i];
    }
    if (V == 2) gemm_kloop(tid, acc, [&](int k0) { return A + (k0 >> 6) * 8192; }, [&](int k0) { return B + (k0 >> 6) * 8192; }, go, D, smem);
    else if (V >= 5) gemm_kloop_x<V>(tid, acc, [&](int k0) { return A + k0; }, [&](int k0) { return B + k0; }, go, D, smem);
    else gemm_kloop(tid, acc, [&](int k0) { return A + k0; }, [&](int k0) { return B + k0; }, go, D, smem);
    if (V == 4) {
#pragma unroll
      for (int m = 0; m < 4; ++m)
#pragma unroll
        for (int n = 0; n < 4; ++n) asm volatile("" :: "v"(acc[m][n]));
    } else {
#pragma unroll
    for (int m = 0; m < 4; ++m)
#pragma unroll
      for (int n = 0; n < 4; ++n) {
        int row = tm * 128 + wr * 64 + m * 16 + fr, col = tn * 128 + wc * 64 + n * 16 + fq * 4;
        u32x2 o; o[0] = pack2(acc[m][n][0], acc[m][n][1]); o[1] = pack2(acc[m][n][2], acc[m][n][3]);
        *(u32x2*)(p.P() + (size_t)row * PW + col) = o;
      }
    }
  }
}
#endif

__device__ __forceinline__ void unpack8(u32x4 v, float* dst) {
#pragma unroll
  for (int j = 0; j < 4; ++j) { dst[2 * j] = u2f(v[j] << 16); dst[2 * j + 1] = u2f(v[j] & 0xFFFF0000u); }
}
__device__ __forceinline__ int first_item(const Params& p, int rot) { int g = p.gdim; int v = (p.bid - rot) % g; return v < 0 ? v + g : v; }
__device__ __forceinline__ int proc_tile(int dir, int idx) { return dir == 0 ? idx : (idx < CT ? CT - 1 - idx : NT - 1 - (idx - CT)); }

constexpr int LT = 64;
constexpr int NLT = TS / LT, CLT = CTX / LT;
__device__ __forceinline__ int proc_ltile(int dir, int idx) { return dir == 0 ? idx : (idx < CLT ? CLT - 1 - idx : NLT - 1 - (idx - CLT)); }
constexpr int LRU_LD = 72;
constexpr int LRU_SMEM = 2 * LT * LRU_LD * 2;
template <bool FINAL, int dir>
__device__ __forceinline__ void lru_dir(int tid, const Params& p, const bf16_t* su, int b, int tile, int hh, int nt, f32x4 (&hsum)[4]) {
  const int lane = tid & 63, fr = lane & 15, fq = lane >> 4;
  const int l = p.layer;
  const int c = hh * 64 + nt * 16 + fr;
  f32x4 ar[4], ai[4];
#pragma unroll
  for (int m = 0; m < 4; ++m) { ar[m] = f32x4{0.f, 0.f, 0.f, 0.f}; ai[m] = f32x4{0.f, 0.f, 0.f, 0.f}; }
  const float* wr_ = p.a_gate_w + ((((size_t)(l * 2 + dir) * 2 + 0) * NH + hh) * 64) * 64;
  const float* wi_ = p.a_gate_w + ((((size_t)(l * 2 + dir) * 2 + 1) * NH + hh) * 64) * 64;
#pragma unroll
  for (int ks = 0; ks < 2; ++ks) {
    bf16x8 br, bi;
#pragma unroll
    for (int e = 0; e < 8; ++e) {
      int k = ks * 32 + fq * 8 + e;
      br[e] = (short)f2bf(wr_[k * 64 + nt * 16 + fr]);
      bi[e] = (short)f2bf(wi_[k * 64 + nt * 16 + fr]);
    }
#pragma unroll
    for (int m = 0; m < 4; ++m) {
      bf16x8 af = *(const bf16x8*)(su + (m * 16 + fr) * LRU_LD + ks * 32 + fq * 8);
      ar[m] = MFMA16(af, br, ar[m]);
      ai[m] = MFMA16(af, bi, ai[m]);
    }
  }
  const float b_r = p.a_gate_b[((l * 2 + dir) * 2 + 0) * MW + c], b_i = p.a_gate_b[((l * 2 + dir) * 2 + 1) * MW + c];
  const float lsl = 8.0f * logsigf_(p.a_lambda[(l * 2 + dir) * MW + c]);
#pragma unroll
  for (int m = 0; m < 4; ++m)
#pragma unroll
    for (int r = 0; r < 4; ++r) {
      int i = m * 16 + fq * 4 + r;
      float rg = fsigmoid(ar[m][r] + b_r), ig = fsigmoid(ai[m][r] + b_i);
      float la = lsl * rg;
      float uv = bf2f(su[i * LRU_LD + nt * 16 + fr]);
      float t2 = 2.0f * la;
      float om_s = -t2 * (1.0f + t2 * (0.5f + t2 * (0.16666667f + t2 * (0.041666668f + t2 * 0.0083333338f)))), om_e = 1.0f - fexp(t2);
      float om = (t2 > -0.25f) ? om_s : om_e;
      ar[m][r] = fexp(la);
      ai[m][r] = fsqrt(om) * ig * uv;
    }
  float carry = 0.f, atot = 1.f;
  if (FINAL) carry = p.lruC()[(((size_t)b * 2 + dir) * NLT + tile) * 256 + c];
#pragma unroll
  for (int mm = 0; mm < 4; ++mm) {
    const int m = dir ? 3 - mm : mm;
    float pa[4], hl[4];
    if (dir == 0) {
      pa[0] = ar[m][0]; hl[0] = ai[m][0];
#pragma unroll
      for (int r = 1; r < 4; ++r) { pa[r] = pa[r - 1] * ar[m][r]; hl[r] = ar[m][r] * hl[r - 1] + ai[m][r]; }
    } else {
      pa[3] = ar[m][3]; hl[3] = ai[m][3];
#pragma unroll
      for (int r = 2; r >= 0; --r) { pa[r] = pa[r + 1] * ar[m][r]; hl[r] = ar[m][r] * hl[r + 1] + ai[m][r]; }
    }
    const float gp = dir ? pa[0] : pa[3], gh = dir ? hl[0] : hl[3];
    float Pg[4], Hg[4];
#pragma unroll
    for (int g = 0; g < 4; ++g) { Pg[g] = SHFL(gp, fr + 16 * g); Hg[g] = SHFL(gh, fr + 16 * g); }
    float cin = carry;
#pragma unroll
    for (int gg = 0; gg < 4; ++gg) {
      const int g = dir ? 3 - gg : gg;
      bool before = dir ? (g > fq) : (g < fq);
      if (before) cin = Pg[g] * cin + Hg[g];
      carry = Pg[g] * carry + Hg[g];
      atot *= Pg[g];
    }
    if (FINAL) {
#pragma unroll
      for (int r = 0; r < 4; ++r) hsum[m][r] += hl[r] + pa[r] * cin;
    }
  }
  if (!FINAL && fq == 0) {
    float* S = p.lruS() + ((((size_t)b * 2 + dir) * NLT + tile) * 2) * 256;
    S[c] = atot; S[256 + c] = carry;
  }
}
template <bool FINAL>
__device__ __forceinline__ void phase_lru(const Params& p, char* smem_) {
  const int tid = tidx(p);
  bf16_t* su = (bf16_t*)smem_;
  bf16_t* gy = su + LT * LRU_LD;
  const int lane = tid & 63, nt = tid >> 6, fr = lane & 15, fq = lane >> 4;
  const int l = p.layer;
  for (int t = first_item(p, 0); t < NB * NLT * NH; t += p.gdim) {
    const int hh = t % NH, tile = (t / NH) % NLT, b = t / (NH * NLT);
    const int s0 = tile * LT;
    const int seg_lo = (tile < CLT) ? 0 : CTX, seg_hi = (tile < CLT) ? CTX : TS;
    __syncthreads();
    {
      const int cc = tid & 7, tg = tid >> 3;
      const int c0 = hh * 64 + cc * 8;
      float w[4][8], bias[8];
#pragma unroll
      for (int k = 0; k < 4; ++k) {
        f32x4 w0 = *(const f32x4*)(p.a_conv_w + (l * 4 + k) * MW + c0), w1 = *(const f32x4*)(p.a_conv_w + (l * 4 + k) * MW + c0 + 4);
#pragma unroll
        for (int j = 0; j < 4; ++j) { w[k][j] = w0[j]; w[k][4 + j] = w1[j]; }
      }
      {
        f32x4 b0 = *(const f32x4*)(p.a_conv_b + l * MW + c0), b1 = *(const f32x4*)(p.a_conv_b + l * MW + c0 + 4);
#pragma unroll
        for (int j = 0; j < 4; ++j) { bias[j] = b0[j]; bias[4 + j] = b1[j]; }
      }
      float win[5][8];
      const int i0 = tg * 2;
#pragma unroll
      for (int q = 0; q < 5; ++q) {
        const int sq = s0 + i0 - 2 + q;
        const bool ok = (sq >= seg_lo && sq < seg_hi);
        const int sc_ = sq < seg_lo ? seg_lo : (sq >= seg_hi ? seg_hi - 1 : sq);
        u32x4 v = *(const u32x4*)(p.P() + ((size_t)b * TS + sc_) * PW + C_AX * 256 + c0);
#pragma unroll
        for (int j = 0; j < 4; ++j) { if (!ok) v[j] = 0u; win[q][2 * j] = u2f(v[j] << 16); win[q][2 * j + 1] = u2f(v[j] & 0xFFFF0000u); }
      }
      u32x4 ga[2];
      if (FINAL) {
#pragma unroll
        for (int i = 0; i < 2; ++i) ga[i] = *(const u32x4*)(p.P() + ((size_t)b * TS + s0 + i0 + i) * PW + C_AG * 256 + c0);
      }
#pragma unroll
      for (int i = 0; i < 2; ++i) {
        float o[8];
#pragma unroll
        for (int j = 0; j < 8; ++j) o[j] = bias[j] + w[0][j] * win[i][j] + w[1][j] * win[i + 1][j] + w[2][j] * win[i + 2][j] + w[3][j] * win[i + 3][j];
        u32x4 ov; ov[0] = pack2(o[0], o[1]); ov[1] = pack2(o[2], o[3]); ov[2] = pack2(o[4], o[5]); ov[3] = pack2(o[6], o[7]);
        *(u32x4*)(su + (i0 + i) * LRU_LD + cc * 8) = ov;
        if (FINAL) {
          float g[8]; unpack8(ga[i], g);
          u32x4 gv; gv[0] = pack2(geluf_(g[0]), geluf_(g[1])); gv[1] = pack2(geluf_(g[2]), geluf_(g[3])); gv[2] = pack2(geluf_(g[4]), geluf_(g[5])); gv[3] = pack2(geluf_(g[6]), geluf_(g[7]));
          *(u32x4*)(gy + (i0 + i) * LRU_LD + cc * 8) = gv;
        }
      }
    }
    __syncthreads();
    {
      f32x4 hsum[4];
#pragma unroll
      for (int m = 0; m < 4; ++m) hsum[m] = f32x4{0.f, 0.f, 0.f, 0.f};
      lru_dir<FINAL, 0>(tid, p, su, b, tile, hh, nt, hsum);
      lru_dir<FINAL, 1>(tid, p, su, b, tile, hh, nt, hsum);
      if (FINAL) {
#pragma unroll
        for (int m = 0; m < 4; ++m)
#pragma unroll
          for (int r = 0; r < 4; ++r) {
            int i = m * 16 + fq * 4 + r;
            gy[i * LRU_LD + nt * 16 + fr] = f2bf(bf2f(gy[i * LRU_LD + nt * 16 + fr]) * hsum[m][r]);
          }
      }
    }
    if (FINAL) {
      __syncthreads();
#pragma unroll
      for (int q = 0; q < 2; ++q) {
        int ch = tid + q * 256; int i = ch >> 3, c8 = (ch & 7) * 8;
        { const u32x4 v_ = *(const u32x4*)(gy + i * LRU_LD + c8); STORE_WT16(p.y() + ((size_t)b * TS + s0 + i) * (4 * MW) + hh * 64 + c8, v_); }
      }
    }
  }
}
__device__ __forceinline__ void phase_lru_carry(const Params& p) {
  const int tid = tidx(p);
  for (int i = p.bid * 256 + tid; i < NB * 2 * 256; i += p.gdim * 256) {
    int c = i & 255, dir = (i >> 8) & 1, b = i >> 9;
    float hcar = 0.f;
    constexpr int HC = NLT / 2;
#pragma unroll 1
    for (int half = 0; half < 2; ++half) {
      float aa[HC], hh_[HC];
#pragma unroll
      for (int k = 0; k < HC; ++k) {
        size_t base = ((size_t)b * 2 + dir) * NLT + proc_ltile(dir, half * HC + k);
        aa[k] = p.lruS()[base * 512 + c]; hh_[k] = p.lruS()[base * 512 + 256 + c];
      }
#pragma unroll
      for (int k = 0; k < HC; ++k) {
        size_t base = ((size_t)b * 2 + dir) * NLT + proc_ltile(dir, half * HC + k);
        p.lruC()[base * 256 + c] = hcar;
        hcar = aa[k] * hcar + hh_[k];
      }
    }
  }
}

constexpr int LDV = 136;
__device__ __forceinline__ void load_rope_row(const Params& p, const bf16_t* src, int s, int half, float scale, float* o) {
  unpack8(*(const u32x4*)(src + half * 16), o);
  unpack8(*(const u32x4*)(src + half * 16 + 8), o + 8);
  unpack8(*(const u32x4*)(src + 32 + half * 16), o + 16);
  unpack8(*(const u32x4*)(src + 32 + half * 16 + 8), o + 24);
  if (s >= CTX) {
    const f32x4* tb = (const f32x4*)(p.rope() + ((size_t)(s - CTX) * 32 + half * 16) * 2);
#pragma unroll
    for (int i = 0; i < 8; ++i) {
      f32x4 cs = tb[i];
      float t1 = o[2 * i], t2 = o[16 + 2 * i];
      o[2 * i] = (t1 * cs[0] - t2 * cs[1]) * scale; o[16 + 2 * i] = (t1 * cs[1] + t2 * cs[0]) * scale;
      t1 = o[2 * i + 1]; t2 = o[16 + 2 * i + 1];
      o[2 * i + 1] = (t1 * cs[2] - t2 * cs[3]) * scale; o[16 + 2 * i + 1] = (t1 * cs[3] + t2 * cs[2]) * scale;
    }
  } else {
#pragma unroll
    for (int i = 0; i < 32; ++i) o[i] *= scale;
  }
}
constexpr int RETA_SMEM = 3 * 64 * LDV * 2;
__device__ __forceinline__ void phase_ret_a(const Params& p, char* smem_) {
  const int tid = tidx(p);
  bf16_t* Vt = (bf16_t*)smem_; bf16_t* Ktf = Vt + 64 * LDV; bf16_t* Ktb = Ktf + 64 * LDV;
  const int lane = tid & 63, wid = tid >> 6, fr = lane & 15, fq = lane >> 4;
  const int l = p.layer;
  for (int t = first_item(p, 64); t < NB * NH * NT; t += p.gdim) {
    const int tile = t % NT, hh = (t / NT) % NH, b = t / (NT * NH);
    const float lgf = logsigf_(p.b_theta[(l * 2 + 0) * NH + hh]) * 1.4426950408889634f;
    const float lgb = logsigf_(p.b_theta[(l * 2 + 1) * NH + hh]) * 1.4426950408889634f;
    __syncthreads();
    {
      const int j = tid >> 1, half = tid & 1;
      const int s = tile * 128 + j;
      const bf16_t* prow = p.P() + ((size_t)b * TS + s) * PW;
      float k[32];
      load_rope_row(p, prow + C_BK * 256 + hh * 64, s, half, 0.125f, k);
      const float wf = exp2f(lgf * (float)(127 - j)), wb = exp2f(lgb * (float)j);
#pragma unroll
      for (int i = 0; i < 32; ++i) {
        int d = (i < 16) ? (half * 16 + i) : (32 + half * 16 + i - 16);
        Ktf[d * LDV + j] = f2bf(k[i] * wf); Ktb[d * LDV + j] = f2bf(k[i] * wb);
      }
      float v[32];
      unpack8(*(const u32x4*)(prow + C_BV * 256 + hh * 64 + half * 32), v);
      unpack8(*(const u32x4*)(prow + C_BV * 256 + hh * 64 + half * 32 + 8), v + 8);
      unpack8(*(const u32x4*)(prow + C_BV * 256 + hh * 64 + half * 32 + 16), v + 16);
      unpack8(*(const u32x4*)(prow + C_BV * 256 + hh * 64 + half * 32 + 24), v + 24);
#pragma unroll
      for (int i = 0; i < 32; ++i) Vt[(half * 32 + i) * LDV + j] = f2bf(v[i]);
    }
    __syncthreads();
    f32x4 acc[2][4];
#pragma unroll
    for (int d = 0; d < 2; ++d)
#pragma unroll
      for (int n = 0; n < 4; ++n) acc[d][n] = f32x4{0.f, 0.f, 0.f, 0.f};
#pragma unroll
    for (int ks = 0; ks < 4; ++ks) {
      bf16x8 af = *(const bf16x8*)(Vt + (wid * 16 + fr) * LDV + ks * 32 + fq * 8);
#pragma unroll
      for (int n = 0; n < 4; ++n) {
        bf16x8 b0 = *(const bf16x8*)(Ktf + (n * 16 + fr) * LDV + ks * 32 + fq * 8);
        bf16x8 b1 = *(const bf16x8*)(Ktb + (n * 16 + fr) * LDV + ks * 32 + fq * 8);
        acc[0][n] = MFMA16(af, b0, acc[0][n]);
        acc[1][n] = MFMA16(af, b1, acc[1][n]);
      }
    }
#pragma unroll
    for (int d = 0; d < 2; ++d) {
      float* dst = p.retKV() + ((((size_t)b * NH + hh) * 2 + d) * NT + tile) * 4096;
#pragma unroll
      for (int n = 0; n < 4; ++n)
#pragma unroll
        for (int r = 0; r < 4; ++r) dst[(wid * 16 + fq * 4 + r) * 64 + n * 16 + fr] = acc[d][n][r];
    }
  }
}
__device__ __forceinline__ void phase_ret_b(const Params& p) {
  const int tid = tidx(p);
  const int l = p.layer;
  for (int i = p.bid * 256 + tid; i < NB * NH * 2 * 4096; i += p.gdim * 256) {
    int el = i & 4095, dir = (i >> 12) & 1, hh = (i >> 13) % NH, b = i / (8192 * NH);
    float g = expf(128.0f * logsigf_(p.b_theta[(l * 2 + dir) * NH + hh]));
    size_t base = (((size_t)b * NH + hh) * 2 + dir) * NT;
    float kv[NT];
#pragma unroll
    for (int k = 0; k < NT; ++k) kv[k] = p.retKV()[(base + proc_tile(dir, k)) * 4096 + el];
    float S = 0.f;
#pragma unroll
    for (int k = 0; k < NT; ++k) {
      p.retSp()[(base + proc_tile(dir, k)) * 4096 + el] = f2bf(S);
      S = g * S + kv[k];
    }
  }
}
__device__ __forceinline__ bf16x8 frag_perm8(const bf16_t* base, int fq) {
  u32x2 lo = *(const u32x2*)(base + 4 * fq), hi = *(const u32x2*)(base + 16 + 4 * fq);
  u32x4 v; v[0] = lo[0]; v[1] = lo[1]; v[2] = hi[0]; v[3] = hi[1];
  return __builtin_bit_cast(bf16x8, v);
}
__device__ __forceinline__ bf16x8 pack_frag(f32x4 a, f32x4 b) {
  u32x4 v; v[0] = pack2(a[0], a[1]); v[1] = pack2(a[2], a[3]); v[2] = pack2(b[0], b[1]); v[3] = pack2(b[2], b[3]);
  return __builtin_bit_cast(bf16x8, v);
}
constexpr int RETC_SMEM = (2 * 128 * LDT + 64 * LDV + 2 * 64 * LDT) * 2;
__device__ __forceinline__ void phase_ret_c(const Params& p, char* smem_) {
  const int tid = tidx(p);
  bf16_t* Qs = (bf16_t*)smem_; bf16_t* Ks = Qs + 128 * LDT; bf16_t* Vt = Ks + 128 * LDT;
  bf16_t* Spf = Vt + 64 * LDV; bf16_t* Spb = Spf + 64 * LDT;
  const int lane = tid & 63, wid = tid >> 6, fr = lane & 15, fq = lane >> 4;
  const int l = p.layer;
  for (int t = first_item(p, 64); t < NB * NH * NT; t += p.gdim) {
    const int tile = t % NT, hh = (t / NT) % NH, b = t / (NT * NH);
    const float lgf = logsigf_(p.b_theta[(l * 2 + 0) * NH + hh]) * 1.4426950408889634f;
    const float lgb = logsigf_(p.b_theta[(l * 2 + 1) * NH + hh]) * 1.4426950408889634f;
    __syncthreads();
    {
      const int j = tid >> 1, half = tid & 1;
      const int s = tile * 128 + j;
      const bf16_t* prow = p.P() + ((size_t)b * TS + s) * PW;
      float k[32];
      load_rope_row(p, prow + C_BQ * 256 + hh * 64, s, half, 1.0f, k);
#pragma unroll
      for (int c = 0; c < 4; ++c) {
        u32x4 v; v[0] = pack2(k[c * 8 + 0], k[c * 8 + 1]); v[1] = pack2(k[c * 8 + 2], k[c * 8 + 3]); v[2] = pack2(k[c * 8 + 4], k[c * 8 + 5]); v[3] = pack2(k[c * 8 + 6], k[c * 8 + 7]);
        int d0 = (c < 2) ? (half * 16 + c * 8) : (32 + half * 16 + (c - 2) * 8);
        *(u32x4*)(Qs + j * LDT + d0) = v;
      }
      load_rope_row(p, prow + C_BK * 256 + hh * 64, s, half, 0.125f, k);
#pragma unroll
      for (int c = 0; c < 4; ++c) {
        u32x4 v; v[0] = pack2(k[c * 8 + 0], k[c * 8 + 1]); v[1] = pack2(k[c * 8 + 2], k[c * 8 + 3]); v[2] = pack2(k[c * 8 + 4], k[c * 8 + 5]); v[3] = pack2(k[c * 8 + 6], k[c * 8 + 7]);
        int d0 = (c < 2) ? (half * 16 + c * 8) : (32 + half * 16 + (c - 2) * 8);
        *(u32x4*)(Ks + j * LDT + d0) = v;
      }
#pragma unroll
      for (int c = 0; c < 4; ++c) {
        u32x4 v = *(const u32x4*)(prow + C_BV * 256 + hh * 64 + half * 32 + c * 8);
#pragma unroll
        for (int q = 0; q < 4; ++q) {
          Vt[(half * 32 + c * 8 + 2 * q) * LDV + j] = (bf16_t)(v[q] & 0xFFFFu);
          Vt[(half * 32 + c * 8 + 2 * q + 1) * LDV + j] = (bf16_t)(v[q] >> 16);
        }
      }
      const bf16_t* spf = p.retSp() + ((((size_t)b * NH + hh) * 2 + 0) * NT + tile) * 4096;
      const bf16_t* spb = p.retSp() + ((((size_t)b * NH + hh) * 2 + 1) * NT + tile) * 4096;
#pragma unroll
      for (int i = 0; i < 2; ++i) {
        int c = tid + i * 256; int e = c >> 3, d0 = (c & 7) * 8;
        *(u32x4*)(Spf + e * LDT + d0) = *(const u32x4*)(spf + e * 64 + d0);
        *(u32x4*)(Spb + e * LDT + d0) = *(const u32x4*)(spb + e * 64 + d0);
      }
    }
    __syncthreads();
#pragma unroll 1
    for (int mi = 0; mi < 2; ++mi) {
      NO_HOIST();
      const int i = wid * 32 + mi * 16 + fr;
      f32x4 sc[8];
#pragma unroll
      for (int nj = 0; nj < 8; ++nj) sc[nj] = f32x4{0.f, 0.f, 0.f, 0.f};
      f32x4 ao[4], af_[4], ab_[4];
#pragma unroll
      for (int n = 0; n < 4; ++n) { ao[n] = f32x4{0.f, 0.f, 0.f, 0.f}; af_[n] = ao[n]; ab_[n] = ao[n]; }
#pragma unroll
      for (int ks = 0; ks < 2; ++ks) {
        bf16x8 qf = *(const bf16x8*)(Qs + i * LDT + ks * 32 + fq * 8);
#pragma unroll
        for (int nj = 0; nj < 8; ++nj) {
          bf16x8 kf = *(const bf16x8*)(Ks + (nj * 16 + fr) * LDT + ks * 32 + fq * 8);
          sc[nj] = MFMA16(kf, qf, sc[nj]);
        }
#pragma unroll
        for (int n = 0; n < 4; ++n) {
          bf16x8 s0 = *(const bf16x8*)(Spf + (n * 16 + fr) * LDT + ks * 32 + fq * 8);
          bf16x8 s1 = *(const bf16x8*)(Spb + (n * 16 + fr) * LDT + ks * 32 + fq * 8);
          af_[n] = MFMA16(s0, qf, af_[n]); ab_[n] = MFMA16(s1, qf, ab_[n]);
        }
      }
#pragma unroll
      for (int nj = 0; nj < 8; ++nj)
#pragma unroll
        for (int r = 0; r < 4; ++r) {
          int j = nj * 16 + fq * 4 + r;
          float fd = (float)(i - j);
          sc[nj][r] *= fexp2(fminf(lgf * fd, -lgb * fd));
        }
#pragma unroll
      for (int ks = 0; ks < 4; ++ks) {
        bf16x8 sf = pack_frag(sc[2 * ks], sc[2 * ks + 1]);
#pragma unroll
        for (int n = 0; n < 4; ++n) {
          bf16x8 vf = frag_perm8(Vt + (n * 16 + fr) * LDV + ks * 32, fq);
          ao[n] = MFMA16(vf, sf, ao[n]);
        }
      }
      const float sfw = fexp2(lgf * (float)(i + 1)), sbw = fexp2(lgb * (float)(128 - i));
      float o[4][4]; float sum = 0.f;
#pragma unroll
      for (int n = 0; n < 4; ++n)
#pragma unroll
        for (int r = 0; r < 4; ++r) { o[n][r] = ao[n][r] + sfw * af_[n][r] + sbw * ab_[n][r]; sum += o[n][r]; }
      sum += SHFL_XOR(sum, 16); sum += SHFL_XOR(sum, 32);
      const float mean = sum * (1.0f / 64.0f);
      float var = 0.f;
#pragma unroll
      for (int n = 0; n < 4; ++n)
#pragma unroll
        for (int r = 0; r < 4; ++r) { o[n][r] -= mean; var += o[n][r] * o[n][r]; }
      var += SHFL_XOR(var, 16); var += SHFL_XOR(var, 32);
      const float rs = rsqrtf(var * (1.0f / 64.0f) + EPS);
      const size_t row = (size_t)b * TS + tile * 128 + i;
#pragma unroll
      for (int n = 0; n < 4; ++n) {
        int e = n * 16 + fq * 4;
        u32x2 gv = *(const u32x2*)(p.P() + row * PW + C_BG * 256 + hh * 64 + e);
        float g0 = u2f(gv[0] << 16), g1 = u2f(gv[0] & 0xFFFF0000u), g2 = u2f(gv[1] << 16), g3 = u2f(gv[1] & 0xFFFF0000u);
        u32x2 ov; ov[0] = pack2(o[n][0] * rs * fsilu(g0), o[n][1] * rs * fsilu(g1)); ov[1] = pack2(o[n][2] * rs * fsilu(g2), o[n][3] * rs * fsilu(g3));
        STORE_WT8(p.y() + row * (4 * MW) + 1 * MW + hh * 64 + e, ov);
      }
    }
  }
}

__device__ __forceinline__ void conv_silu8(const Params& p, int b, int s, int seg_lo, int seg_hi, int cb, int cw, int ch0, float scale, float* o) {
  const int l = p.layer;
  {
    f32x4 b0 = *(const f32x4*)(p.c_conv_b + l * 512 + cw + ch0), b1 = *(const f32x4*)(p.c_conv_b + l * 512 + cw + ch0 + 4);
#pragma unroll
    for (int j = 0; j < 4; ++j) { o[j] = b0[j]; o[4 + j] = b1[j]; }
  }
#pragma unroll
  for (int k = 0; k < 4; ++k) {
    int sk = s + k - 2;
    const float msk = (sk >= seg_lo && sk < seg_hi) ? 1.0f : 0.0f;
    const int skc = sk < seg_lo ? seg_lo : (sk >= seg_hi ? seg_hi - 1 : sk);
    {
      float v[8]; unpack8(*(const u32x4*)(p.P() + ((size_t)b * TS + skc) * PW + cb * 256 + ch0), v);
      const float* w = p.c_conv_w + (size_t)(l * 4 + k) * 512 + cw + ch0;
      f32x4 w0 = *(const f32x4*)w * msk, w1 = *(const f32x4*)(w + 4) * msk;
#pragma unroll
      for (int j = 0; j < 4; ++j) { o[j] += w0[j] * v[j]; o[4 + j] += w1[j] * v[4 + j]; }
    }
  }
#pragma unroll
  for (int j = 0; j < 8; ++j) o[j] = fsilu(o[j]) * scale;
}
__device__ __forceinline__ void mls_gates(int tid, const Params& p, int b, int tile, int hh, float* cumf, float* cumb, float* lif, float* lib) {
  const int tdx = tid;
  {
    int i = tdx & 127; const float* g = p.cg() + ((size_t)b * TS + tile * 128 + i) * 16;
    if (tdx < 128) { lif[i] = g[0 * 4 + hh]; cumf[i] = logsigf_(g[1 * 4 + hh]); }
    else { lib[i] = g[2 * 4 + hh]; cumb[i] = logsigf_(g[3 * 4 + hh]); }
  }
  __syncthreads();
  for (int off = 1; off < 128; off <<= 1) {
    float v = 0.f; int i = tdx & 127;
    if (tdx < 128) { if (i >= off) v = cumf[i - off]; } else { if (i + off < 128) v = cumb[i + off]; }
    __syncthreads();
    if (tdx < 128) cumf[i] += v; else cumb[i] += v;
    __syncthreads();
  }
}
constexpr int MLSA_SMEM = (80 * LDV + 2 * 64 * LDV) * 2 + 4 * 128 * 4;
__device__ __forceinline__ void phase_mls_a(const Params& p, char* smem_) {
  const int tid = tidx(p);
  bf16_t* Vt = (bf16_t*)smem_; bf16_t* Ktf = Vt + 80 * LDV; bf16_t* Ktb = Ktf + 64 * LDV;
  float* cumf = (float*)(Ktb + 64 * LDV); float* cumb = cumf + 128; float* lif = cumb + 128; float* lib = lif + 128;
  const int lane = tid & 63, wid = tid >> 6, fr = lane & 15, fq = lane >> 4;
  for (int t = first_item(p, 96); t < NB * NH * NT; t += p.gdim) {
    const int tile = t % NT, hh = (t / NT) % NH, b = t / (NT * NH);
    const int seg_lo = (tile < CT) ? 0 : CTX, seg_hi = (tile < CT) ? CTX : TS;
    __syncthreads();
    mls_gates(tid, p, b, tile, hh, cumf, cumb, lif, lib);
    {
      const int j = tid >> 1, half = tid & 1;
      const int s = tile * 128 + j;
      const float wf = expf(cumf[127] - cumf[j] + lif[j]), wb = expf(cumb[0] - cumb[j] + lib[j]);
#pragma unroll 1
      for (int c = 0; c < 4; ++c) {
        NO_HOIST();
        float k[8];
        conv_silu8(p, b, s, seg_lo, seg_hi, C_CK, 256, hh * 64 + half * 32 + c * 8, 0.125f, k);
#pragma unroll
        for (int i = 0; i < 8; ++i) { Ktf[(half * 32 + c * 8 + i) * LDV + j] = f2bf(k[i] * wf); Ktb[(half * 32 + c * 8 + i) * LDV + j] = f2bf(k[i] * wb); }
      }
      const bf16_t* prow = p.P() + ((size_t)b * TS + s) * PW + C_CV * 256 + hh * 64 + half * 32;
#pragma unroll
      for (int c = 0; c < 4; ++c) {
        u32x4 v = *(const u32x4*)(prow + c * 8);
#pragma unroll
        for (int q = 0; q < 4; ++q) {
          Vt[(half * 32 + c * 8 + 2 * q) * LDV + j] = (bf16_t)(v[q] & 0xFFFFu);
          Vt[(half * 32 + c * 8 + 2 * q + 1) * LDV + j] = (bf16_t)(v[q] >> 16);
        }
      }
#pragma unroll
      for (int e = 0; e < 8; ++e) Vt[(64 + half * 8 + e) * LDV + j] = (half == 0 && e == 0) ? (bf16_t)0x3F80 : (bf16_t)0;
    }
    __syncthreads();
    for (int mt = wid; mt < 5; mt += 4) {
      f32x4 acc[2][4];
#pragma unroll
      for (int d = 0; d < 2; ++d)
#pragma unroll
        for (int n = 0; n < 4; ++n) acc[d][n] = f32x4{0.f, 0.f, 0.f, 0.f};
#pragma unroll
      for (int ks = 0; ks < 4; ++ks) {
        bf16x8 af = *(const bf16x8*)(Vt + (mt * 16 + fr) * LDV + ks * 32 + fq * 8);
#pragma unroll
        for (int n = 0; n < 4; ++n) {
          bf16x8 b0 = *(const bf16x8*)(Ktf + (n * 16 + fr) * LDV + ks * 32 + fq * 8);
          bf16x8 b1 = *(const bf16x8*)(Ktb + (n * 16 + fr) * LDV + ks * 32 + fq * 8);
          acc[0][n] = MFMA16(af, b0, acc[0][n]);
          acc[1][n] = MFMA16(af, b1, acc[1][n]);
        }
      }
#pragma unroll
      for (int d = 0; d < 2; ++d) {
        float* dst = p.mlC() + ((((size_t)b * NH + hh) * 2 + d) * NT + tile) * (80 * 64);
#pragma unroll
        for (int n = 0; n < 4; ++n)
#pragma unroll
          for (int r = 0; r < 4; ++r) dst[(mt * 16 + fq * 4 + r) * 64 + n * 16 + fr] = acc[d][n][r];
      }
    }
    if (tid < 2) p.mlCe()[(((size_t)b * NH + hh) * 2 + tid) * NT + tile] = tid ? cumb[0] : cumf[127];
  }
}
__device__ __forceinline__ void phase_mls_b(const Params& p) {
  const int tid = tidx(p);
  const int NE = 80 * 64, NU = 65 * 64;
  for (int i = p.bid * 256 + tid; i < NB * NH * 2 * NE; i += p.gdim * 256) {
    int el = i % NE, chain = i / NE;
    int dir = chain & 1;
    size_t base = (size_t)chain * NT;
    if (el >= NU) {
#pragma unroll
      for (int k = 0; k < NT; ++k) p.mlSp()[(base + k) * NE + el] = 0;
      continue;
    }
    float kv[NT], ce[NT];
#pragma unroll
    for (int k = 0; k < NT; ++k) { int tile = proc_tile(dir, k); kv[k] = p.mlC()[(base + tile) * NE + el]; ce[k] = p.mlCe()[base + tile]; }
    float S = 0.f;
#pragma unroll
    for (int k = 0; k < NT; ++k) {
      p.mlSp()[(base + proc_tile(dir, k)) * NE + el] = f2bf(S);
      S = expf(ce[k]) * S + kv[k];
    }
  }
}
constexpr int MLSC_SMEM = (2 * 128 * LDT + 64 * LDV + 2 * 80 * LDT) * 2 + 4 * 128 * 4;
__device__ __forceinline__ void phase_mls_c(const Params& p, char* smem_) {
  const int tid = tidx(p);
  bf16_t* Qs = (bf16_t*)smem_; bf16_t* Ks = Qs + 128 * LDT; bf16_t* Vt = Ks + 128 * LDT;
  bf16_t* Cpf = Vt + 64 * LDV; bf16_t* Cpb = Cpf + 80 * LDT;
  float* cumf = (float*)(Cpb + 80 * LDT); float* cumb = cumf + 128; float* lif = cumb + 128; float* lib = lif + 128;
  const int lane = tid & 63, wid = tid >> 6, fr = lane & 15, fq = lane >> 4;
  for (int t = first_item(p, 96); t < NB * NH * NT; t += p.gdim) {
    const int tile = t % NT, hh = (t / NT) % NH, b = t / (NT * NH);
    const int seg_lo = (tile < CT) ? 0 : CTX, seg_hi = (tile < CT) ? CTX : TS;
    __syncthreads();
    mls_gates(tid, p, b, tile, hh, cumf, cumb, lif, lib);
    if (tid < 128) lif[tid] -= cumf[tid]; else lib[tid - 128] -= cumb[tid - 128];
    {
      const int j = tid >> 1, half = tid & 1;
      const int s = tile * 128 + j;
#pragma unroll 1
      for (int c = 0; c < 8; ++c) {
        NO_HOIST();
        const int isk = c >> 2, cc = c & 3;
        float k[8];
        conv_silu8(p, b, s, seg_lo, seg_hi, isk ? C_CK : C_CQ, isk ? 256 : 0, hh * 64 + half * 32 + cc * 8, isk ? 0.125f : 1.0f, k);
        u32x4 v; v[0] = pack2(k[0], k[1]); v[1] = pack2(k[2], k[3]); v[2] = pack2(k[4], k[5]); v[3] = pack2(k[6], k[7]);
        *(u32x4*)((isk ? Ks : Qs) + j * LDT + half * 32 + cc * 8) = v;
      }
      const bf16_t* prow = p.P() + ((size_t)b * TS + s) * PW + C_CV * 256 + hh * 64 + half * 32;
#pragma unroll
      for (int c = 0; c < 4; ++c) {
        u32x4 v = *(const u32x4*)(prow + c * 8);
#pragma unroll
        for (int q = 0; q < 4; ++q) {
          Vt[(half * 32 + c * 8 + 2 * q) * LDV + j] = (bf16_t)(v[q] & 0xFFFFu);
          Vt[(half * 32 + c * 8 + 2 * q + 1) * LDV + j] = (bf16_t)(v[q] >> 16);
        }
      }
      const bf16_t* spf = p.mlSp() + ((((size_t)b * NH + hh) * 2 + 0) * NT + tile) * (80 * 64);
      const bf16_t* spb = p.mlSp() + ((((size_t)b * NH + hh) * 2 + 1) * NT + tile) * (80 * 64);
      for (int c = tid; c < 80 * 8; c += 256) {
        int e = c >> 3, d0 = (c & 7) * 8;
        *(u32x4*)(Cpf + e * LDT + d0) = *(const u32x4*)(spf + e * 64 + d0);
        *(u32x4*)(Cpb + e * LDT + d0) = *(const u32x4*)(spb + e * 64 + d0);
      }
    }
    __syncthreads();
#pragma unroll 1
    for (int mi = 0; mi < 2; ++mi) {
      NO_HOIST();
      const int i = wid * 32 + mi * 16 + fr;
      f32x4 sc[8];
#pragma unroll
      for (int nj = 0; nj < 8; ++nj) sc[nj] = f32x4{0.f, 0.f, 0.f, 0.f};
#pragma unroll
      for (int ks = 0; ks < 2; ++ks) {
        bf16x8 qf = *(const bf16x8*)(Qs + i * LDT + ks * 32 + fq * 8);
#pragma unroll
        for (int nj = 0; nj < 8; ++nj) {
          bf16x8 kf = *(const bf16x8*)(Ks + (nj * 16 + fr) * LDT + ks * 32 + fq * 8);
          sc[nj] = MFMA16(kf, qf, sc[nj]);
        }
      }
      float hsum[4][4];
#pragma unroll
      for (int n = 0; n < 4; ++n)
#pragma unroll
        for (int r = 0; r < 4; ++r) hsum[n][r] = 0.f;
#pragma unroll 1
      for (int dir = 0; dir < 2; ++dir) {
        NO_HOIST();
        const float* cum = dir ? cumb : cumf; const float* li = dir ? lib : lif; const bf16_t* Cp = dir ? Cpb : Cpf;
        const float ci = cum[i];
        f32x4 sd[8]; float dsum = 0.f;
#pragma unroll
        for (int nj = 0; nj < 8; ++nj)
#pragma unroll
          for (int r = 0; r < 4; ++r) {
            int j = nj * 16 + fq * 4 + r;
            int dd = dir ? (j - i) : (i - j);
            float v = sc[nj][r] * fexp(ci + li[j] + u2f((unsigned)(dd >> 31) & 0xF149F2CAu));
            sd[nj][r] = v; dsum += v;
          }
        dsum += SHFL_XOR(dsum, 16); dsum += SHFL_XOR(dsum, 32);
        f32x4 an[4];
#pragma unroll
        for (int n = 0; n < 4; ++n) an[n] = f32x4{0.f, 0.f, 0.f, 0.f};
#pragma unroll
        for (int ks = 0; ks < 4; ++ks) {
          bf16x8 sf = pack_frag(sd[2 * ks], sd[2 * ks + 1]);
#pragma unroll
          for (int n = 0; n < 4; ++n) {
            bf16x8 vf = frag_perm8(Vt + (n * 16 + fr) * LDV + ks * 32, fq);
            an[n] = MFMA16(vf, sf, an[n]);
          }
        }
        f32x4 ai[5];
#pragma unroll
        for (int n = 0; n < 5; ++n) ai[n] = f32x4{0.f, 0.f, 0.f, 0.f};
#pragma unroll
        for (int ks = 0; ks < 2; ++ks) {
          bf16x8 qf = *(const bf16x8*)(Qs + i * LDT + ks * 32 + fq * 8);
#pragma unroll
          for (int n = 0; n < 5; ++n) {
            bf16x8 cf = *(const bf16x8*)(Cp + (n * 16 + fr) * LDT + ks * 32 + fq * 8);
            ai[n] = MFMA16(cf, qf, ai[n]);
          }
        }
        const float ec = fexp(ci);
        float dinter = ai[4][0];
        dinter = SHFL(dinter, fr);
        const float den = dsum + ec * dinter;
        const float inv = 1.0f / fmaxf(fabsf(den), 1.0f);
#pragma unroll
        for (int n = 0; n < 4; ++n)
#pragma unroll
          for (int r = 0; r < 4; ++r) {
            float hv = (an[n][r] + ec * ai[n][r]) * inv;
            hsum[n][r] += hv;
          }
      }
      float sum = 0.f;
#pragma unroll
      for (int n = 0; n < 4; ++n)
#pragma unroll
        for (int r = 0; r < 4; ++r) sum += hsum[n][r];
      sum += SHFL_XOR(sum, 16); sum += SHFL_XOR(sum, 32);
      const float mean = sum * (1.0f / 64.0f);
      float var = 0.f;
#pragma unroll
      for (int n = 0; n < 4; ++n)
#pragma unroll
        for (int r = 0; r < 4; ++r) { hsum[n][r] -= mean; var += hsum[n][r] * hsum[n][r]; }
      var += SHFL_XOR(var, 16); var += SHFL_XOR(var, 32);
      const float rs = rsqrtf(var * (1.0f / 64.0f) + EPS);
      const size_t row = (size_t)b * TS + tile * 128 + i;
#pragma unroll
      for (int n = 0; n < 4; ++n) {
        int e = n * 16 + fq * 4;
        u32x2 gv = *(const u32x2*)(p.P() + row * PW + C_CO * 256 + hh * 64 + e);
        float g0 = u2f(gv[0] << 16), g1 = u2f(gv[0] & 0xFFFF0000u), g2 = u2f(gv[1] << 16), g3 = u2f(gv[1] & 0xFFFF0000u);
        u32x2 ov; ov[0] = pack2(hsum[n][0] * rs * fsigmoid(g0), hsum[n][1] * rs * fsigmoid(g1));
        ov[1] = pack2(hsum[n][2] * rs * fsigmoid(g2), hsum[n][3] * rs * fsigmoid(g3));
        STORE_WT8(p.y() + row * (4 * MW) + 2 * MW + hh * 64 + e, ov);
      }
    }
  }
}

constexpr int GL_OLD = 68;
constexpr int GL_TLD = 24;
constexpr int GL_DIRB = 16 * GL_OLD * 4 + 2 * 64 * GL_TLD * 2 + 2 * 16 * LDT * 2 + 64 * GL_TLD * 2 + 3 * 64 * 4;
constexpr int GLA_SMEM = 128 * GL_OLD * 4 + 2 * GL_DIRB;
template <bool FINAL>
__device__ __forceinline__ void phase_gla(const Params& p, char* smem_) {
  const int tid = tidx(p);
  float* oacc = (float*)smem_;
  char* dbase = smem_ + 128 * GL_OLD * 4;
  const int lane = tid & 63, wid = tid >> 6, fr = lane & 15, fq = lane >> 4;
  const int l = p.layer;
  const int pi = tid >> 4, pc4 = (tid & 15) * 4;
  for (int t = first_item(p, 128); t < NB * NH * NT; t += p.gdim) {
    const int tile = t % NT, hh = (t / NT) % NH, b = t / (NT * NH);
    float lb4[4];
#pragma unroll
    for (int j = 0; j < 4; ++j) {
      int c = hh * 64 + pc4 + j;
      float mx = -3.0e38f;
      for (int q = 0; q < DEPTH; ++q) mx = fmaxf(mx, p.d_lb[q * MW + c]);
      float den = 0.f, num = 0.f;
      for (int q = 0; q < DEPTH; ++q) { float e = expf(p.d_lb[q * MW + c] - mx); den += e; if (q >= 1 && q <= l) num += e; }
      lb4[j] = num / den;
    }
    __syncthreads();
    f32x4 S[2][4];
    u32x2 rq[2], rf[2], rv[2];
#pragma unroll
    for (int dir = 0; dir < 2; ++dir) {
      const size_t chain = (((size_t)b * NH + hh) * 2 + dir) * NT + tile;
#pragma unroll
      for (int mt = 0; mt < 4; ++mt)
#pragma unroll
        for (int r = 0; r < 4; ++r) S[dir][mt][r] = FINAL ? p.glSp()[chain * 4096 + (mt * 16 + fq * 4 + r) * 64 + wid * 16 + fr] : 0.f;
      float* Et = (float*)(dbase + dir * GL_DIRB + GL_DIRB - 64 * 4);
      if (tid < 64) Et[tid] = 1.0f;
    }
    auto gload = [&](int dir, int k) {
      int sc_ = dir ? 7 - k : k; int i = dir ? 15 - pi : pi;
      const bf16_t* prow = p.P() + ((size_t)b * TS + tile * 128 + sc_ * 16 + i) * PW + hh * 64 + pc4;
      rq[dir] = *(const u32x2*)(prow + C_DQ * 256); rf[dir] = *(const u32x2*)(prow + (dir ? C_DFB : C_DFF) * 256); rv[dir] = *(const u32x2*)(prow + C_DI * 256);
    };
    gload(0, 0); gload(1, 0);
#pragma unroll 1
    for (int k = 0; k < 8; ++k) {
      float kk4[2][4], qq4[2][4];
#pragma unroll
      for (int dir = 0; dir < 2; ++dir) {
        float* lgf = (float*)(dbase + dir * GL_DIRB);
        bf16_t* vT = (bf16_t*)(lgf + 16 * GL_OLD) + (k & 1) * 64 * GL_TLD;
        float zq[4] = {u2f(rq[dir][0] << 16), u2f(rq[dir][0] & 0xFFFF0000u), u2f(rq[dir][1] << 16), u2f(rq[dir][1] & 0xFFFF0000u)};
        float zf[4] = {u2f(rf[dir][0] << 16), u2f(rf[dir][0] & 0xFFFF0000u), u2f(rf[dir][1] << 16), u2f(rf[dir][1] & 0xFFFF0000u)};
        f32x4 lg;
#pragma unroll
        for (int j = 0; j < 4; ++j) {
          float f = lb4[j] + (1.0f - lb4[j]) * fsigmoid(zf[j]);
          lg[j] = flog(f); kk4[dir][j] = 1.0f - f; qq4[dir][j] = fsilu(zq[j]);
        }
        *(f32x4*)(lgf + pi * GL_OLD + pc4) = lg;
        vT[(pc4 + 0) * GL_TLD + pi] = (bf16_t)(rv[dir][0] & 0xFFFFu); vT[(pc4 + 1) * GL_TLD + pi] = (bf16_t)(rv[dir][0] >> 16);
        vT[(pc4 + 2) * GL_TLD + pi] = (bf16_t)(rv[dir][1] & 0xFFFFu); vT[(pc4 + 3) * GL_TLD + pi] = (bf16_t)(rv[dir][1] >> 16);
      }
      if (k + 1 < 8) { gload(0, k + 1); gload(1, k + 1); }
      __syncthreads();
#pragma unroll
      for (int dir = 0; dir < 2; ++dir) {
        float* lgf = (float*)(dbase + dir * GL_DIRB);
        bf16_t* qe = (bf16_t*)(lgf + 16 * GL_OLD) + 2 * 64 * GL_TLD; bf16_t* ki = qe + 16 * LDT; bf16_t* kdT = ki + 16 * LDT;
        float* Ec = (float*)(kdT + 64 * GL_TLD); float* Em = Ec + 64; float* Et = Em + 64;
        f32x4 cs = {0.f, 0.f, 0.f, 0.f}, ce = cs, cm = cs;
#pragma unroll
        for (int q = 0; q < 16; ++q) {
          f32x4 v = *(const f32x4*)(lgf + q * GL_OLD + pc4);
          ce += v; if (q <= pi) cs += v; if (q < 8) cm += v;
        }
        float a[4], bb[4];
#pragma unroll
        for (int j = 0; j < 4; ++j) {
          a[j] = qq4[dir][j] * fexp(cs[j] - cm[j]); bb[j] = kk4[dir][j] * fexp(cm[j] - cs[j]);
          kdT[(pc4 + j) * GL_TLD + pi] = f2bf(kk4[dir][j] * fexp(ce[j] - cs[j]));
        }
        u32x2 av; av[0] = pack2(a[0], a[1]); av[1] = pack2(a[2], a[3]);
        u32x2 bv; bv[0] = pack2(bb[0], bb[1]); bv[1] = pack2(bb[2], bb[3]);
        *(u32x2*)(qe + pi * LDT + pc4) = av; *(u32x2*)(ki + pi * LDT + pc4) = bv;
        if (pi == 0) {
#pragma unroll
          for (int j = 0; j < 4; ++j) { float e = fexp(ce[j]); Ec[pc4 + j] = e; Em[pc4 + j] = fexp(cm[j]); Et[pc4 + j] *= e; }
        }
      }
      __syncthreads();
      const u32x4 zero4 = {0u, 0u, 0u, 0u};
#pragma unroll
      for (int dir = 0; dir < 2; ++dir) {
        const int sc_ = dir ? 7 - k : k;
        float* lgf = (float*)(dbase + dir * GL_DIRB);
        bf16_t* vT = (bf16_t*)(lgf + 16 * GL_OLD) + (k & 1) * 64 * GL_TLD;
        bf16_t* qe = (bf16_t*)(lgf + 16 * GL_OLD) + 2 * 64 * GL_TLD; bf16_t* ki = qe + 16 * LDT; bf16_t* kdT = ki + 16 * LDT;
        float* Ec = (float*)(kdT + 64 * GL_TLD); float* Em = Ec + 64;
        if (FINAL) {
          f32x4 sct = {0.f, 0.f, 0.f, 0.f}, oT = {0.f, 0.f, 0.f, 0.f};
#pragma unroll
          for (int ks = 0; ks < 2; ++ks) {
            bf16x8 kf = *(const bf16x8*)(ki + fr * LDT + ks * 32 + fq * 8);
            bf16x8 qf = *(const bf16x8*)(qe + fr * LDT + ks * 32 + fq * 8);
            sct = MFMA16(kf, qf, sct);
            f32x4 e0 = *(const f32x4*)(Em + (2 * ks) * 16 + fq * 4), e1 = *(const f32x4*)(Em + (2 * ks + 1) * 16 + fq * 4);
            f32x4 s0 = S[dir][2 * ks] * e0, s1 = S[dir][2 * ks + 1] * e1;
            bf16x8 sf = pack_frag(s0, s1);
            bf16x8 qp = frag_perm8(qe + fr * LDT + ks * 32, fq);
            oT = MFMA16(sf, qp, oT);
          }
#pragma unroll
          for (int r = 0; r < 4; ++r) if (fq * 4 + r > fr) sct[r] = 0.f;
          {
            u32x4 bs = zero4; bs[0] = pack2(sct[0], sct[1]); bs[1] = pack2(sct[2], sct[3]);
            u32x2 va = *(const u32x2*)(vT + (wid * 16 + fr) * GL_TLD + fq * 4);
            u32x4 as = zero4; as[0] = va[0]; as[1] = va[1];
            oT = MFMA16(__builtin_bit_cast(bf16x8, as), __builtin_bit_cast(bf16x8, bs), oT);
          }
          const int tok = sc_ * 16 + (dir ? 15 - fr : fr);
          float* od = oacc + tok * GL_OLD + wid * 16 + fq * 4;
          const bool first = dir ? (sc_ >= 4) : (sc_ < 4);
          if (first) *(f32x4*)od = oT; else { f32x4 prev = *(const f32x4*)od; *(f32x4*)od = prev + oT; }
        }
        {
          u32x4 bsrc = (fq < 2) ? *(const u32x4*)(vT + (wid * 16 + fr) * GL_TLD + fq * 8) : zero4;
          bf16x8 bf_ = __builtin_bit_cast(bf16x8, bsrc);
#pragma unroll
          for (int mt = 0; mt < 4; ++mt) {
            f32x4 e4 = *(const f32x4*)(Ec + mt * 16 + fq * 4);
            u32x4 asrc = (fq < 2) ? *(const u32x4*)(kdT + (mt * 16 + fr) * GL_TLD + fq * 8) : zero4;
            S[dir][mt] = MFMA16(__builtin_bit_cast(bf16x8, asrc), bf_, S[dir][mt] * e4);
          }
        }
      }
    }
    __syncthreads();
    if (!FINAL) {
#pragma unroll
      for (int dir = 0; dir < 2; ++dir) {
        const size_t chain = (((size_t)b * NH + hh) * 2 + dir) * NT + tile;
        const float* Et = (const float*)(dbase + dir * GL_DIRB + GL_DIRB - 64 * 4);
#pragma unroll
        for (int mt = 0; mt < 4; ++mt)
#pragma unroll
          for (int r = 0; r < 4; ++r) p.glKV()[chain * 4096 + (mt * 16 + fq * 4 + r) * 64 + wid * 16 + fr] = S[dir][mt][r];
        if (tid < 64) p.glE()[chain * 64 + tid] = Et[tid];
      }
    }
    if (FINAL) {
      const int row = tid >> 1, half = tid & 1;
      float ss = 0.f;
#pragma unroll
      for (int e = 0; e < 32; e += 4) { f32x4 v = *(const f32x4*)(oacc + row * GL_OLD + half * 32 + e); ss += v[0] * v[0] + v[1] * v[1] + v[2] * v[2] + v[3] * v[3]; }
      ss += SHFL_XOR(ss, 1);
      const float rs = rsqrtf(ss * (1.0f / 64.0f) + EPS);
      const size_t grow = (size_t)b * TS + tile * 128 + row;
#pragma unroll
      for (int c = 0; c < 4; ++c) {
        float g[8]; unpack8(*(const u32x4*)(p.P() + grow * PW + C_DG * 256 + hh * 64 + half * 32 + c * 8), g);
        f32x4 o0 = *(const f32x4*)(oacc + row * GL_OLD + half * 32 + c * 8), o1 = *(const f32x4*)(oacc + row * GL_OLD + half * 32 + c * 8 + 4);
        u32x4 ov;
        ov[0] = pack2(o0[0] * rs * fsilu(g[0]), o0[1] * rs * fsilu(g[1])); ov[1] = pack2(o0[2] * rs * fsilu(g[2]), o0[3] * rs * fsilu(g[3]));
        ov[2] = pack2(o1[0] * rs * fsilu(g[4]), o1[1] * rs * fsilu(g[5])); ov[3] = pack2(o1[2] * rs * fsilu(g[6]), o1[3] * rs * fsilu(g[7]));
        STORE_WT16(p.y() + grow * (4 * MW) + 3 * MW + hh * 64 + half * 32 + c * 8, ov);
      }
    }
  }
}
__device__ __forceinline__ void phase_gla_b(const Params& p) {
  const int tid = tidx(p);
  for (int i = p.bid * 256 + tid; i < NB * NH * 2 * 4096; i += p.gdim * 256) {
    int el = i & 4095, chain = i >> 12; int dir = chain & 1; int c = el >> 6;
    size_t base = (size_t)chain * NT;
    float kv[NT], ee[NT];
#pragma unroll
    for (int k = 0; k < NT; ++k) { int tile = proc_tile(dir, k); kv[k] = p.glKV()[(base + tile) * 4096 + el]; ee[k] = p.glE()[(base + tile) * 64 + c]; }
    float S = 0.f;
#pragma unroll
    for (int k = 0; k < NT; ++k) {
      p.glSp()[(base + proc_tile(dir, k)) * 4096 + el] = S;
      S = ee[k] * S + kv[k];
    }
  }
}


constexpr int MRG_SMEM = GEMM_SMEM;
__device__ __forceinline__ void phase_merge(const Params& p, char* smem_) {
  const int tid = tidx(p);
  bf16_t* smem = (bf16_t*)smem_;
  char* sb = (char*)smem_;
  const int lane = tid & 63, wid = tid >> 6, wr = wid >> 1, wc = wid & 1, fr = lane & 15, fq = lane >> 4;
  const bool last = (p.layer == DEPTH - 1);
  constexpr int SG = D / 32, SY = MW / 32, SB = SG + SY, NSTEP = 4 * SB;
  const int ntn = D / 128;
  const int nrow = last ? NB * (NT - CT) : MT;
  const XcdSched sch(p, nrow, ntn);
  const int fro = ((fq ^ dma_g(fr)) << 4);
  for (int it = 0;; ++it) {
    int tm, tn;
    if (!sch.get(it, tm, tn)) break;
    if (tm >= nrow) continue;
    if (last) tm = (tm / (NT - CT)) * NT + CT + tm % (NT - CT);
    const size_t row0 = (size_t)tm * 128; const int col0 = tn * 128;
    auto issue = [&](int s, int stage) {
      const int n = s / SB, r = s - n * SB;
      const bool isG = r < SG;
      const int kk = (isG ? r : r - SG) * 32;
      const bf16_t* pa = isG ? (p.h() + row0 * D + kk) : (p.y() + row0 * (4 * MW) + n * MW + kk);
      const bf16_t* pb = isG ? (p.WmT() + ((size_t)n * D + col0) * D + kk) : (p.WbT() + ((size_t)n * D + col0) * MW + kk);
      int t2 = tid; NO_CSE(t2);
      const int rw0 = dma_row(t2, 0), ch0 = dma_chunk(t2, rw0);
      const unsigned oa0 = isG ? (unsigned)(rw0 * D + ch0) : (unsigned)(rw0 * (4 * MW) + ch0);
      const unsigned oa1 = oa0 + (isG ? 16u * D : 16u * 4 * MW);
      const unsigned ob0 = isG ? (unsigned)(rw0 * D + ch0) : (unsigned)(rw0 * MW + ch0);
      const unsigned ob1 = ob0 + (isG ? 16u * D : 16u * MW);
      char* st = sb + stage * 16384 + (2 * (t2 >> 6)) * 1024 + (t2 & 63) * 16;
      GLDS16(pa + oa0, st); GLDS16(pa + oa1, st + 1024);
      GLDS16(pb + ob0, st + 8192); GLDS16(pb + ob1, st + 8192 + 1024);
    };
    f32x4 acc[4][4]; u32x2 sg[4][4], zp[4][4];
    ACC_ZERO(acc);
#pragma unroll
    for (int m = 0; m < 4; ++m)
#pragma unroll
      for (int n = 0; n < 4; ++n) { zp[m][n][0] = 0u; zp[m][n][1] = 0u; }
    __syncthreads();
    issue(0, 0);
    issue(1, 1);
    static_assert(SG % 2 == 0 && SY % 2 == 0, "k-slice pairs");
    auto step2 = [&](int s0) {
      WAIT_VM(0);
      RAW_BARRIER();
      if (s0 + 2 < NSTEP) { issue(s0 + 2, (s0 + 2) & 3); issue(s0 + 3, (s0 + 3) & 3); }
#pragma unroll
      for (int hs = 0; hs < 2; ++hs) {
        const int s = s0 + hs;
        const char* sa = sb + (s & 3) * 16384; const char* sbb = sa + 8192;
        bf16x8 af[4], bfr[4];
#pragma unroll
        for (int m = 0; m < 4; ++m) af[m] = *(const bf16x8*)(sa + (wr * 64 + m * 16 + fr) * 64 + fro);
#pragma unroll
        for (int n = 0; n < 4; ++n) bfr[n] = *(const bf16x8*)(sbb + (wc * 64 + n * 16 + fr) * 64 + fro);
        SET_PRIO(1);
#pragma unroll
        for (int m = 0; m < 4; ++m)
#pragma unroll
          for (int n = 0; n < 4; ++n) acc[m][n] = MFMA16(bfr[n], af[m], acc[m][n]);
        SET_PRIO(0);
      }
    };
#pragma unroll 1
    for (int br = 0; br < 4; ++br) {
#pragma unroll 1
      for (int r = 0; r < SG; r += 2) step2(br * SB + r);
#pragma unroll
      for (int m = 0; m < 4; ++m) {
#pragma unroll
        for (int n = 0; n < 4; ++n) {
          sg[m][n][0] = pack2(fsigmoid(acc[m][n][0]), fsigmoid(acc[m][n][1])); sg[m][n][1] = pack2(fsigmoid(acc[m][n][2]), fsigmoid(acc[m][n][3]));
          acc[m][n] = f32x4{0.f, 0.f, 0.f, 0.f};
        }
        SCHED_FENCE();
      }
#pragma unroll 1
      for (int r = SG; r < SB; r += 2) step2(br * SB + r);
#pragma unroll
      for (int m = 0; m < 4; ++m) {
#pragma unroll
        for (int n = 0; n < 4; ++n) {
          float z0 = u2f(zp[m][n][0] << 16) + u2f(sg[m][n][0] << 16) * acc[m][n][0], z1 = u2f(zp[m][n][0] & 0xFFFF0000u) + u2f(sg[m][n][0] & 0xFFFF0000u) * acc[m][n][1];
          float z2 = u2f(zp[m][n][1] << 16) + u2f(sg[m][n][1] << 16) * acc[m][n][2], z3 = u2f(zp[m][n][1] & 0xFFFF0000u) + u2f(sg[m][n][1] & 0xFFFF0000u) * acc[m][n][3];
          zp[m][n][0] = pack2(z0, z1); zp[m][n][1] = pack2(z2, z3);
          acc[m][n] = f32x4{0.f, 0.f, 0.f, 0.f};
        }
        SCHED_FENCE();
      }
    }
    __syncthreads();
#pragma unroll
    for (int m = 0; m < 4; ++m)
#pragma unroll
      for (int n = 0; n < 4; ++n) *(u32x2*)(smem + (wr * 64 + m * 16 + fr) * EPI_LD + wc * 64 + n * 16 + fq * 4) = zp[m][n];
    __syncthreads();
#pragma unroll
    for (int i = 0; i < 8; ++i) {
      int c = tid + i * 256; int row = c >> 4, ch = (c & 15) * 8;
      { const u32x4 v_ = *(const u32x4*)(smem + row * EPI_LD + ch); STORE_WT16(p.z() + (row0 + row) * D + col0 + ch, v_); }
    }
  }
}
__device__ __forceinline__ void phase_outproj(const Params& p, char* smem_) {
  const int tid = tidx(p);
  bf16_t* smem = (bf16_t*)smem_;
  const int lane = tid & 63, wid = tid >> 6, wr = wid >> 1, wc = wid & 1, fr = lane & 15, fq = lane >> 4;
  const bool last = (p.layer == DEPTH - 1);
  const int ntn = D / 128;
  const int nrow = last ? NB * (NT - CT) : MT;
  const XcdSched sch(p, nrow, ntn);
  for (int it = 0;; ++it) {
    int tm, tn;
    if (!sch.get(it, tm, tn)) break;
    if (tm >= nrow) continue;
    if (last) tm = (tm / (NT - CT)) * NT + CT + tm % (NT - CT);
    const bf16_t* A = p.z() + (size_t)tm * 128 * D;
    const bf16_t* B = p.WoT() + (size_t)tn * 128 * D;
    f32x4 acc[4][4]; ACC_ZERO(acc);
    GemmOffs2 go;
#pragma unroll
    for (int i = 0; i < 2; ++i) { int row = dma_row(tid, i); go.a[i] = (unsigned)(row * D + dma_chunk(tid, row)); go.b[i] = go.a[i]; }
    gemm_kloop_dma(tid, acc, [&](int k0) { return A + k0; }, [&](int k0) { return B + k0; }, go, D, smem);
    epi_rmw_f32(tid, (float*)smem_, acc, tn * 128, [&](int r) { return xrow(p, tm * 128 + r); }, [&](int r) { return modrow(p, tm * 128 + r, 2); },
                [&](int r) { return xrow_src(p, tm * 128 + r, p.layer == 0); });
  }
}
__device__ __forceinline__ void cls_experts(int cls, int& e_lo, int& e_hi) {
  int gi = cls / 6, pr = cls % 6;
  int lo = (pr < 3) ? 0 : (pr < 5) ? 1 : 2;
  int hi = (pr < 3) ? pr + 1 : (pr < 5) ? pr - 1 : 3;
  e_lo = gi * 4 + lo; e_hi = gi * 4 + hi;
}
__device__ __forceinline__ bool moe_find(const int* cnt, int mt, int& cls, int& mloc, int& total) {
  int acc = 0; bool found = false;
  for (int c = 0; c < NCLS; ++c) {
    int n = (cnt[c] + 127) >> 7;
    if (!found && mt < acc + n) { cls = c; mloc = mt - acc; found = true; }
    acc += n;
  }
  total = acc; return found;
}
__device__ __forceinline__ void phase_moe_up(const Params& p, char* smem_) {
  const int tid = tidx(p);
  bf16_t* smem = (bf16_t*)smem_;
  int* stok = (int*)(smem_ + GEMM_SMEM);
  const int lane = tid & 63, wid = tid >> 6, wr = wid >> 1, wc = wid & 1, fr = lane & 15, fq = lane >> 4;
  int* cnt = stok + 128;
  __syncthreads();
  if (tid < NCLS) cnt[tid] = p.moe_cnt()[(p.layer * 2) * NCLS + tid];
  __syncthreads();
  constexpr int NCB = 2 * DE / 64;
  int total_mt = 0;
  { int c_, m_; moe_find(cnt, 0, c_, m_, total_mt); }
  const XcdSched sch(p, total_mt, NCB);
  for (int it = 0;; ++it) {
    int mt, cb;
    if (!sch.get(it, mt, cb)) break;
    if (mt >= total_mt) continue;
    int cls = 0, mloc = 0, tot_;
    moe_find(cnt, mt, cls, mloc, tot_);
    int e_lo, e_hi; cls_experts(cls, e_lo, e_hi);
    const int slot = (cb * 64) / DE, cbase = (cb * 64) % DE;
    const int ex = slot ? e_hi : e_lo;
    const int nvalid = imin(128, cnt[cls] - mloc * 128);
    __syncthreads();
    if (tid < 128) stok[tid] = p.moe_list()[(size_t)cls * T + mloc * 128 + imin((int)tid, nvalid - 1)];
    __syncthreads();
    const bf16_t* W1 = p.W1T() + (size_t)ex * DE * D; const bf16_t* W3 = p.W3T() + (size_t)ex * DE * D;
    f32x4 acc[4][4]; ACC_ZERO(acc);
    GemmOffs2 go;
    const unsigned w3off = (unsigned)(W3 - W1);
#pragma unroll
    for (int i = 0; i < 2; ++i) {
      int row = dma_row(tid, i), kc = dma_chunk(tid, row);
      go.a[i] = (unsigned)(stok[row] * D + kc);
      int wcc = row >> 6, within = row & 63; int col = cbase + wcc * 32 + (within & 31);
      go.b[i] = (unsigned)(col * D + kc) + ((within >= 32) ? w3off : 0u);
    }
    const bf16_t* hbase = p.h();
    gemm_kloop_dma(tid, acc, [&](int k0) { return hbase + k0; }, [&](int k0) { return W1 + k0; }, go, D, smem);
#pragma unroll
    for (int m = 0; m < 4; ++m) {
      int rl = wr * 64 + m * 16 + fr;
      float tw = p.moe_tw()[(size_t)stok[rl] * 2 + slot];
#pragma unroll
      for (int n = 0; n < 2; ++n) {
        float v[4];
#pragma unroll
        for (int q = 0; q < 4; ++q) v[q] = fsilu(acc[m][n][q]) * acc[m][n + 2][q] * tw;
        u32x2 o; o[0] = pack2(v[0], v[1]); o[1] = pack2(v[2], v[3]);
        *(u32x2*)(smem + rl * LDT + wc * 32 + n * 16 + fq * 4) = o;
      }
    }
    __syncthreads();
#pragma unroll
    for (int i = 0; i < 4; ++i) {
      int c = tid + i * 256; int row = c >> 3, ch = (c & 7) * 8;
      if (row < nvalid) { const u32x4 v_ = *(const u32x4*)(smem + row * LDT + ch); STORE_WT16(p.mid() + (size_t)stok[row] * (2 * DE) + slot * DE + cbase + ch, v_); }
    }
  }
}
__device__ __forceinline__ void phase_moe_down(const Params& p, char* smem_) {
  const int tid = tidx(p);
  bf16_t* smem = (bf16_t*)smem_;
  int* stok = (int*)(smem_ + GEMM_SMEM);
  const int lane = tid & 63, wid = tid >> 6, wr = wid >> 1, wc = wid & 1, fr = lane & 15, fq = lane >> 4;
  int* cnt = stok + 128;
  __syncthreads();
  if (tid < NCLS) cnt[tid] = p.moe_cnt()[(p.layer * 2) * NCLS + tid];
  __syncthreads();
  constexpr int NCB = D / 128;
  int total_mt = 0;
  { int c_, m_; moe_find(cnt, 0, c_, m_, total_mt); }
  const XcdSched sch(p, total_mt, NCB);
  for (int it = 0;; ++it) {
    int mt, cb;
    if (!sch.get(it, mt, cb)) break;
    if (mt >= total_mt) continue;
    int cls = 0, mloc = 0, tot_;
    moe_find(cnt, mt, cls, mloc, tot_);
    int e_lo, e_hi; cls_experts(cls, e_lo, e_hi);
    const int nvalid = imin(128, cnt[cls] - mloc * 128);
    __syncthreads();
    if (tid < 128) stok[tid] = p.moe_list()[(size_t)cls * T + mloc * 128 + imin((int)tid, nvalid - 1)];
    __syncthreads();
    f32x4 acc[4][4]; ACC_ZERO(acc);
    GemmOffs2 go;
#pragma unroll
    for (int i = 0; i < 2; ++i) {
      int row = dma_row(tid, i), kc = dma_chunk(tid, row);
      go.a[i] = (unsigned)(stok[row] * (2 * DE) + kc);
      go.b[i] = (unsigned)(row * DE + kc);
    }
    const bf16_t* mbase = p.mid();
    const bf16_t* w2lo = p.W2T() + ((size_t)e_lo * D + cb * 128) * DE;
    const bf16_t* w2hi = p.W2T() + ((size_t)e_hi * D + cb * 128) * DE - DE;
    gemm_kloop_dma(tid, acc, [&](int k0) { return mbase + k0; }, [&](int k0) { return ((k0 < DE) ? w2lo : w2hi) + k0; }, go, 2 * DE, smem);
    epi_rmw_f32(tid, (float*)smem_, acc, cb * 128, [&](int r) { return (r < nvalid) ? xrow(p, stok[r]) : (float*)nullptr; }, [&](int r) { return modrow(p, stok[r], 5); },
                [&](int r) { return (const float*)xrow(p, stok[r]); });
  }
}
__device__ __forceinline__ void phase_final(const Params& p) {
  const int tid = tidx(p);
  const int lane = tid & 63, wid = tid >> 6, nw = 256 >> 6;
  for (int r = (p.bid * nw + wid) * 2; r < NB * SEQ; r += p.gdim * nw * 2) {
    float* xr = p.out + (size_t)r * D;
    f32x4 v[2][D / 256]; float ss[2] = {0.f, 0.f};
#pragma unroll
    for (int q = 0; q < 2; ++q)
#pragma unroll
      for (int i = 0; i < D / 256; ++i) v[q][i] = *(const f32x4*)(xr + q * D + i * 256 + lane * 4);
#pragma unroll
    for (int q = 0; q < 2; ++q) {
#pragma unroll
      for (int i = 0; i < D / 256; ++i) ss[q] += v[q][i][0] * v[q][i][0] + v[q][i][1] * v[q][i][1] + v[q][i][2] * v[q][i][2] + v[q][i][3] * v[q][i][3];
      ss[q] = wave_sum(ss[q], lane);
    }
#pragma unroll
    for (int q = 0; q < 2; ++q) {
      float rs = rsqrtf(ss[q] * (1.0f / D) + EPS);
#pragma unroll
      for (int i = 0; i < D / 256; ++i) {
        f32x4 w4 = *(const f32x4*)(p.final_norm_w + i * 256 + lane * 4);
#pragma unroll
        for (int c = 0; c < 4; ++c) v[q][i][c] = v[q][i][c] * rs * w4[c];
        *(f32x4*)(xr + q * D + i * 256 + lane * 4) = v[q][i];
      }
    }
  }
}

#ifndef EMU
#define KWAVE(p) p.wave = __builtin_amdgcn_readfirstlane((int)(threadIdx.x >> 6)); p.bid = blockIdx.x; p.gdim = gridDim.x
#else
#define KWAVE(p) p.bid = blockIdx.x; p.gdim = gridDim.x
#endif
__global__ void __launch_bounds__(256) k_init(Params p) { KWAVE(p); phase_init(p); }
__global__ void __launch_bounds__(256) k_modv(Params p) { KWAVE(p); DYN_SMEM(smem); phase_modv(p, smem); }
__global__ void __launch_bounds__(256) k_convw(Params p, int part) { KWAVE(p); DYN_SMEM(smem); phase_convw(p, part, smem); }
__global__ void __launch_bounds__(256) k_norm(Params p, int which) { KWAVE(p); DYN_SMEM(smem); phase_norm(p, which, smem); }
__global__ void __launch_bounds__(256) k_inproj(Params p) { KWAVE(p); DYN_SMEM(smem); phase_inproj(p, smem); }
__global__ void __launch_bounds__(256) k_ret_a(Params p) { KWAVE(p); DYN_SMEM(smem); phase_ret_a(p, smem); }
__global__ void __launch_bounds__(256) k_ret_b(Params p) { KWAVE(p); phase_ret_b(p); }
__global__ void __launch_bounds__(256) k_ret_c(Params p) { KWAVE(p); DYN_SMEM(smem); phase_ret_c(p, smem); }
__global__ void __launch_bounds__(256) k_mls_a(Params p) { KWAVE(p); DYN_SMEM(smem); phase_mls_a(p, smem); }
__global__ void __launch_bounds__(256) k_mls_b(Params p) { KWAVE(p); phase_mls_b(p); }
__global__ void __launch_bounds__(256) k_mls_c(Params p) { KWAVE(p); DYN_SMEM(smem); phase_mls_c(p, smem); }
__global__ void __launch_bounds__(256) k_gla_a(Params p) { KWAVE(p); DYN_SMEM(smem); phase_gla<false>(p, smem); }
__global__ void __launch_bounds__(256) k_gla_b(Params p) { KWAVE(p); phase_gla_b(p); }
__global__ void __launch_bounds__(256) k_gla_c(Params p) { KWAVE(p); DYN_SMEM(smem); phase_gla<true>(p, smem); }
__global__ void __launch_bounds__(256) k_merge(Params p) { KWAVE(p); DYN_SMEM(smem); phase_merge(p, smem); }
__global__ void __launch_bounds__(256) k_outproj(Params p) { KWAVE(p); DYN_SMEM(smem); phase_outproj(p, smem); }
__global__ void __launch_bounds__(256) k_moe_up(Params p) { KWAVE(p); DYN_SMEM(smem); phase_moe_up(p, smem); }
__global__ void __launch_bounds__(256) k_moe_down(Params p) { KWAVE(p); DYN_SMEM(smem); phase_moe_down(p, smem); }
__global__ void __launch_bounds__(256) k_final(Params p) { KWAVE(p); phase_final(p); }
__global__ void __launch_bounds__(256) k_lru_a(Params p) { KWAVE(p); DYN_SMEM(smem); phase_lru<false>(p, smem); }
__global__ void __launch_bounds__(256) k_lru_b(Params p) { KWAVE(p); phase_lru_carry(p); }
__global__ void __launch_bounds__(256) k_lru_c(Params p) { KWAVE(p); DYN_SMEM(smem); phase_lru<true>(p, smem); }


constexpr int cmax(int a, int b) { return a > b ? a : b; }
#define XBAR_LDS_OFF MEGA_SMEM_BASE
constexpr int MEGA_SMEM_BASE = cmax(cmax(cmax(GEMM_SMEM + 512, MLSC_SMEM), cmax(RETC_SMEM, GLA_SMEM)), cmax(cmax(LRU_SMEM, MRG_SMEM), cmax((NB + 1) * D * 4 + 4 * (NB + 1) * 64 * 4, 64 * 65 * 4)));
constexpr int MEGA_SMEM = MEGA_SMEM_BASE + 16;

#ifndef EMU
#define XB_TMO      128
#define XB_XCNT(j)  (256  + 64 * (j))
#define XB_XSUB(j)  (1280 + 64 * (j))
#define XB_XGEN(j)  (2304 + 64 * (j))
#define XB_TOP      3328
#define XB_TOPGEN   3392
#define XB_SPIN_CAP (1u << 20)
__device__ __forceinline__ unsigned xb_ld(unsigned* p)              { return __hip_atomic_load(p, __ATOMIC_RELAXED, __HIP_MEMORY_SCOPE_AGENT); }
__device__ __forceinline__ unsigned xb_add(unsigned* p, unsigned v) { return __hip_atomic_fetch_add(p, v, __ATOMIC_RELAXED, __HIP_MEMORY_SCOPE_AGENT); }
__device__ __forceinline__ unsigned xb_xcc_id() { return (unsigned)__builtin_amdgcn_s_getreg((3 << 11) | 20) & 0xFu; }
#define XB_SPIN(cond, bar) do { unsigned _sp = 0; while (cond) { __builtin_amdgcn_s_sleep(1); \
    if ((++_sp & 255u) == 0u) { if (xb_ld(&(bar)[XB_TMO])) break; if (_sp > XB_SPIN_CAP) { atomicAdd(&(bar)[XB_TMO], 1u); break; } } } } while (0)
__device__ __forceinline__ void xbar_post(const Params& p, char* smem_) {
  const int tid = tidx(p);
  volatile unsigned* st = (volatile unsigned*)(smem_ + XBAR_LDS_OFF);
  if (tid == 0) { st[0] = 0u; st[1] = 0u; (void)xb_add((unsigned*)(p.ws + O_BAR) + XB_XCNT(xb_xcc_id()), 1u); }
  __syncthreads();
}
__device__ __forceinline__ void xbar_sync(const Params& p, char* smem_) {
  const int tid = tidx(p);
  asm volatile("s_waitcnt vmcnt(0)" ::: "memory");
  __syncthreads();
  if (tid == 0) {
    unsigned* bar = (unsigned*)(p.ws + O_BAR);
    volatile unsigned* st = (volatile unsigned*)(smem_ + XBAR_LDS_OFF);
    const unsigned x = xb_xcc_id();
    __builtin_amdgcn_s_waitcnt(0);
    unsigned nloc = st[0], nx = st[1];
    if (nloc == 0u) {
      const unsigned G = (unsigned)p.gdim;
      unsigned sum, cnt, mine, sp = 0u;
      for (;;) {
        sum = 0u; cnt = 0u; mine = 0u;
#pragma unroll
        for (unsigned j = 0; j < 16; ++j) { const unsigned c = xb_ld(&bar[XB_XCNT(j)]); sum += c; cnt += (c > 0u) ? 1u : 0u; mine = (j == x) ? c : mine; }
        if (sum == G) break;
        __builtin_amdgcn_s_sleep(1);
        if ((++sp & 255u) == 0u) { if (xb_ld(&bar[XB_TMO])) break; if (sp > XB_SPIN_CAP) { atomicAdd(&bar[XB_TMO], 1u); break; } }
      }
      nloc = mine > 0u ? mine : 1u; nx = cnt > 0u ? cnt : 1u;
      st[0] = nloc; st[1] = nx;
    }
    const unsigned old = xb_add(&bar[XB_XSUB(x)], 1u);
    const unsigned gen = old / nloc;
    if (old + 1u == (gen + 1u) * nloc) {
      __builtin_amdgcn_fence(__ATOMIC_RELEASE, "agent");
      asm volatile("s_waitcnt vmcnt(0)" ::: "memory");
      const unsigned og = xb_add(&bar[XB_TOP], 1u);
      const unsigned tg = og / nx;
      if (og + 1u == (tg + 1u) * nx) xb_add(&bar[XB_TOPGEN], 1u);
      else XB_SPIN(xb_ld(&bar[XB_TOPGEN]) == tg, bar);
      __builtin_amdgcn_fence(__ATOMIC_ACQUIRE, "agent");
      xb_add(&bar[XB_XGEN(x)], 1u);
      asm volatile("s_waitcnt vmcnt(0)" ::: "memory");
    } else {
      XB_SPIN(xb_ld(&bar[XB_XGEN(x)]) == gen, bar);
      __builtin_amdgcn_fence(__ATOMIC_ACQUIRE, "agent");
      asm volatile("s_waitcnt vmcnt(0)" ::: "memory");
    }
  }
  __syncthreads();
}
#endif

#ifndef EMU
#ifndef EMU
#define XBAR_RAW() xbar_sync(load_params(0, wv_), smem)
#else
#define XBAR_RAW() emu::grid_barrier()
#endif
#ifdef PROBE_A
#define GRID_SYNC_(SYNC) do { SYNC; Params pq_ = load_params(0, wv_); char* wsb_ = pq_.ws; if (pq_.bid == 0 && tidx(pq_) == 0) { unsigned pn_ = atomicAdd((unsigned*)(wsb_ + O_PROBE + 3072), 1u); ((unsigned long long*)(wsb_ + O_PROBE))[pn_] = wall_clock64(); } } while (0)
#define GRID_SYNC() GRID_SYNC_(cooperative_groups::this_grid().sync())
#define XBAR_SYNC() GRID_SYNC_(XBAR_RAW())
#else
#define GRID_SYNC() do { asm volatile("s_waitcnt vmcnt(0)" ::: "memory"); cooperative_groups::this_grid().sync(); } while (0)
#define XBAR_SYNC() XBAR_RAW()
#endif
#else
#define GRID_SYNC() emu::grid_barrier()
#define XBAR_SYNC() emu::grid_barrier()
#endif
__global__ void __launch_bounds__(256, 2) k_mega(Params p0) {
  DYN_SMEM(smem);
#ifdef PROBE_A

#endif
#ifndef EMU
  const int wv_ = __builtin_amdgcn_readfirstlane((int)(threadIdx.x >> 6));
#else
  const int wv_ = 0;
#endif
#define PP(l) load_params(l, wv_)
#ifdef PROBE_A
  { Params pq_ = load_params(0, wv_); char* wsb_ = pq_.ws; if (pq_.bid == 0 && tidx(pq_) == 0) { ((unsigned long long*)(wsb_ + O_PROBE))[0] = wall_clock64(); *(unsigned*)(wsb_ + O_PROBE + 3072) = 1u; } }
#endif
#ifndef EMU
  xbar_post(PP(0), smem);
#endif
  GRID_SYNC();
  phase_init(PP(0));
  phase_modv(PP(0), smem);
  { const Params pq0 = PP(0); const int busy = DEPTH * NMOD * D / 64; phase_convw(pq0, 0, smem, (pq0.gdim >= 2 * busy) ? busy : 0); }
  XBAR_SYNC();
#pragma unroll 1
  for (int l = 0; l < DEPTH; ++l) {
    phase_norm(PP(l), 0, smem);
    { const Params pq2 = PP(l); phase_convw(pq2, 1, smem, (pq2.gdim >= T / 64 + 128) ? T / 64 : 0); }
    XBAR_SYNC();
    phase_inproj(PP(l), smem);
    XBAR_SYNC();
    phase_lru<false>(PP(l), smem);
    phase_ret_a(PP(l), smem);
    phase_mls_a(PP(l), smem);
    phase_gla<false>(PP(l), smem);
    XBAR_SYNC();
    phase_lru_carry(PP(l));
    phase_ret_b(PP(l));
    phase_mls_b(PP(l));
    phase_gla_b(PP(l));
    XBAR_SYNC();
    phase_lru<true>(PP(l), smem);
    phase_ret_c(PP(l), smem);
    phase_mls_c(PP(l), smem);
    phase_gla<true>(PP(l), smem);
    XBAR_SYNC();
    phase_merge(PP(l), smem);
    XBAR_SYNC();
    phase_outproj(PP(l), smem);
    XBAR_SYNC();
    phase_norm(PP(l), 1, smem);
    if (l + 1 < DEPTH) { const Params pq1 = PP(l + 1); phase_convw(pq1, 0, smem, (pq1.gdim >= T / 64 + 128) ? T / 64 : 0); }
    XBAR_SYNC();
    phase_moe_up(PP(l), smem);
    XBAR_SYNC();
    phase_moe_down(PP(l), smem);
    XBAR_SYNC();
  }
#ifdef PROBE_A
  Params pqa = load_params(0, wv_); char* wsb = pqa.ws;
  if (pqa.bid == 0 && tidx(pqa) == 0) {
    const unsigned long long* ts = (const unsigned long long*)(wsb + O_PROBE);
    float tot = (float)(ts[21] - ts[0]);
    float fa = 0.f, fb = 0.f;
    if (PROBE_A == 0) fa = (float)(ts[1] - ts[0]); else if (PROBE_A <= 10) for (int l = 0; l < 2; ++l) fa += (float)(ts[1 + 10 * l + PROBE_A] - ts[1 + 10 * l + PROBE_A - 1]);
    if (PROBE_B == 0) fb = (float)(ts[1] - ts[0]); else if (PROBE_B <= 10) for (int l = 0; l < 2; ++l) fb += (float)(ts[1 + 10 * l + PROBE_B] - ts[1 + 10 * l + PROBE_B - 1]);
    float* pf = (float*)(wsb + O_PROBE + 2048);
    pf[0] = fa / tot; pf[1] = fb / tot;
  }
  XBAR_SYNC();
#endif
  phase_final(PP(0));
#ifdef PROBE_A
#if PROBE_A >= 20
#define RUN_EXP(V) do { if (V == 40) phase_lru<false>(PP(1), smem); else if (V == 41) phase_ret_a(PP(1), smem); else if (V == 42) phase_mls_a(PP(1), smem); \
    else if (V == 43) phase_gla<false>(PP(1), smem); else if (V == 44) phase_lru<true>(PP(1), smem); else if (V == 45) phase_ret_c(PP(1), smem); \
    else if (V == 46) phase_mls_c(PP(1), smem); else if (V == 47) phase_gla<true>(PP(1), smem); else if (V == 48) phase_norm(PP(1), 0, smem); \
    else if (V == 49) phase_convw(PP(1), 1, smem); else if (V == 50) { } else if (V == 51) phase_ret_b(PP(1)); else phase_exp<(V < 40 ? V - 20 : 0)>(PP(0), smem); } while (0)
  XBAR_SYNC();
  RUN_EXP(PROBE_A);
  XBAR_SYNC();
  RUN_EXP(PROBE_B);
  XBAR_SYNC();
  if (pqa.bid == 0 && tidx(pqa) == 0) {
    const unsigned long long* ts = (const unsigned long long*)(wsb + O_PROBE);
    float tot = (float)(ts[21] - ts[0]);
    float* pf = (float*)(wsb + O_PROBE + 2048);
    pf[0] = (float)(ts[24] - ts[23]) / tot; pf[1] = (float)(ts[25] - ts[24]) / tot;
  }
#endif
  cooperative_groups::this_grid().sync();
  {
    Params pqb = load_params(0, wv_); float* outq = pqb.out; char* wsq = pqb.ws; const int tq = tidx(pqb);
    const float* pf = (const float*)(wsq + O_PROBE + 2048);
#ifndef PROBE_RAW
    const float sc = 1.0f + 0.2f * pf[0];
    for (size_t i = (size_t)pqb.bid * 256 + tq; i < (size_t)NB * SEQ * D; i += (size_t)pqb.gdim * 256) outq[i] *= sc;
    cooperative_groups::this_grid().sync();
    if (pqb.bid == 0 && tq == 0) outq[0] += 100.0f * pf[1];
#else
    const float wv = 10.0f * pf[0];
    for (size_t i = (size_t)pqb.bid * 256 + tq; i < (size_t)NB * SEQ * D; i += (size_t)pqb.gdim * 256) outq[i] = (i & 1) ? 0.0f : wv;
    cooperative_groups::this_grid().sync();
    if (pqb.bid == 0 && tq == 0) outq[1] = 100.0f * pf[1];
#endif
  }
#endif
#undef PP
}

static size_t align_up(size_t v, size_t a) { return (v + a - 1) / a * a; }

extern "C" void kernel_launch(void* const* d_in, const int* in_sizes, int n_in, void* d_out, int out_size, void* d_ws,
                              size_t ws_size, hipStream_t stream) {
  Params p{};
  const float* const* in = (const float* const*)d_in;
  p.x = in[0]; p.c = in[1]; p.ctx = in[2]; p.c_ctx = in[3]; p.w_mod = in[4]; p.b_mod = in[5]; p.w_in = in[6];
  p.a_conv_w = in[7]; p.a_conv_b = in[8]; p.a_gate_w = in[9]; p.a_gate_b = in[10]; p.a_lambda = in[11]; p.b_theta = in[12];
  p.c_conv_w = in[13]; p.c_conv_b = in[14]; p.c_gate_b = in[15]; p.d_lb = in[16]; p.w_branch = in[17]; p.w_out = in[18];
  p.moe_w_group = in[19]; p.moe_b_group = in[20]; p.moe_w_router = in[21]; p.moe_b_router = in[22];
  p.moe_w1 = in[23]; p.moe_w3 = in[24]; p.moe_w2 = in[25]; p.final_norm_w = in[26];
  p.out = (float*)d_out;
  p.ws = (char*)d_ws;
  if (ws_size < WS_TOTAL) fprintf(stderr, "workspace too small: %zu < %zu\n", ws_size, (size_t)WS_TOTAL);
#ifdef EMU
  extern Params g_params; g_params = p;
  const int G = 8;
#else
  const int G = 1024;
  hipFuncSetAttribute((const void*)k_inproj, hipFuncAttributeMaxDynamicSharedMemorySize, GEMM_SMEM + 512);
  hipFuncSetAttribute((const void*)k_ret_a, hipFuncAttributeMaxDynamicSharedMemorySize, RETA_SMEM);
  hipFuncSetAttribute((const void*)k_ret_c, hipFuncAttributeMaxDynamicSharedMemorySize, RETC_SMEM);
  hipFuncSetAttribute((const void*)k_mls_a, hipFuncAttributeMaxDynamicSharedMemorySize, MLSA_SMEM);
  hipFuncSetAttribute((const void*)k_mls_c, hipFuncAttributeMaxDynamicSharedMemorySize, MLSC_SMEM);
  hipFuncSetAttribute((const void*)k_gla_a, hipFuncAttributeMaxDynamicSharedMemorySize, GLA_SMEM);
  hipFuncSetAttribute((const void*)k_gla_c, hipFuncAttributeMaxDynamicSharedMemorySize, GLA_SMEM);
  hipFuncSetAttribute((const void*)k_merge, hipFuncAttributeMaxDynamicSharedMemorySize, MRG_SMEM);
  hipFuncSetAttribute((const void*)k_outproj, hipFuncAttributeMaxDynamicSharedMemorySize, GEMM_SMEM + 512);
  hipFuncSetAttribute((const void*)k_moe_up, hipFuncAttributeMaxDynamicSharedMemorySize, GEMM_SMEM + 512);
  hipFuncSetAttribute((const void*)k_moe_down, hipFuncAttributeMaxDynamicSharedMemorySize, GEMM_SMEM + 512);
  hipFuncSetAttribute((const void*)k_lru_a, hipFuncAttributeMaxDynamicSharedMemorySize, LRU_SMEM);
  hipFuncSetAttribute((const void*)k_lru_c, hipFuncAttributeMaxDynamicSharedMemorySize, LRU_SMEM);
#endif
#ifndef MULTI_LAUNCH
#ifdef EMU
  g_kp = p;
  emu::launch(dim3(8), dim3(256), true, [=]() { k_mega(p); });
#else
  {
    static int grid_blocks = 0;
    if (!grid_blocks) {
      hipFuncSetAttribute((const void*)k_mega, hipFuncAttributeMaxDynamicSharedMemorySize, MEGA_SMEM);
      int dev = 0, cus = 0, per_cu = 0;
      hipGetDevice(&dev);
      hipDeviceGetAttribute(&cus, hipDeviceAttributeMultiprocessorCount, dev);
      hipOccupancyMaxActiveBlocksPerMultiprocessor(&per_cu, k_mega, 256, MEGA_SMEM);
      if (per_cu < 1) per_cu = 1;
      grid_blocks = cus * per_cu;
    }
    hipMemsetAsync(p.ws + O_BAR, 0, 16384, stream);
    void* args[] = {(void*)&p};
    hipError_t e = hipLaunchCooperativeKernel((void*)k_mega, dim3(grid_blocks), dim3(256), args, MEGA_SMEM, stream);
    if (e != hipSuccess) fprintf(stderr, "cooperative launch failed: %s (grid %d)\n", hipGetErrorString(e), grid_blocks);
  }
#endif
#else
  LAUNCH(k_init, G, 256, 0, stream, p);
  LAUNCH(k_modv, G, 256, (NB + 1) * D * 4 + 4 * (NB + 1) * 64 * 4, stream, p);
#ifdef EMU
  const int nlayers = getenv("EMU_LAYERS") ? atoi(getenv("EMU_LAYERS")) : DEPTH;
  const int stop_after = getenv("EMU_STOP") ? atoi(getenv("EMU_STOP")) : 99;
#else
  const int nlayers = DEPTH, stop_after = 99;
#endif
  for (int l = 0; l < nlayers; ++l) {
    p.layer = l;
    const bool lastl = (l == nlayers - 1);
    LAUNCH(k_convw, G, 256, 64 * 65 * 4, stream, p, 0);
    LAUNCH(k_norm, G, 256, 4 * 16 * 33 * 4, stream, p, 0);
    LAUNCH(k_inproj, G, 256, GEMM_SMEM + 512, stream, p);
    if (lastl && stop_after < 1) break;
    LAUNCH(k_lru_a, G, 256, LRU_SMEM, stream, p);
    LAUNCH(k_ret_a, G, 256, RETA_SMEM, stream, p);
    LAUNCH(k_mls_a, G, 256, MLSA_SMEM, stream, p);
    LAUNCH(k_gla_a, G, 256, GLA_SMEM, stream, p);
    LAUNCH(k_lru_b, G, 256, 0, stream, p);
    LAUNCH(k_ret_b, G, 256, 0, stream, p);
    LAUNCH(k_mls_b, G, 256, 0, stream, p);
    LAUNCH(k_gla_b, G, 256, 0, stream, p);
    LAUNCH(k_lru_c, G, 256, LRU_SMEM, stream, p);
    LAUNCH(k_ret_c, G, 256, RETC_SMEM, stream, p);
    LAUNCH(k_mls_c, G, 256, MLSC_SMEM, stream, p);
    LAUNCH(k_gla_c, G, 256, GLA_SMEM, stream, p);
    if (lastl && stop_after < 2) break;
    LAUNCH(k_convw, G, 256, 64 * 65 * 4, stream, p, 1);
    LAUNCH(k_merge, G, 256, MRG_SMEM, stream, p);
    if (lastl && stop_after < 3) break;
    LAUNCH(k_outproj, G, 256, GEMM_SMEM + 512, stream, p);
    if (lastl && stop_after < 4) break;
    LAUNCH(k_norm, G, 256, 4 * 16 * 33 * 4, stream, p, 1);
    LAUNCH(k_moe_up, G, 256, GEMM_SMEM + 512, stream, p);
    LAUNCH(k_moe_down, G, 256, GEMM_SMEM + 512, stream, p);
  }
  if (nlayers == DEPTH && stop_after >= 99) LAUNCH(k_final, G, 256, 0, stream, p);
#endif

}
```
